# Optimizing an MI355X kernel written in HIP

```python
import math
import numpy as np
import jax
import jax.numpy as jnp
from jax import lax

D_MODEL = 1024
BATCH = 8
SEQ = 4096
DEPTH = 2

POOL_WIDTH = D_MODEL // 2
POOL_GROUPS = 4
POOL_WINDOWS = (2, 4, 8, 16)
POOL_GROUP_CH = POOL_WIDTH // POOL_GROUPS
SSM_WIDTH = D_MODEL // 2
SSM_GROUP_CH = 16
SSM_GROUPS = SSM_WIDTH // SSM_GROUP_CH
SSM_STATE = 64
NSA_HEADS = 8
NSA_KV_HEADS = 2
NSA_GROUP = NSA_HEADS // NSA_KV_HEADS
HEAD_DIM = 64
NSA_WIDTH = NSA_HEADS * HEAD_DIM
KV_WIDTH = NSA_KV_HEADS * HEAD_DIM
CMP_BLOCK = 32
CMP_STRIDE = 16
CMP_HIDDEN = 2 * HEAD_DIM
SEL_BLOCK = 64
SEL_TOPK = 16
WINDOW = 512
Q_BLOCK = 128
SEL_Q_BLOCK = 64
ROPE_THETA = 500000.0
ROPE_DIMS = HEAD_DIM // 4
NEG = -1e30
FORCE_SCORE = 1e6
D_FF = 4 * D_MODEL
ALPHA = (2 * DEPTH) ** 0.25
BETA = (8 * DEPTH) ** -0.25
LN_EPS = 1e-5
IN_SPLITS = (POOL_WIDTH, SSM_WIDTH, NSA_WIDTH, 6 * KV_WIDTH, 3 * NSA_HEADS, 3 * D_MODEL)
IN_WIDTH = sum(IN_SPLITS)

kernel_name = "hybrid_pool_s5_nsa_deepnorm"


def layer_norm(x, g, b):
    xf = x.astype(jnp.float32)
    mu = jnp.mean(xf, axis=-1, keepdims=True)
    var = jnp.mean(jnp.square(xf - mu), axis=-1, keepdims=True)
    y = (xf - mu) * lax.rsqrt(var + LN_EPS)
    return (y * g.astype(jnp.float32) + b.astype(jnp.float32)).astype(x.dtype)


def rope_tables(L):
    pos = jnp.arange(L, dtype=jnp.float32)
    inv_freq = ROPE_THETA ** (-jnp.arange(0, ROPE_DIMS, 2, dtype=jnp.float32) / ROPE_DIMS)
    ang = pos[:, None] * inv_freq[None, :]
    return jnp.cos(ang), jnp.sin(ang)


def partial_rope(x, cos, sin):
    half = ROPE_DIMS // 2
    c = cos[:, None, :].astype(x.dtype)
    s = sin[:, None, :].astype(x.dtype)
    x1 = x[..., :half]
    x2 = x[..., half:ROPE_DIMS]
    return jnp.concatenate([x1 * c - x2 * s, x1 * s + x2 * c, x[..., ROPE_DIMS:]], axis=-1)


def pool_mixer(u, w_pool, pool_scale):
    B, L, _ = u.shape
    uf = u.astype(jnp.float32)
    csum = jnp.cumsum(uf, axis=1)
    t = jnp.arange(L)
    means = []
    for gi, w in enumerate(POOL_WINDOWS):
        cs = csum[..., gi * POOL_GROUP_CH:(gi + 1) * POOL_GROUP_CH]
        lag = jnp.pad(cs[:, :L - w], ((0, 0), (w, 0), (0, 0)))
        cnt = jnp.minimum(t + 1, w).astype(jnp.float32)[None, :, None]
        means.append((cs - lag) / cnt)
    z = (jnp.concatenate(means, axis=-1) - uf).astype(u.dtype)
    z = z.reshape(B, L, POOL_GROUPS, POOL_GROUP_CH)
    y = jnp.einsum('blgc,gcd->blgd', z, w_pool).reshape(B, L, POOL_WIDTH)
    return y * pool_scale


def s5_mixer(u, lam_re, lam_im, log_dt, b_re, b_im, c_re, c_im, d_skip, w_glu, b_glu):
    B, L, _ = u.shape
    f32 = jnp.float32
    uf = u.astype(f32).reshape(B, L, SSM_GROUPS, SSM_GROUP_CH)
    lr = lam_re.astype(f32)
    li = lam_im.astype(f32)
    step = jnp.exp(log_dt.astype(f32))[:, None]
    mag = jnp.exp(lr * step)
    ab_re = mag * jnp.cos(li * step)
    ab_im = mag * jnp.sin(li * step)
    den = lr * lr + li * li
    n_re = ab_re - 1.0
    n_im = ab_im
    k_re = (n_re * lr + n_im * li) / den
    k_im = (n_im * lr - n_re * li) / den
    br = b_re.astype(f32)
    bi = b_im.astype(f32)
    bb_re = k_re[..., None] * br - k_im[..., None] * bi
    bb_im = k_re[..., None] * bi + k_im[..., None] * br
    bu_re = jnp.einsum('gpc,blgc->blgp', bb_re, uf)
    bu_im = jnp.einsum('gpc,blgc->blgp', bb_im, uf)
    a_re = jnp.broadcast_to(ab_re[None, None], (1, L) + ab_re.shape)
    a_im = jnp.broadcast_to(ab_im[None, None], (1, L) + ab_im.shape)

    def combine(e1, e2):
        a1r, a1i, b1r, b1i = e1
        a2r, a2i, b2r, b2i = e2
        return (a1r * a2r - a1i * a2i,
                a1r * a2i + a1i * a2r,
                a2r * b1r - a2i * b1i + b2r,
                a2r * b1i + a2i * b1r + b2i)

    _, _, h_re, h_im = lax.associative_scan(combine, (a_re, a_im, bu_re, bu_im), axis=1)
    y = (jnp.einsum('gcp,blgp->blgc', c_re.astype(f32), h_re)
         - jnp.einsum('gcp,blgp->blgc', c_im.astype(f32), h_im)
         + d_skip.astype(f32) * uf)
    z = jax.nn.gelu(y.reshape(B, L, SSM_WIDTH))
    out = z * jax.nn.sigmoid(z @ w_glu.astype(f32) + b_glu.astype(f32))
    return out.astype(u.dtype)


def overlap_matrix(n_cmp, n_sel):
    cs = np.arange(n_cmp)[:, None] * CMP_STRIDE
    ss = np.arange(n_sel)[None, :] * SEL_BLOCK
    ov = np.minimum(cs + CMP_BLOCK, ss + SEL_BLOCK) - np.maximum(cs, ss)
    return jnp.asarray(np.maximum(ov, 0) / CMP_STRIDE, dtype=jnp.float32)


def nsa_mixer(q, kc, vc, ks, vs, kw, vw, gate_logits, pe_k, pe_v, wk1, wk2, wv1, wv2):
    B, L = q.shape[0], q.shape[1]
    dtype = q.dtype
    f32 = jnp.float32
    scale = 1.0 / math.sqrt(HEAD_DIM)
    K, G = NSA_KV_HEADS, NSA_GROUP
    qg = q.reshape(B, L, K, G, HEAD_DIM)
    t = jnp.arange(L)

    n_cmp = (L - CMP_BLOCK) // CMP_STRIDE + 1
    idx = np.arange(n_cmp)[:, None] * CMP_STRIDE + np.arange(CMP_BLOCK)[None, :]

    def compress(src, pe, w1, w2):
        blk = src[:, idx] + pe[None, None, :, None, :]
        flat = blk.transpose(0, 1, 3, 2, 4).reshape(B, n_cmp, K, CMP_BLOCK * HEAD_DIM)
        return jax.nn.gelu(flat @ w1) @ w2

    k_cmp = compress(kc, pe_k, wk1, wk2)
    v_cmp = compress(vc, pe_v, wv1, wv2)
    s_cmp = jnp.einsum('blkgd,bnkd->bkgln', qg, k_cmp).astype(f32) * scale
    blk_end = jnp.arange(n_cmp) * CMP_STRIDE + CMP_BLOCK - 1
    cmp_valid = blk_end[None, :] <= t[:, None]
    p_cmp = jax.nn.softmax(jnp.where(cmp_valid, s_cmp, NEG), axis=-1)
    p_cmp = jnp.where(cmp_valid, p_cmp, 0.0)
    o_cmp = jnp.einsum('bkgln,bnkd->blkgd', p_cmp.astype(dtype), v_cmp)

    n_sel = L // SEL_BLOCK
    topk = min(SEL_TOPK, n_sel)
    imp = jnp.einsum('bkgln,ns->bkls', p_cmp, overlap_matrix(n_cmp, n_sel))
    j = jnp.arange(n_sel)[None, :]
    cur = (t // SEL_BLOCK)[:, None]
    forced = (j == 0) | (j == cur) | (j == cur - 1)
    sel_valid = j * SEL_BLOCK <= t[:, None]
    score = jnp.where(forced, FORCE_SCORE, jnp.where(sel_valid, imp, -FORCE_SCORE))
    _, sel_idx = lax.top_k(score, topk)

    ks_blk = ks.transpose(0, 2, 1, 3).reshape(B, K, n_sel, SEL_BLOCK, HEAD_DIM)
    vs_blk = vs.transpose(0, 2, 1, 3).reshape(B, K, n_sel, SEL_BLOCK, HEAD_DIM)
    nq = L // SEL_Q_BLOCK
    q_ch = qg.reshape(B, nq, SEL_Q_BLOCK, K, G, HEAD_DIM).transpose(1, 0, 2, 3, 4, 5)
    i_ch = sel_idx.reshape(B, K, nq, SEL_Q_BLOCK, topk).transpose(2, 0, 1, 3, 4)
    t_ch = t.reshape(nq, SEL_Q_BLOCK)
    b_ix = jnp.arange(B)[:, None, None, None]
    k_ix = jnp.arange(K)[None, :, None, None]

    def sel_chunk(args):
        qc, ic, tc = args
        kg = ks_blk[b_ix, k_ix, ic]
        vg = vs_blk[b_ix, k_ix, ic]
        s = jnp.einsum('bqkgd,bkqsjd->bkgqsj', qc, kg).astype(f32) * scale
        kpos = ic[..., None] * SEL_BLOCK + jnp.arange(SEL_BLOCK)
        mask = (kpos <= tc[None, None, :, None, None])[:, :, None]
        s = jnp.where(mask, s, NEG).reshape(B, K, G, SEL_Q_BLOCK, topk * SEL_BLOCK)
        p = jax.nn.softmax(s, axis=-1).reshape(B, K, G, SEL_Q_BLOCK, topk, SEL_BLOCK)
        return jnp.einsum('bkgqsj,bkqsjd->bqkgd', p.astype(dtype), vg)

    o_sel = lax.map(sel_chunk, (q_ch, i_ch, t_ch))
    o_sel = o_sel.transpose(1, 0, 2, 3, 4, 5).reshape(B, L, K, G, HEAD_DIM)

    kw_pad = jnp.pad(kw, ((0, 0), (WINDOW, 0), (0, 0), (0, 0)))
    vw_pad = jnp.pad(vw, ((0, 0), (WINDOW, 0), (0, 0), (0, 0)))
    nwq = L // Q_BLOCK
    qw_ch = qg.reshape(B, nwq, Q_BLOCK, K, G, HEAD_DIM).transpose(1, 0, 2, 3, 4, 5)

    def win_chunk(args):
        qc, c = args
        start = c * Q_BLOCK
        kb = lax.dynamic_slice_in_dim(kw_pad, start, WINDOW + Q_BLOCK, axis=1)
        vb = lax.dynamic_slice_in_dim(vw_pad, start, WINDOW + Q_BLOCK, axis=1)
        s = jnp.einsum('bqkgd,bskd->bkgqs', qc, kb).astype(f32) * scale
        tq = start + jnp.arange(Q_BLOCK)
        sk = start - WINDOW + jnp.arange(WINDOW + Q_BLOCK)
        diff = tq[:, None] - sk[None, :]
        mask = (sk[None, :] >= 0) & (diff >= 0) & (diff < WINDOW)
        p = jax.nn.softmax(jnp.where(mask, s, NEG), axis=-1)
        return jnp.einsum('bkgqs,bskd->bqkgd', p.astype(dtype), vb)

    o_win = lax.map(win_chunk, (qw_ch, jnp.arange(nwq)))
    o_win = o_win.transpose(1, 0, 2, 3, 4, 5).reshape(B, L, K, G, HEAD_DIM)

    g = jax.nn.sigmoid(gate_logits.astype(f32)).astype(dtype).reshape(B, L, K, G, 3)
    o = g[..., 0:1] * o_cmp + g[..., 1:2] * o_sel + g[..., 2:3] * o_win
    return o.reshape(B, L, NSA_WIDTH)


def hybrid_layer(x, cos, sin, w_in, w_pool, pool_scale, ssm_lam_re, ssm_lam_im, ssm_log_dt,
                 ssm_b_re, ssm_b_im, ssm_c_re, ssm_c_im, ssm_d, w_glu, b_glu,
                 cmp_pe_k, cmp_pe_v, cmp_wk1, cmp_wk2, cmp_wv1, cmp_wv2,
                 w_up_pool, w_up_ssm, w_up_nsa, w_out, ln1_g, ln1_b, w_ff1, w_ff2, ln2_g, ln2_b):
    B, L, _ = x.shape
    proj = x @ w_in
    offs = [int(o) for o in np.cumsum(IN_SPLITS)[:-1]]
    u_pool, u_ssm, q, kv, g_nsa, g_merge = jnp.split(proj, offs, axis=-1)
    kc, vc, ks, vs, kw, vw = [a.reshape(B, L, NSA_KV_HEADS, HEAD_DIM) for a in jnp.split(kv, 6, axis=-1)]
    q = partial_rope(q.reshape(B, L, NSA_HEADS, HEAD_DIM), cos, sin)
    kc = partial_rope(kc, cos, sin)
    ks = partial_rope(ks, cos, sin)
    kw = partial_rope(kw, cos, sin)

    y_pool = pool_mixer(u_pool, w_pool, pool_scale)
    y_ssm = s5_mixer(u_ssm, ssm_lam_re, ssm_lam_im, ssm_log_dt, ssm_b_re, ssm_b_im,
                     ssm_c_re, ssm_c_im, ssm_d, w_glu, b_glu)
    y_nsa = nsa_mixer(q, kc, vc, ks, vs, kw, vw, g_nsa.reshape(B, L, NSA_HEADS, 3),
                      cmp_pe_k, cmp_pe_v, cmp_wk1, cmp_wk2, cmp_wv1, cmp_wv2)

    gates = jax.nn.sigmoid(g_merge.astype(jnp.float32)).astype(x.dtype).reshape(B, L, 3, D_MODEL)
    merged = (gates[:, :, 0] * (y_pool @ w_up_pool)
              + gates[:, :, 1] * (y_ssm @ w_up_ssm)
              + gates[:, :, 2] * (y_nsa @ w_up_nsa))
    x = layer_norm(ALPHA * x + merged @ w_out, ln1_g, ln1_b)
    h = jnp.square(jax.nn.relu(x @ w_ff1)) @ w_ff2
    return layer_norm(ALPHA * x + h, ln2_g, ln2_b)


def setup_inputs(seed: int = 0) -> dict:
    key = jax.random.key(seed)
    k = jax.random.split(key, 40)
    f32 = jnp.float32

    def nrm(kk, shape, scale):
        return jax.random.normal(kk, shape, f32) * scale

    Dp = DEPTH
    n = jnp.arange(SSM_STATE, dtype=f32)
    return {
        "x": nrm(k[0], (BATCH, SEQ, D_MODEL), 1.0),
        "ln_in_g": 1.0 + nrm(k[1], (D_MODEL,), 0.02),
        "ln_in_b": nrm(k[2], (D_MODEL,), 0.02),
        "w_in": nrm(k[3], (Dp, D_MODEL, IN_WIDTH), D_MODEL ** -0.5),
        "w_pool": nrm(k[4], (Dp, POOL_GROUPS, POOL_GROUP_CH, POOL_GROUP_CH), POOL_GROUP_CH ** -0.5),
        "pool_scale": 1.0 + nrm(k[5], (Dp, POOL_WIDTH), 0.02),
        "ssm_lam_re": -0.5 + nrm(k[6], (Dp, SSM_GROUPS, SSM_STATE), 0.01),
        "ssm_lam_im": math.pi * n + nrm(k[7], (Dp, SSM_GROUPS, SSM_STATE), 0.01),
        "ssm_log_dt": jax.random.uniform(k[8], (Dp, SSM_GROUPS), f32, math.log(1e-3), math.log(1e-1)),
        "ssm_b_re": nrm(k[9], (Dp, SSM_GROUPS, SSM_STATE, SSM_GROUP_CH), (2 * SSM_GROUP_CH) ** -0.5),
        "ssm_b_im": nrm(k[10], (Dp, SSM_GROUPS, SSM_STATE, SSM_GROUP_CH), (2 * SSM_GROUP_CH) ** -0.5),
        "ssm_c_re": nrm(k[11], (Dp, SSM_GROUPS, SSM_GROUP_CH, SSM_STATE), SSM_STATE ** -0.5),
        "ssm_c_im": nrm(k[12], (Dp, SSM_GROUPS, SSM_GROUP_CH, SSM_STATE), SSM_STATE ** -0.5),
        "ssm_d": nrm(k[13], (Dp, SSM_GROUPS, SSM_GROUP_CH), 1.0),
        "w_glu": nrm(k[14], (Dp, SSM_WIDTH, SSM_WIDTH), SSM_WIDTH ** -0.5),
        "b_glu": nrm(k[15], (Dp, SSM_WIDTH), 0.02),
        "cmp_pe_k": nrm(k[16], (Dp, CMP_BLOCK, HEAD_DIM), 0.1),
        "cmp_pe_v": nrm(k[17], (Dp, CMP_BLOCK, HEAD_DIM), 0.1),
        "cmp_wk1": nrm(k[18], (Dp, CMP_BLOCK * HEAD_DIM, CMP_HIDDEN), (CMP_BLOCK * HEAD_DIM) ** -0.5),
        "cmp_wk2": nrm(k[19], (Dp, CMP_HIDDEN, HEAD_DIM), CMP_HIDDEN ** -0.5),
        "cmp_wv1": nrm(k[20], (Dp, CMP_BLOCK * HEAD_DIM, CMP_HIDDEN), (CMP_BLOCK * HEAD_DIM) ** -0.5),
        "cmp_wv2": nrm(k[21], (Dp, CMP_HIDDEN, HEAD_DIM), CMP_HIDDEN ** -0.5),
        "w_up_pool": nrm(k[22], (Dp, POOL_WIDTH, D_MODEL), POOL_WIDTH ** -0.5),
        "w_up_ssm": nrm(k[23], (Dp, SSM_WIDTH, D_MODEL), SSM_WIDTH ** -0.5),
        "w_up_nsa": nrm(k[24], (Dp, NSA_WIDTH, D_MODEL), NSA_WIDTH ** -0.5),
        "w_out": nrm(k[25], (Dp, D_MODEL, D_MODEL), BETA * D_MODEL ** -0.5),
        "ln1_g": 1.0 + nrm(k[26], (Dp, D_MODEL), 0.02),
        "ln1_b": nrm(k[27], (Dp, D_MODEL), 0.02),
        "w_ff1": nrm(k[28], (Dp, D_MODEL, D_FF), D_MODEL ** -0.5),
        "w_ff2": nrm(k[29], (Dp, D_FF, D_MODEL), BETA * D_FF ** -0.5),
        "ln2_g": 1.0 + nrm(k[30], (Dp, D_MODEL), 0.02),
        "ln2_b": nrm(k[31], (Dp, D_MODEL), 0.02),
    }


def reference(x, ln_in_g, ln_in_b, w_in, w_pool, pool_scale, ssm_lam_re, ssm_lam_im, ssm_log_dt,
              ssm_b_re, ssm_b_im, ssm_c_re, ssm_c_im, ssm_d, w_glu, b_glu,
              cmp_pe_k, cmp_pe_v, cmp_wk1, cmp_wk2, cmp_wv1, cmp_wv2,
              w_up_pool, w_up_ssm, w_up_nsa, w_out, ln1_g, ln1_b, w_ff1, w_ff2, ln2_g, ln2_b):
    cos, sin = rope_tables(x.shape[1])
    x = layer_norm(x, ln_in_g, ln_in_b)
    for i in range(DEPTH):
        x = hybrid_layer(x, cos, sin, w_in[i], w_pool[i], pool_scale[i], ssm_lam_re[i], ssm_lam_im[i],
                         ssm_log_dt[i], ssm_b_re[i], ssm_b_im[i], ssm_c_re[i], ssm_c_im[i], ssm_d[i],
                         w_glu[i], b_glu[i], cmp_pe_k[i], cmp_pe_v[i], cmp_wk1[i], cmp_wk2[i],
                         cmp_wv1[i], cmp_wv2[i], w_up_pool[i], w_up_ssm[i], w_up_nsa[i], w_out[i],
                         ln1_g[i], ln1_b[i], w_ff1[i], w_ff2[i], ln2_g[i], ln2_b[i])
    return x
```

```cpp
#include <hip/hip_runtime.h>
#include <hip/hip_cooperative_groups.h>
namespace cg = cooperative_groups;

#ifndef MEGA
#define MEGA 0
#endif

typedef unsigned short bf16_t;
typedef short bf16x8 __attribute__((ext_vector_type(8)));
typedef float f32x4 __attribute__((ext_vector_type(4)));
typedef unsigned long long u64;

constexpr int DM = 1024, NB = 8, SEQ = 4096, DEPTH = 2;
constexpr int CHB = 4;
constexpr int NCH = NB / CHB;
constexpr int MC = CHB * SEQ;
constexpr int INW = 5400, INP = 5504;
constexpr int C_SSM = 512, C_Q = 1024, C_KV = 1536, C_GN = 2304, C_GM = 2328;
constexpr int NROW = CHB * 64;
constexpr float ALPHA = 1.4142135623730951f;
constexpr int LDS_BYTES = 57344;
constexpr int NTHR = 256;

constexpr size_t al256(size_t x) { return (x + 255) & ~(size_t)255; }
constexpr size_t O_WIN = 0;
constexpr size_t O_WPOOL = O_WIN + (size_t)INP * 1024 * 2;
constexpr size_t O_WGLU = O_WPOOL + 4 * 128 * 128 * 2;
constexpr size_t O_WUP = O_WGLU + 512 * 512 * 2;
constexpr size_t O_WOUT = O_WUP + 3 * 1024 * 512 * 2;
constexpr size_t O_WFF1 = O_WOUT + 1024 * 1024 * 2;
constexpr size_t O_WFF2 = O_WFF1 + 4096 * 1024 * 2;
constexpr size_t O_WCK1 = O_WFF2 + 4096 * 1024 * 2;
constexpr size_t O_WCV1 = O_WCK1 + 128 * 2048 * 2;
constexpr size_t O_WCK2 = O_WCV1 + 128 * 2048 * 2;
constexpr size_t O_WCV2 = O_WCK2 + 64 * 128 * 2;
constexpr size_t O_BCK1 = O_WCV2 + 64 * 128 * 2;
constexpr size_t O_BCV1 = O_BCK1 + 512;
constexpr size_t O_KMAT = O_BCV1 + 512;
constexpr size_t O_EMAT = O_KMAT + 32 * 64 * 256 * 2;
constexpr size_t O_FMAT = O_EMAT + (size_t)32 * 128 * 1024 * 2;
constexpr size_t O_A64 = O_FMAT + (size_t)32 * 1024 * 128 * 2;
constexpr size_t WL_SIZE = al256(O_A64 + 32 * 64 * 2 * 4);
constexpr size_t G_WL = 0;
constexpr size_t G_ROPE = G_WL + 2 * WL_SIZE;
constexpr size_t G_XB = al256(G_ROPE + 4096 * 16 * 4);
constexpr size_t G_PROJ = al256(G_XB + (size_t)MC * 1024 * 2);
constexpr size_t G_Y = al256(G_PROJ + (size_t)MC * INP * 2);
constexpr size_t G_ZS = al256(G_Y + (size_t)MC * 1536 * 2);
constexpr size_t G_ONSA = al256(G_ZS + (size_t)MC * 512 * 2);
constexpr size_t G_MERGED = al256(G_ONSA + (size_t)MC * 512 * 4);
constexpr size_t G_S = al256(G_MERGED + (size_t)MC * 1024 * 2);
constexpr size_t G_HIN = al256(G_S + (size_t)32 * NROW * 128 * 4);
constexpr size_t G_KCMP = al256(G_HIN + (size_t)32 * NROW * 128 * 2);
constexpr size_t G_VCMPT = al256(G_KCMP + (size_t)CHB * 2 * 256 * 64 * 2);
constexpr size_t G_H1 = al256(G_VCMPT + (size_t)CHB * 2 * 256 * 64 * 2);
constexpr size_t G_SEL = al256(G_H1 + (size_t)2 * CHB * 512 * 128 * 2);
constexpr size_t G_END = al256(G_SEL + (size_t)MC * 2 * 8);

struct Params {
  const float* in[32];
  float* out;
  unsigned char* ws;
};

__device__ __forceinline__ float bf2f(bf16_t h) { return __uint_as_float(((unsigned)h) << 16); }
__device__ __forceinline__ bf16_t f2bf(float f) {
  unsigned u = __float_as_uint(f);
  u += 0x7fffu + ((u >> 16) & 1u);
  return (bf16_t)(u >> 16);
}
__device__ __forceinline__ unsigned pack2(float a, float b) { return (unsigned)f2bf(a) | ((unsigned)f2bf(b) << 16); }
__device__ __forceinline__ uint2 pack4(f32x4 v) { uint2 r; r.x = pack2(v[0], v[1]); r.y = pack2(v[2], v[3]); return r; }
__device__ __forceinline__ f32x4 unpack4(uint2 u) {
  f32x4 r; r[0] = __uint_as_float(u.x << 16); r[1] = __uint_as_float(u.x & 0xffff0000u);
  r[2] = __uint_as_float(u.y << 16); r[3] = __uint_as_float(u.y & 0xffff0000u); return r;
}
__device__ __forceinline__ float sigmoidf_(float x) { return 1.0f / (1.0f + __expf(-x)); }
__device__ __forceinline__ float gelu_tanh(float x) {
  float u = 0.7978845608028654f * (x + 0.044715f * x * x * x);
  return x / (1.0f + __expf(-2.0f * u));
}
__device__ __forceinline__ float wave_sum(float v) {
#pragma unroll
  for (int o = 32; o >= 1; o >>= 1) v += __shfl_xor(v, o);
  return v;
}

template <class LA, class LB>
__device__ __forceinline__ void gemm_acc(unsigned char* lds, int nk, const LA& la, const LB& lb, f32x4 (&acc)[4][4]) {
  const int tid = threadIdx.x, lane = tid & 63, wid = tid >> 6, wr = wid >> 1, wc = wid & 1, fr = lane & 15, fq = lane >> 4;
  bf16_t* sA = (bf16_t*)lds;
  bf16_t* sB = sA + 128 * 72;
  const int lrow = tid >> 3, lk = (tid & 7) * 8;
  uint4 ra[4], rb[4];
#pragma unroll
  for (int i = 0; i < 4; ++i) { ra[i] = la(lrow + i * 32, lk); rb[i] = lb(lrow + i * 32, lk); }
  for (int kt = 0; kt < nk; ++kt) {
    __syncthreads();
#pragma unroll
    for (int i = 0; i < 4; ++i) {
      *(uint4*)(sA + (lrow + i * 32) * 72 + lk) = ra[i];
      *(uint4*)(sB + (lrow + i * 32) * 72 + lk) = rb[i];
    }
    __syncthreads();
    if (kt + 1 < nk) {
#pragma unroll
      for (int i = 0; i < 4; ++i) { ra[i] = la(lrow + i * 32, (kt + 1) * 64 + lk); rb[i] = lb(lrow + i * 32, (kt + 1) * 64 + lk); }
    }
#pragma unroll
    for (int ks = 0; ks < 2; ++ks) {
      bf16x8 af[4], bfr[4];
#pragma unroll
      for (int mi = 0; mi < 4; ++mi) af[mi] = *(const bf16x8*)(sA + (wr * 64 + mi * 16 + fr) * 72 + ks * 32 + fq * 8);
#pragma unroll
      for (int ni = 0; ni < 4; ++ni) bfr[ni] = *(const bf16x8*)(sB + (wc * 64 + ni * 16 + fr) * 72 + ks * 32 + fq * 8);
#pragma unroll
      for (int mi = 0; mi < 4; ++mi)
#pragma unroll
        for (int ni = 0; ni < 4; ++ni) acc[mi][ni] = __builtin_amdgcn_mfma_f32_16x16x32_bf16(bfr[ni], af[mi], acc[mi][ni], 0, 0, 0);
    }
  }
}
__device__ __forceinline__ void zero_acc(f32x4 (&acc)[4][4]) {
#pragma unroll
  for (int i = 0; i < 4; ++i)
#pragma unroll
    for (int j = 0; j < 4; ++j) acc[i][j] = (f32x4){0.f, 0.f, 0.f, 0.f};
}
template <class EP>
__device__ __forceinline__ void gemm_epi(const f32x4 (&acc)[4][4], const EP& ep) {
  const int tid = threadIdx.x, lane = tid & 63, wid = tid >> 6, wr = wid >> 1, wc = wid & 1, fr = lane & 15, fq = lane >> 4;
#pragma unroll
  for (int mi = 0; mi < 4; ++mi)
#pragma unroll
    for (int ni = 0; ni < 4; ++ni) ep(wr * 64 + mi * 16 + fr, wc * 64 + ni * 16 + fq * 4, acc[mi][ni], ni);
}

__device__ void transpose_job(unsigned char* lds, const float* src, bf16_t* dst, int K, int N, int Npad, int bid, int nblk) {
  float* sm = (float*)lds;
  const int tid = threadIdx.x;
  const int tk = K / 64, tn = Npad / 64;
  for (int t = bid; t < tk * tn; t += nblk) {
    const int k0 = (t % tk) * 64, n0 = (t / tk) * 64;
    __syncthreads();
#pragma unroll
    for (int i = 0; i < 16; ++i) {
      int r = (tid >> 6) + 4 * i, c = tid & 63;
      sm[r * 65 + c] = (n0 + c < N) ? src[(size_t)(k0 + r) * N + n0 + c] : 0.f;
    }
    __syncthreads();
#pragma unroll
    for (int i = 0; i < 16; ++i) {
      int n = (tid >> 6) + 4 * i, k = tid & 63;
      dst[(size_t)(n0 + n) * K + k0 + k] = f2bf(sm[k * 65 + n]);
    }
  }
}

__device__ __forceinline__ void sincos_red(double ang, double& s, double& c) {
  const double TWO_PI_HI = 6.283185307179586232, TWO_PI_LO = 2.4492935982947064e-16;
  double q = rint(ang * 0.15915494309189535);
  double r = fma(-q, TWO_PI_HI, ang);
  r = fma(-q, TWO_PI_LO, r);
  double x2 = r * r;
  double ss = r, term = r;
#pragma unroll 1
  for (int n = 1; n <= 14; ++n) { term *= -x2 / (double)((2 * n) * (2 * n + 1)); ss += term; }
  double cc = 1.0; term = 1.0;
#pragma unroll 1
  for (int n = 1; n <= 15; ++n) { term *= -x2 / (double)((2 * n - 1) * (2 * n)); cc += term; }
  s = ss; c = cc;
}

__device__ void phase0(const Params& p, unsigned char* lds, int bid, int nblk) {
  const int tid = threadIdx.x;
  for (int layer = 0; layer < DEPTH; ++layer) {
    unsigned char* wl = p.ws + G_WL + layer * WL_SIZE;
    transpose_job(lds, p.in[3] + (size_t)layer * 1024 * INW, (bf16_t*)(wl + O_WIN), 1024, INW, INP, bid, nblk);
    for (int g = 0; g < 4; ++g)
      transpose_job(lds, p.in[4] + (size_t)(layer * 4 + g) * 128 * 128, (bf16_t*)(wl + O_WPOOL) + g * 128 * 128, 128, 128, 128, bid, nblk);
    transpose_job(lds, p.in[14] + (size_t)layer * 512 * 512, (bf16_t*)(wl + O_WGLU), 512, 512, 512, bid, nblk);
    for (int i = 0; i < 3; ++i)
      transpose_job(lds, p.in[22 + i] + (size_t)layer * 512 * 1024, (bf16_t*)(wl + O_WUP) + (size_t)i * 1024 * 512, 512, 1024, 1024, bid, nblk);
    transpose_job(lds, p.in[25] + (size_t)layer * 1024 * 1024, (bf16_t*)(wl + O_WOUT), 1024, 1024, 1024, bid, nblk);
    transpose_job(lds, p.in[28] + (size_t)layer * 1024 * 4096, (bf16_t*)(wl + O_WFF1), 1024, 4096, 4096, bid, nblk);
    transpose_job(lds, p.in[29] + (size_t)layer * 4096 * 1024, (bf16_t*)(wl + O_WFF2), 4096, 1024, 1024, bid, nblk);
    transpose_job(lds, p.in[18] + (size_t)layer * 2048 * 128, (bf16_t*)(wl + O_WCK1), 2048, 128, 128, bid, nblk);
    transpose_job(lds, p.in[20] + (size_t)layer * 2048 * 128, (bf16_t*)(wl + O_WCV1), 2048, 128, 128, bid, nblk);
    transpose_job(lds, p.in[19] + (size_t)layer * 128 * 64, (bf16_t*)(wl + O_WCK2), 128, 64, 64, bid, nblk);
    transpose_job(lds, p.in[21] + (size_t)layer * 128 * 64, (bf16_t*)(wl + O_WCV2), 128, 64, 64, bid, nblk);
  }
  {
    float* rope = (float*)(p.ws + G_ROPE);
    for (int idx = bid * NTHR + tid; idx < 4096 * 8; idx += nblk * NTHR) {
      int pos = idx >> 3, i = idx & 7;
      float inv = (float)exp(-(double)i * 0.125 * 13.122363377404328);
      double ang = (double)((float)pos * inv);
      double s, c; sincos_red(ang, s, c);
      rope[pos * 16 + i] = (float)c; rope[pos * 16 + 8 + i] = (float)s;
    }
  }
  for (int it = bid; it < DEPTH * 2; it += nblk) {
    const int layer = it >> 1, kv = it & 1;
    const float* pe = p.in[16 + kv] + (size_t)layer * 2048;
    const float* w1 = p.in[kv ? 20 : 18] + (size_t)layer * 2048 * 128;
    float* sm = (float*)lds;
    const int j = tid & 127, half = tid >> 7;
    float acc = 0.f;
    for (int kk = half * 1024; kk < half * 1024 + 1024; ++kk) acc += pe[kk] * w1[(size_t)kk * 128 + j];
    __syncthreads();
    sm[tid] = acc;
    __syncthreads();
    if (tid < 128) ((float*)(p.ws + G_WL + layer * WL_SIZE + (kv ? O_BCV1 : O_BCK1)))[tid] = sm[tid] + sm[tid + 128];
    __syncthreads();
  }
  for (int it = bid; it < DEPTH * 32 * 65; it += nblk) {
    const int layer = it / (32 * 65), rem = it % (32 * 65), g = rem / 65, d = rem % 65;
    unsigned char* wl = p.ws + G_WL + layer * WL_SIZE;
    float* pwr = (float*)lds; float* pwi = pwr + 64; float* kr = pwi + 64; float* ki = kr + 64;
    float* bbr = ki + 64; float* bbi = bbr + 1024;
    const size_t gp = (size_t)(layer * 32 + g) * 64;
    __syncthreads();
    if (tid < 64) {
      double lr = p.in[6][gp + tid], li = p.in[7][gp + tid];
      double step = exp((double)p.in[8][layer * 32 + g]);
      double s1, c1; sincos_red(li * step, s1, c1);
      double mag = exp(lr * step);
      double abr = mag * c1, abi = mag * s1;
      double den = lr * lr + li * li;
      double nr = abr - 1.0, ni = abi;
      kr[tid] = (float)((nr * lr + ni * li) / den);
      ki[tid] = (float)((ni * lr - nr * li) / den);
      double sd, cd; sincos_red(li * step * (double)d, sd, cd);
      double md = exp(lr * step * (double)d);
      pwr[tid] = (float)(md * cd); pwi[tid] = (float)(md * sd);
    }
    __syncthreads();
    for (int idx = tid; idx < 1024; idx += NTHR) {
      int pp = idx >> 4;
      float br = p.in[9][gp * 16 + idx], bi = p.in[10][gp * 16 + idx];
      bbr[idx] = kr[pp] * br - ki[pp] * bi;
      bbi[idx] = kr[pp] * bi + ki[pp] * br;
    }
    __syncthreads();
    if (d <= 63) {
      {
        const int co = tid >> 4, ci = tid & 15;
        const float* cre = p.in[11] + ((size_t)(layer * 32 + g) * 16 + co) * 64;
        const float* cim = p.in[12] + ((size_t)(layer * 32 + g) * 16 + co) * 64;
        float val = 0.f;
        for (int pp = 0; pp < 64; ++pp) {
          float cr = cre[pp], cm = cim[pp];
          float wr_ = cr * pwr[pp] - cm * pwi[pp], wi_ = cr * pwi[pp] + cm * pwr[pp];
          val += wr_ * bbr[pp * 16 + ci] - wi_ * bbi[pp * 16 + ci];
        }
        ((bf16_t*)(wl + O_KMAT))[(((size_t)g * 64 + d) * 16 + co) * 16 + ci] = f2bf(val);
      }
      const int s = 63 - d;
      bf16_t* em = (bf16_t*)(wl + O_EMAT);
      for (int idx = tid; idx < 1024; idx += NTHR) {
        int pp = idx >> 4, ci = idx & 15;
        float re = pwr[pp] * bbr[idx] - pwi[pp] * bbi[idx], im = pwr[pp] * bbi[idx] + pwi[pp] * bbr[idx];
        em[((size_t)g * 128 + pp) * 1024 + s * 16 + ci] = f2bf(re);
        em[((size_t)g * 128 + 64 + pp) * 1024 + s * 16 + ci] = f2bf(im);
      }
    }
    if (d >= 1) {
      const int t = d - 1;
      bf16_t* fm = (bf16_t*)(wl + O_FMAT);
      for (int idx = tid; idx < 1024; idx += NTHR) {
        int co = idx >> 6, pp = idx & 63;
        float cr = p.in[11][((size_t)(layer * 32 + g) * 16 + co) * 64 + pp], cm = p.in[12][((size_t)(layer * 32 + g) * 16 + co) * 64 + pp];
        float wr_ = cr * pwr[pp] - cm * pwi[pp], wi_ = cr * pwi[pp] + cm * pwr[pp];
        fm[((size_t)g * 1024 + t * 16 + co) * 128 + pp] = f2bf(wr_);
        fm[((size_t)g * 1024 + t * 16 + co) * 128 + 64 + pp] = f2bf(-wi_);
      }
    }
    if (d == 64 && tid < 64) {
      float* a64 = (float*)(wl + O_A64);
      a64[(g * 64 + tid) * 2] = pwr[tid]; a64[(g * 64 + tid) * 2 + 1] = pwi[tid];
    }
  }
}

__device__ void ln_rows(const float* src, float* dst, bf16_t* dstb, const float* gam, const float* bet, int nrows, int bid, int nblk) {
  const int tid = threadIdx.x, lane = tid & 63, wid = tid >> 6;
  for (int row = bid * 4 + wid; row < nrows; row += nblk * 4) {
    const float4* s4 = (const float4*)(src + (size_t)row * 1024);
    float4 v[4];
    float sum = 0.f;
#pragma unroll
    for (int i = 0; i < 4; ++i) { v[i] = s4[i * 64 + lane]; sum += (v[i].x + v[i].y) + (v[i].z + v[i].w); }
    const float mean = wave_sum(sum) * (1.0f / 1024.0f);
    float sq = 0.f;
#pragma unroll
    for (int i = 0; i < 4; ++i) {
      float a = v[i].x - mean, b = v[i].y - mean, c = v[i].z - mean, d = v[i].w - mean;
      sq += (a * a + b * b) + (c * c + d * d);
    }
    const float rstd = rsqrtf(wave_sum(sq) * (1.0f / 1024.0f) + 1e-5f);
#pragma unroll
    for (int i = 0; i < 4; ++i) {
      float4 gg = ((const float4*)gam)[i * 64 + lane], bb = ((const float4*)bet)[i * 64 + lane];
      float4 o;
      o.x = (v[i].x - mean) * rstd * gg.x + bb.x; o.y = (v[i].y - mean) * rstd * gg.y + bb.y;
      o.z = (v[i].z - mean) * rstd * gg.z + bb.z; o.w = (v[i].w - mean) * rstd * gg.w + bb.w;
      ((float4*)(dst + (size_t)row * 1024))[i * 64 + lane] = o;
      uint2 pk; pk.x = pack2(o.x, o.y); pk.y = pack2(o.z, o.w);
      ((uint2*)(dstb + (size_t)row * 1024))[i * 64 + lane] = pk;
    }
  }
}

__device__ void phase_proj(const Params& p, unsigned char* lds, int layer, int bid, int nblk) {
  const bf16_t* A = (const bf16_t*)(p.ws + G_XB);
  const bf16_t* Bt = (const bf16_t*)(p.ws + G_WL + layer * WL_SIZE + O_WIN);
  bf16_t* PROJ = (bf16_t*)(p.ws + G_PROJ);
  const float* rope = (const float*)(p.ws + G_ROPE);
  const int wid = threadIdx.x >> 6, lane = threadIdx.x & 63, fq = lane >> 4;
  constexpr int NT = INP / 128, MT = MC / 128;
  for (int t = bid; t < NT * MT; t += nblk) {
    const int nt = t % NT, mt = t / NT;
    const int m0 = mt * 128, n0 = nt * 128;
    f32x4 acc[4][4]; zero_acc(acc);
    auto la = [=](int r, int kk) -> uint4 { return *(const uint4*)(A + (size_t)(m0 + r) * 1024 + kk); };
    auto lb = [=](int n, int kk) -> uint4 { return *(const uint4*)(Bt + (size_t)(n0 + n) * 1024 + kk); };
    gemm_acc(lds, 16, la, lb, acc);
    const int cb = n0 + (wid & 1) * 64;
    const int jg = (cb - C_Q) >> 6;
    const bool roped = (cb >= C_Q) && (cb < C_GN) && (jg < 8 || (((jg - 8) & 2) == 0));
    const bool isq = (cb >= C_Q) && (cb < C_KV);
    const bool isgate = cb >= C_GN;
    gemm_epi(acc, [=](int r, int c, f32x4 v, int ni) {
      const int row = m0 + r, col = n0 + c;
      if (isgate) {
#pragma unroll
        for (int e = 0; e < 4; ++e) v[e] = sigmoidf_(v[e]);
      } else if (roped) {
        if (ni == 0) {
          const int pos = row & (SEQ - 1);
          const float4 cs = *(const float4*)(rope + pos * 16 + (fq & 1) * 4);
          const float4 sn = *(const float4*)(rope + pos * 16 + 8 + (fq & 1) * 4);
          const float csv[4] = {cs.x, cs.y, cs.z, cs.w}, snv[4] = {sn.x, sn.y, sn.z, sn.w};
#pragma unroll
          for (int e = 0; e < 4; ++e) {
            float pv = __shfl_xor(v[e], 32);
            v[e] = (fq < 2) ? (v[e] * csv[e] - pv * snv[e]) : (pv * snv[e] + v[e] * csv[e]);
          }
        }
      }
      if (isq) {
#pragma unroll
        for (int e = 0; e < 4; ++e) v[e] *= 0.125f;
      }
      *(uint2*)(PROJ + (size_t)row * INP + col) = pack4(v);
    });
  }
}

__device__ void phase2(const Params& p, unsigned char* lds, int layer, int bid, int nblk) {
  unsigned char* wl = p.ws + G_WL + layer * WL_SIZE;
  const bf16_t* PROJ = (const bf16_t*)(p.ws + G_PROJ);
  constexpr int T_CMP = 32, T_S5 = 64, T_POOL = (MC / 128) * 4;
  for (int t = bid; t < T_CMP + T_S5 + T_POOL; t += nblk) {
    f32x4 acc[4][4]; zero_acc(acc);
    if (t < T_CMP) {
      const int kv = t & 1, mt = t >> 1, m0 = mt * 128;
      const bf16_t* Bt = (const bf16_t*)(wl + (kv ? O_WCV1 : O_WCK1));
      const float* bias = (const float*)(wl + (kv ? O_BCV1 : O_BCK1));
      bf16_t* H1 = (bf16_t*)(p.ws + G_H1) + (size_t)kv * CHB * 512 * 128;
      const int col0 = C_KV + kv * 128;
      auto la = [=](int r, int kk) -> uint4 {
        const int row = m0 + r;
        int n = row & 255; if (n > 254) n = 254;
        const int k = (row >> 8) & 1, bl = row >> 9;
        return *(const uint4*)(PROJ + ((size_t)bl * SEQ + 16 * n + (kk >> 6)) * INP + col0 + k * 64 + (kk & 63));
      };
      auto lb = [=](int n, int kk) -> uint4 { return *(const uint4*)(Bt + (size_t)n * 2048 + kk); };
      gemm_acc(lds, 32, la, lb, acc);
      gemm_epi(acc, [=](int r, int c, f32x4 v, int) {
        const float4 b4 = *(const float4*)(bias + c);
        v[0] = gelu_tanh(v[0] + b4.x); v[1] = gelu_tanh(v[1] + b4.y); v[2] = gelu_tanh(v[2] + b4.z); v[3] = gelu_tanh(v[3] + b4.w);
        *(uint2*)(H1 + (size_t)(m0 + r) * 128 + c) = pack4(v);
      });
    } else if (t < T_CMP + T_S5) {
      const int tt = t - T_CMP, g = tt >> 1, m0 = (tt & 1) * 128;
      const bf16_t* Bt = (const bf16_t*)(wl + O_EMAT) + (size_t)g * 128 * 1024;
      float* S = (float*)(p.ws + G_S);
      auto la = [=](int r, int kk) -> uint4 {
        return *(const uint4*)(PROJ + ((size_t)(m0 + r) * 64 + (kk >> 4)) * INP + C_SSM + g * 16 + (kk & 15));
      };
      auto lb = [=](int n, int kk) -> uint4 { return *(const uint4*)(Bt + (size_t)n * 1024 + kk); };
      gemm_acc(lds, 16, la, lb, acc);
      gemm_epi(acc, [=](int r, int c, f32x4 v, int) {
        *(float4*)(S + ((size_t)g * NROW + m0 + r) * 128 + c) = make_float4(v[0], v[1], v[2], v[3]);
      });
    } else {
      const int tt = t - T_CMP - T_S5, g = tt & 3, m0 = (tt >> 2) * 128;
      const bf16_t* Bt = (const bf16_t*)(wl + O_WPOOL) + g * 128 * 128;
      const float* pscale = p.in[5] + (size_t)layer * 512 + g * 128;
      bf16_t* Y = (bf16_t*)(p.ws + G_Y);
      const int w = 2 << g;
      auto la = [=](int r, int kk) -> uint4 {
        const int row = m0 + r, tpos = row & (SEQ - 1);
        const int cnt = (tpos + 1 < w) ? (tpos + 1) : w;
        const bf16_t* base = PROJ + (size_t)row * INP + g * 128 + kk;
        float sum[8];
        const uint4 u0 = *(const uint4*)base;
        float uf[8];
        uf[0] = __uint_as_float(u0.x << 16); uf[1] = __uint_as_float(u0.x & 0xffff0000u);
        uf[2] = __uint_as_float(u0.y << 16); uf[3] = __uint_as_float(u0.y & 0xffff0000u);
        uf[4] = __uint_as_float(u0.z << 16); uf[5] = __uint_as_float(u0.z & 0xffff0000u);
        uf[6] = __uint_as_float(u0.w << 16); uf[7] = __uint_as_float(u0.w & 0xffff0000u);
#pragma unroll
        for (int e = 0; e < 8; ++e) sum[e] = uf[e];
        for (int j = 1; j < cnt; ++j) {
          const uint4 u = *(const uint4*)(base - (size_t)j * INP);
          sum[0] += __uint_as_float(u.x << 16); sum[1] += __uint_as_float(u.x & 0xffff0000u);
          sum[2] += __uint_as_float(u.y << 16); sum[3] += __uint_as_float(u.y & 0xffff0000u);
          sum[4] += __uint_as_float(u.z << 16); sum[5] += __uint_as_float(u.z & 0xffff0000u);
          sum[6] += __uint_as_float(u.w << 16); sum[7] += __uint_as_float(u.w & 0xffff0000u);
        }
        const float ic = 1.0f / (float)cnt;
        uint4 o;
        o.x = pack2(sum[0] * ic - uf[0], sum[1] * ic - uf[1]); o.y = pack2(sum[2] * ic - uf[2], sum[3] * ic - uf[3]);
        o.z = pack2(sum[4] * ic - uf[4], sum[5] * ic - uf[5]); o.w = pack2(sum[6] * ic - uf[6], sum[7] * ic - uf[7]);
        return o;
      };
      auto lb = [=](int n, int kk) -> uint4 { return *(const uint4*)(Bt + (size_t)n * 128 + kk); };
      gemm_acc(lds, 2, la, lb, acc);
      gemm_epi(acc, [=](int r, int c, f32x4 v, int) {
        const float4 s4 = *(const float4*)(pscale + c);
        v[0] *= s4.x; v[1] *= s4.y; v[2] *= s4.z; v[3] *= s4.w;
        *(uint2*)(Y + (size_t)(m0 + r) * 1536 + g * 128 + c) = pack4(v);
      });
    }
  }
}

__device__ void phase3(const Params& p, unsigned char* lds, int layer, int bid, int nblk) {
  unsigned char* wl = p.ws + G_WL + layer * WL_SIZE;
  constexpr int T_CMP = 32, T_SCAN = 32 * CHB * 64 / NTHR;
  for (int t = bid; t < T_CMP + T_SCAN; t += nblk) {
    if (t < T_CMP) {
      const int kv = t & 1, m0 = (t >> 1) * 128;
      const bf16_t* A = (const bf16_t*)(p.ws + G_H1) + (size_t)kv * CHB * 512 * 128;
      const bf16_t* Bt = (const bf16_t*)(wl + (kv ? O_WCV2 : O_WCK2));
      bf16_t* KC = (bf16_t*)(p.ws + G_KCMP);
      bf16_t* VT = (bf16_t*)(p.ws + G_VCMPT);
      f32x4 acc[4][4]; zero_acc(acc);
      auto la = [=](int r, int kk) -> uint4 { return *(const uint4*)(A + (size_t)(m0 + r) * 128 + kk); };
      auto lb = [=](int n, int kk) -> uint4 { return *(const uint4*)(Bt + (size_t)(n & 63) * 128 + kk); };
      gemm_acc(lds, 2, la, lb, acc);
      gemm_epi(acc, [=](int r, int c, f32x4 v, int) {
        if (c < 64) {
          const int row = m0 + r;
          if (kv == 0) {
            *(uint2*)(KC + (size_t)row * 64 + c) = pack4(v);
          } else {
            const int bk = row >> 8, n = row & 255;
#pragma unroll
            for (int e = 0; e < 4; ++e) VT[((size_t)bk * 64 + c + e) * 256 + n] = f2bf(v[e]);
          }
        }
      });
    } else {
      const int idx = (t - T_CMP) * NTHR + threadIdx.x;
      const int pp = idx & 63, bl = (idx >> 6) % CHB, g = idx / (64 * CHB);
      const float* a64 = (const float*)(wl + O_A64);
      const float ar = a64[(g * 64 + pp) * 2], ai = a64[(g * 64 + pp) * 2 + 1];
      const float* S = (const float*)(p.ws + G_S) + ((size_t)g * NROW + bl * 64) * 128;
      bf16_t* HIN = (bf16_t*)(p.ws + G_HIN) + ((size_t)g * NROW + bl * 64) * 128;
      float hr = 0.f, hi = 0.f;
      for (int c = 0; c < 64; ++c) {
        HIN[c * 128 + pp] = f2bf(hr); HIN[c * 128 + 64 + pp] = f2bf(hi);
        const float sr = S[c * 128 + pp], si = S[c * 128 + 64 + pp];
        const float nr = ar * hr - ai * hi + sr, ni = ar * hi + ai * hr + si;
        hr = nr; hi = ni;
      }
    }
  }
}

__device__ void cmp_attn_item(const Params& p, unsigned char* lds, int item) {
  const int tid = threadIdx.x, lane = tid & 63, g = tid >> 6, fr = lane & 15, fq = lane >> 4;
  const int tg = item & 255, k = (item >> 8) & 1, bl = item >> 9;
  const bf16_t* PROJ = (const bf16_t*)(p.ws + G_PROJ);
  const bf16_t* KC = (const bf16_t*)(p.ws + G_KCMP) + (size_t)(bl * 2 + k) * 256 * 64;
  const bf16_t* VT = (const bf16_t*)(p.ws + G_VCMPT) + (size_t)(bl * 2 + k) * 64 * 256;
  float* ONSA = (float*)(p.ws + G_ONSA);
  u64* SEL = (u64*)(p.ws + G_SEL);
  bf16_t* sP = (bf16_t*)lds + g * 16 * 264;
  float* simp = (float*)(lds + 4 * 16 * 264 * 2);
  const int h = k * 4 + g, t0 = tg * 16;
  const size_t tok = (size_t)bl * SEQ + t0 + fr;
  const int nvr = (tg == 0) ? 0 : ((fr == 15) ? tg : tg - 1);
  bf16x8 qf[2];
#pragma unroll
  for (int ks = 0; ks < 2; ++ks) qf[ks] = *(const bf16x8*)(PROJ + tok * INP + C_Q + h * 64 + ks * 32 + fq * 8);
  f32x4 s[16];
#pragma unroll
  for (int ni = 0; ni < 16; ++ni) {
    s[ni] = (f32x4){0.f, 0.f, 0.f, 0.f};
    if (ni * 16 < tg) {
#pragma unroll
      for (int ks = 0; ks < 2; ++ks) {
        const bf16x8 kf = *(const bf16x8*)(KC + (size_t)(ni * 16 + fr) * 64 + ks * 32 + fq * 8);
        s[ni] = __builtin_amdgcn_mfma_f32_16x16x32_bf16(kf, qf[ks], s[ni], 0, 0, 0);
      }
    }
  }
  float rmax = -1e30f;
#pragma unroll
  for (int ni = 0; ni < 16; ++ni)
#pragma unroll
    for (int e = 0; e < 4; ++e) {
      const int n = ni * 16 + fq * 4 + e;
      if (n < nvr) rmax = fmaxf(rmax, s[ni][e]);
    }
  rmax = fmaxf(rmax, __shfl_xor(rmax, 16)); rmax = fmaxf(rmax, __shfl_xor(rmax, 32));
  float rsum = 0.f;
#pragma unroll
  for (int ni = 0; ni < 16; ++ni)
#pragma unroll
    for (int e = 0; e < 4; ++e) {
      const int n = ni * 16 + fq * 4 + e;
      const float pv = (n < nvr) ? __expf(s[ni][e] - rmax) : 0.f;
      s[ni][e] = pv; rsum += pv;
    }
  rsum += __shfl_xor(rsum, 16); rsum += __shfl_xor(rsum, 32);
  const float inv = (rsum > 0.f) ? 1.0f / rsum : 0.f;
  __syncthreads();
  const int src = (lane + 48) & 63;
#pragma unroll
  for (int ni = 0; ni < 16; ++ni) {
#pragma unroll
    for (int e = 0; e < 4; ++e) s[ni][e] *= inv;
    *(uint2*)(sP + fr * 264 + ni * 16 + fq * 4) = pack4(s[ni]);
    const float a = __shfl(s[ni][3], src);
    const float b = (ni > 0) ? __shfl(s[ni > 0 ? ni - 1 : 0][3], src) : 0.f;
    const float prev = (fq > 0) ? a : b;
    simp[(g * 16 + fr) * 64 + ni * 4 + fq] = 2.0f * (s[ni][0] + s[ni][1] + s[ni][2]) + s[ni][3] + prev;
  }
  __syncthreads();
  f32x4 o[4];
#pragma unroll
  for (int nd = 0; nd < 4; ++nd) o[nd] = (f32x4){0.f, 0.f, 0.f, 0.f};
  for (int ks = 0; ks * 32 < tg; ++ks) {
    const bf16x8 pf = *(const bf16x8*)(sP + fr * 264 + ks * 32 + fq * 8);
#pragma unroll
    for (int nd = 0; nd < 4; ++nd) {
      const bf16x8 vf = *(const bf16x8*)(VT + (size_t)(nd * 16 + fr) * 256 + ks * 32 + fq * 8);
      o[nd] = __builtin_amdgcn_mfma_f32_16x16x32_bf16(vf, pf, o[nd], 0, 0, 0);
    }
  }
  const float gt = bf2f(PROJ[tok * INP + C_GN + h * 3 + 0]);
#pragma unroll
  for (int nd = 0; nd < 4; ++nd)
    *(float4*)(ONSA + tok * 512 + h * 64 + nd * 16 + fq * 4) = make_float4(gt * o[nd][0], gt * o[nd][1], gt * o[nd][2], gt * o[nd][3]);
#pragma unroll 1
  for (int i = 0; i < 4; ++i) {
    const int r = g * 4 + i, t = t0 + r, cur = t >> 6, sb = lane;
    const float imp = simp[(0 * 16 + r) * 64 + sb] + simp[(1 * 16 + r) * 64 + sb] + simp[(2 * 16 + r) * 64 + sb] + simp[(3 * 16 + r) * 64 + sb];
    const bool forced = (sb == 0) || (sb == cur) || (sb == cur - 1);
    const float score = forced ? 1e6f : ((sb <= cur) ? imp : -1e6f);
    int rank = 0;
    for (int j = 0; j < 64; ++j) {
      const float sj = __shfl(score, j);
      rank += (sj > score || (sj == score && j < sb)) ? 1 : 0;
    }
    const u64 m = __ballot(rank < 16);
    if (lane == 0) SEL[((size_t)bl * SEQ + t) * 2 + k] = m;
  }
}

__device__ void phase4(const Params& p, unsigned char* lds, int layer, int bid, int nblk) {
  unsigned char* wl = p.ws + G_WL + layer * WL_SIZE;
  const bf16_t* PROJ = (const bf16_t*)(p.ws + G_PROJ);
  constexpr int T_S5 = 32 * 2 * 8, T_CMP = CHB * 2 * 256;
  for (int t = bid; t < T_S5 + T_CMP; t += nblk) {
    if (t < T_S5) {
      const int nt = 7 - (t & 7), mt = (t >> 3) & 1, g = t >> 4;
      const int m0 = mt * 128, n0 = nt * 128, nk1 = 2 * nt + 2;
      const bf16_t* HIN = (const bf16_t*)(p.ws + G_HIN) + (size_t)g * NROW * 128;
      const bf16_t* KM = (const bf16_t*)(wl + O_KMAT) + (size_t)g * 64 * 256;
      const bf16_t* FM = (const bf16_t*)(wl + O_FMAT) + (size_t)g * 1024 * 128;
      const float* dsk = p.in[13] + (size_t)(layer * 32 + g) * 16;
      bf16_t* ZS = (bf16_t*)(p.ws + G_ZS);
      f32x4 acc[4][4]; zero_acc(acc);
      auto la = [=](int r, int kk) -> uint4 {
        const int k2 = (kk >= nk1 * 64) ? (kk - nk1 * 64 + 1024) : kk;
        if (k2 < 1024) return *(const uint4*)(PROJ + ((size_t)(m0 + r) * 64 + (k2 >> 4)) * INP + C_SSM + g * 16 + (k2 & 15));
        return *(const uint4*)(HIN + (size_t)(m0 + r) * 128 + (k2 - 1024));
      };
      auto lb = [=](int n, int kk) -> uint4 {
        const int k2 = (kk >= nk1 * 64) ? (kk - nk1 * 64 + 1024) : kk;
        const int nn = n0 + n, tt = nn >> 4, co = nn & 15;
        if (k2 < 1024) {
          const int s = k2 >> 4;
          if (s > tt) return make_uint4(0, 0, 0, 0);
          return *(const uint4*)(KM + ((size_t)(tt - s) * 16 + co) * 16 + (k2 & 15));
        }
        return *(const uint4*)(FM + (size_t)nn * 128 + (k2 - 1024));
      };
      gemm_acc(lds, nk1 + 2, la, lb, acc);
      gemm_epi(acc, [=](int r, int c, f32x4 v, int) {
        const int nn = n0 + c, tt = nn >> 4, co = nn & 15;
        const size_t tok = (size_t)(m0 + r) * 64 + tt;
        const f32x4 u = unpack4(*(const uint2*)(PROJ + tok * INP + C_SSM + g * 16 + co));
        const float4 d4 = *(const float4*)(dsk + co);
        v[0] = gelu_tanh(v[0] + d4.x * u[0]); v[1] = gelu_tanh(v[1] + d4.y * u[1]);
        v[2] = gelu_tanh(v[2] + d4.z * u[2]); v[3] = gelu_tanh(v[3] + d4.w * u[3]);
        *(uint2*)(ZS + tok * 512 + g * 16 + co) = pack4(v);
      });
    } else {
      cmp_attn_item(p, lds, t - T_S5);
    }
  }
}

__device__ void attn_item(const Params& p, unsigned char* lds, int item) {
  const int tid = threadIdx.x, lane = tid & 63, g = tid >> 6, fr = lane & 15, fq = lane >> 4;
  const int qb = 63 - (item >> 3), k = item & 1, bl = (item >> 1) & 3;
  const bf16_t* PROJ = (const bf16_t*)(p.ws + G_PROJ);
  float* ONSA = (float*)(p.ws + G_ONSA);
  bf16_t* Y = (bf16_t*)(p.ws + G_Y);
  const u64* SEL = (const u64*)(p.ws + G_SEL);
  bf16_t* sK = (bf16_t*)lds;
  bf16_t* sVt = sK + 64 * 72;
  bf16_t* sP = sVt + 64 * 72 + g * 64 * 72;
  const int h = k * 4 + g, t0 = qb * 64;
  const size_t tokb = (size_t)bl * SEQ;
  bf16x8 qf[4][2];
#pragma unroll
  for (int mi = 0; mi < 4; ++mi)
#pragma unroll
    for (int ks = 0; ks < 2; ++ks) qf[mi][ks] = *(const bf16x8*)(PROJ + (tokb + t0 + mi * 16 + fr) * INP + C_Q + h * 64 + ks * 32 + fq * 8);
  u64 mrow[4];
#pragma unroll
  for (int mi = 0; mi < 4; ++mi) mrow[mi] = SEL[(tokb + t0 + mi * 16 + fr) * 2 + k];
  u64 um;
  {
    const u64 mm = SEL[(tokb + t0 + lane) * 2 + k];
    unsigned lo = (unsigned)mm, hi = (unsigned)(mm >> 32);
#pragma unroll
    for (int o = 32; o >= 1; o >>= 1) { lo |= __shfl_xor(lo, o); hi |= __shfl_xor(hi, o); }
    lo = __builtin_amdgcn_readfirstlane(lo); hi = __builtin_amdgcn_readfirstlane(hi);
    um = ((u64)hi << 32) | lo;
    if (qb < 63) um &= ((1ull << (qb + 1)) - 1ull);
  }
#pragma unroll 1
  for (int pass = 0; pass < 2; ++pass) {
    const int kcol = C_KV + (pass == 0 ? 512 : 256) + k * 64, vcol = kcol + 128;
    u64 blk;
    if (pass == 0) {
      const int lo = (qb - 8 > 0) ? qb - 8 : 0;
      blk = ((qb == 63) ? ~0ull : ((1ull << (qb + 1)) - 1ull)) & ~((1ull << lo) - 1ull);
    } else blk = um;
    f32x4 o[4][4];
#pragma unroll
    for (int i = 0; i < 4; ++i)
#pragma unroll
      for (int j = 0; j < 4; ++j) o[i][j] = (f32x4){0.f, 0.f, 0.f, 0.f};
    float mst[4] = {-1e30f, -1e30f, -1e30f, -1e30f}, lst[4] = {0.f, 0.f, 0.f, 0.f};
    while (blk) {
      const int j = 63 - __builtin_clzll(blk);
      blk &= ~(1ull << j);
      __syncthreads();
#pragma unroll
      for (int i = 0; i < 2; ++i) {
        const int idx = tid + i * 256, row = idx >> 3, c8 = (idx & 7) * 8;
        const bf16_t* src = PROJ + (tokb + j * 64 + row) * INP;
        *(uint4*)(sK + row * 72 + c8) = *(const uint4*)(src + kcol + c8);
        const uint4 vv = *(const uint4*)(src + vcol + c8);
        const unsigned w[4] = {vv.x, vv.y, vv.z, vv.w};
#pragma unroll
        for (int e = 0; e < 4; ++e) {
          sVt[(c8 + 2 * e) * 72 + row] = (bf16_t)(w[e] & 0xffffu);
          sVt[(c8 + 2 * e + 1) * 72 + row] = (bf16_t)(w[e] >> 16);
        }
      }
      __syncthreads();
#pragma unroll
      for (int mi = 0; mi < 4; ++mi) {
        f32x4 s[4];
#pragma unroll
        for (int ni = 0; ni < 4; ++ni) s[ni] = (f32x4){0.f, 0.f, 0.f, 0.f};
#pragma unroll
        for (int ks = 0; ks < 2; ++ks)
#pragma unroll
          for (int ni = 0; ni < 4; ++ni) {
            const bf16x8 kf = *(const bf16x8*)(sK + (ni * 16 + fr) * 72 + ks * 32 + fq * 8);
            s[ni] = __builtin_amdgcn_mfma_f32_16x16x32_bf16(kf, qf[mi][ks], s[ni], 0, 0, 0);
          }
        const int t = t0 + mi * 16 + fr;
        const bool rowsel = (pass == 0) || ((mrow[mi] >> j) & 1ull);
        float rmax = -1e30f;
#pragma unroll
        for (int ni = 0; ni < 4; ++ni)
#pragma unroll
          for (int e = 0; e < 4; ++e) {
            const int key = j * 64 + ni * 16 + fq * 4 + e;
            bool valid = rowsel && (key <= t);
            if (pass == 0) valid = valid && (key + 512 > t);
            const float v = valid ? s[ni][e] : -1e30f;
            s[ni][e] = v; rmax = fmaxf(rmax, v);
          }
        rmax = fmaxf(rmax, __shfl_xor(rmax, 16)); rmax = fmaxf(rmax, __shfl_xor(rmax, 32));
        const float mnew = fmaxf(mst[mi], rmax);
        const float alpha = __expf(mst[mi] - mnew);
        mst[mi] = mnew;
        float rsum = 0.f;
#pragma unroll
        for (int ni = 0; ni < 4; ++ni) {
#pragma unroll
          for (int e = 0; e < 4; ++e) { const float pv = __expf(s[ni][e] - mnew); s[ni][e] = pv; rsum += pv; }
          *(uint2*)(sP + (mi * 16 + fr) * 72 + ni * 16 + fq * 4) = pack4(s[ni]);
        }
        rsum += __shfl_xor(rsum, 16); rsum += __shfl_xor(rsum, 32);
        lst[mi] = lst[mi] * alpha + rsum;
#pragma unroll
        for (int nd = 0; nd < 4; ++nd)
#pragma unroll
          for (int e = 0; e < 4; ++e) o[mi][nd][e] *= alpha;
      }
      __syncthreads();
#pragma unroll
      for (int ks = 0; ks < 2; ++ks) {
        bf16x8 vf[4], pf[4];
#pragma unroll
        for (int nd = 0; nd < 4; ++nd) vf[nd] = *(const bf16x8*)(sVt + (nd * 16 + fr) * 72 + ks * 32 + fq * 8);
#pragma unroll
        for (int mi = 0; mi < 4; ++mi) pf[mi] = *(const bf16x8*)(sP + (mi * 16 + fr) * 72 + ks * 32 + fq * 8);
#pragma unroll
        for (int mi = 0; mi < 4; ++mi)
#pragma unroll
          for (int nd = 0; nd < 4; ++nd) o[mi][nd] = __builtin_amdgcn_mfma_f32_16x16x32_bf16(vf[nd], pf[mi], o[mi][nd], 0, 0, 0);
      }
    }
#pragma unroll
    for (int mi = 0; mi < 4; ++mi) {
      const size_t tok = tokb + t0 + mi * 16 + fr;
      const float gt = bf2f(PROJ[tok * INP + C_GN + h * 3 + (pass == 0 ? 2 : 1)]) / lst[mi];
#pragma unroll
      for (int nd = 0; nd < 4; ++nd) {
        float4* op = (float4*)(ONSA + tok * 512 + h * 64 + nd * 16 + fq * 4);
        float4 prev = *op;
        f32x4 r;
        r[0] = prev.x + gt * o[mi][nd][0]; r[1] = prev.y + gt * o[mi][nd][1];
        r[2] = prev.z + gt * o[mi][nd][2]; r[3] = prev.w + gt * o[mi][nd][3];
        if (pass == 0) *op = make_float4(r[0], r[1], r[2], r[3]);
        else *(uint2*)(Y + tok * 1536 + 1024 + h * 64 + nd * 16 + fq * 4) = pack4(r);
      }
    }
  }
}

__device__ void phase5(const Params& p, unsigned char* lds, int layer, int bid, int nblk) {
  unsigned char* wl = p.ws + G_WL + layer * WL_SIZE;
  constexpr int T_ATT = CHB * 2 * 64, T_GLU = (MC / 128) * 4;
  for (int t = bid; t < T_ATT + T_GLU; t += nblk) {
    if (t < T_ATT) {
      attn_item(p, lds, t);
    } else {
      const int tt = t - T_ATT, nt = tt & 3, m0 = (tt >> 2) * 128, n0 = nt * 128;
      const bf16_t* ZS = (const bf16_t*)(p.ws + G_ZS);
      const bf16_t* Bt = (const bf16_t*)(wl + O_WGLU);
      const float* bg = p.in[15] + (size_t)layer * 512;
      bf16_t* Y = (bf16_t*)(p.ws + G_Y);
      f32x4 acc[4][4]; zero_acc(acc);
      auto la = [=](int r, int kk) -> uint4 { return *(const uint4*)(ZS + (size_t)(m0 + r) * 512 + kk); };
      auto lb = [=](int n, int kk) -> uint4 { return *(const uint4*)(Bt + (size_t)(n0 + n) * 512 + kk); };
      gemm_acc(lds, 8, la, lb, acc);
      gemm_epi(acc, [=](int r, int c, f32x4 v, int) {
        const float4 b4 = *(const float4*)(bg + n0 + c);
        const f32x4 z = unpack4(*(const uint2*)(ZS + (size_t)(m0 + r) * 512 + n0 + c));
        v[0] = z[0] * sigmoidf_(v[0] + b4.x); v[1] = z[1] * sigmoidf_(v[1] + b4.y);
        v[2] = z[2] * sigmoidf_(v[2] + b4.z); v[3] = z[3] * sigmoidf_(v[3] + b4.w);
        *(uint2*)(Y + (size_t)(m0 + r) * 1536 + 512 + n0 + c) = pack4(v);
      });
    }
  }
}

__device__ void phase6(const Params& p, unsigned char* lds, int layer, int bid, int nblk) {
  unsigned char* wl = p.ws + G_WL + layer * WL_SIZE;
  const bf16_t* Y = (const bf16_t*)(p.ws + G_Y);
  const bf16_t* PROJ = (const bf16_t*)(p.ws + G_PROJ);
  bf16_t* MG = (bf16_t*)(p.ws + G_MERGED);
  const int tid = threadIdx.x, lane = tid & 63, wid = tid >> 6, wr = wid >> 1, wc = wid & 1, fr = lane & 15, fq = lane >> 4;
  constexpr int NT = 8, MT = MC / 128;
  for (int t = bid; t < NT * MT; t += nblk) {
    const int nt = t % NT, m0 = (t / NT) * 128, n0 = nt * 128;
    f32x4 tot[4][4]; zero_acc(tot);
#pragma unroll 1
    for (int i = 0; i < 3; ++i) {
      const bf16_t* Bt = (const bf16_t*)(wl + O_WUP) + (size_t)i * 1024 * 512;
      f32x4 acc[4][4]; zero_acc(acc);
      auto la = [=](int r, int kk) -> uint4 { return *(const uint4*)(Y + (size_t)(m0 + r) * 1536 + i * 512 + kk); };
      auto lb = [=](int n, int kk) -> uint4 { return *(const uint4*)(Bt + (size_t)(n0 + n) * 512 + kk); };
      gemm_acc(lds, 8, la, lb, acc);
#pragma unroll
      for (int mi = 0; mi < 4; ++mi)
#pragma unroll
        for (int ni = 0; ni < 4; ++ni) {
          const int row = m0 + wr * 64 + mi * 16 + fr, col = n0 + wc * 64 + ni * 16 + fq * 4;
          const f32x4 gt = unpack4(*(const uint2*)(PROJ + (size_t)row * INP + C_GM + i * 1024 + col));
#pragma unroll
          for (int e = 0; e < 4; ++e) tot[mi][ni][e] += gt[e] * acc[mi][ni][e];
        }
    }
    gemm_epi(tot, [=](int r, int c, f32x4 v, int) { *(uint2*)(MG + (size_t)(m0 + r) * 1024 + n0 + c) = pack4(v); });
  }
}

template <int K>
__device__ void phase_resid(const Params& p, unsigned char* lds, const bf16_t* A, const bf16_t* Bt, float* X, int bid, int nblk) {
  constexpr int NT = 8, MT = MC / 128;
  for (int t = bid; t < NT * MT; t += nblk) {
    const int nt = t % NT, m0 = (t / NT) * 128, n0 = nt * 128;
    f32x4 acc[4][4]; zero_acc(acc);
    auto la = [=](int r, int kk) -> uint4 { return *(const uint4*)(A + (size_t)(m0 + r) * K + kk); };
    auto lb = [=](int n, int kk) -> uint4 { return *(const uint4*)(Bt + (size_t)(n0 + n) * K + kk); };
    gemm_acc(lds, K / 64, la, lb, acc);
    gemm_epi(acc, [=](int r, int c, f32x4 v, int) {
      float4* xp = (float4*)(X + (size_t)(m0 + r) * 1024 + n0 + c);
      const float4 x = *xp;
      *xp = make_float4(ALPHA * x.x + v[0], ALPHA * x.y + v[1], ALPHA * x.z + v[2], ALPHA * x.w + v[3]);
    });
  }
}

__device__ void phase_ff1(const Params& p, unsigned char* lds, int layer, int bid, int nblk) {
  const bf16_t* A = (const bf16_t*)(p.ws + G_XB);
  const bf16_t* Bt = (const bf16_t*)(p.ws + G_WL + layer * WL_SIZE + O_WFF1);
  bf16_t* H = (bf16_t*)(p.ws + G_PROJ);
  constexpr int NT = 32, MT = MC / 128;
  for (int t = bid; t < NT * MT; t += nblk) {
    const int nt = t % NT, m0 = (t / NT) * 128, n0 = nt * 128;
    f32x4 acc[4][4]; zero_acc(acc);
    auto la = [=](int r, int kk) -> uint4 { return *(const uint4*)(A + (size_t)(m0 + r) * 1024 + kk); };
    auto lb = [=](int n, int kk) -> uint4 { return *(const uint4*)(Bt + (size_t)(n0 + n) * 1024 + kk); };
    gemm_acc(lds, 16, la, lb, acc);
    gemm_epi(acc, [=](int r, int c, f32x4 v, int) {
#pragma unroll
      for (int e = 0; e < 4; ++e) { const float x = fmaxf(v[e], 0.f); v[e] = x * x; }
      *(uint2*)(H + (size_t)(m0 + r) * 4096 + n0 + c) = pack4(v);
    });
  }
}

__device__ void run_phase(const Params& p, unsigned char* lds, int ph, int layer, int chunk, int bid, int nblk) {
  float* X = p.out + (size_t)chunk * MC * 1024;
  unsigned char* wl = p.ws + G_WL + layer * WL_SIZE;
  switch (ph) {
    case 0: phase0(p, lds, bid, nblk); break;
    case 1: ln_rows(p.in[0] + (size_t)chunk * MC * 1024, X, (bf16_t*)(p.ws + G_XB), p.in[1], p.in[2], MC, bid, nblk); break;
    case 2: phase_proj(p, lds, layer, bid, nblk); break;
    case 3: phase2(p, lds, layer, bid, nblk); break;
    case 4: phase3(p, lds, layer, bid, nblk); break;
    case 5: phase4(p, lds, layer, bid, nblk); break;
    case 6: phase5(p, lds, layer, bid, nblk); break;
    case 7: phase6(p, lds, layer, bid, nblk); break;
    case 8: phase_resid<1024>(p, lds, (const bf16_t*)(p.ws + G_MERGED), (const bf16_t*)(wl + O_WOUT), X, bid, nblk); break;
    case 9: ln_rows(X, X, (bf16_t*)(p.ws + G_XB), p.in[26] + layer * 1024, p.in[27] + layer * 1024, MC, bid, nblk); break;
    case 10: phase_ff1(p, lds, layer, bid, nblk); break;
    case 11: phase_resid<4096>(p, lds, (const bf16_t*)(p.ws + G_PROJ), (const bf16_t*)(wl + O_WFF2), X, bid, nblk); break;
    case 12: ln_rows(X, X, (bf16_t*)(p.ws + G_XB), p.in[30] + layer * 1024, p.in[31] + layer * 1024, MC, bid, nblk); break;
    default: break;
  }
}

#if !MEGA
template <int PH>
__global__ void __launch_bounds__(NTHR) k_one(Params p, int layer, int chunk) {
  __shared__ __attribute__((aligned(16))) unsigned char lds[LDS_BYTES];
  run_phase(p, lds, PH, layer, chunk, blockIdx.x, gridDim.x);
}
#else
__global__ void __launch_bounds__(NTHR, 2) k_mega(Params p) {
  __shared__ __attribute__((aligned(16))) unsigned char lds[LDS_BYTES];
  cg::grid_group grid = cg::this_grid();
  const int bid = blockIdx.x, nblk = gridDim.x;
  run_phase(p, lds, 0, 0, 0, bid, nblk);
  grid.sync();
  for (int chunk = 0; chunk < NCH; ++chunk) {
    run_phase(p, lds, 1, 0, chunk, bid, nblk);
    grid.sync();
    for (int layer = 0; layer < DEPTH; ++layer)
      for (int ph = 2; ph <= 12; ++ph) {
        run_phase(p, lds, ph, layer, chunk, bid, nblk);
        grid.sync();
      }
  }
}
#endif

extern "C" void kernel_launch(void* const* d_in, const int* in_sizes, int n_in, void* d_out, int out_size, void* d_ws, size_t ws_size,
                              hipStream_t stream) {
  Params p{};
  for (int i = 0; i < 32; ++i) p.in[i] = (const float*)d_in[i];
  p.out = (float*)d_out;
  p.ws = (unsigned char*)d_ws;
#if MEGA
  static int grid_blocks = 0;
  if (!grid_blocks) {
    int dev = 0, cus = 0, per_cu = 0;
    hipGetDevice(&dev);
    hipDeviceGetAttribute(&cus, hipDeviceAttributeMultiprocessorCount, dev);
    hipOccupancyMaxActiveBlocksPerMultiprocessor(&per_cu, k_mega, NTHR, 0);
    if (per_cu > 2) per_cu = 2;
    grid_blocks = cus * per_cu;
  }
  void* args[] = {&p};
  hipLaunchCooperativeKernel((void*)k_mega, dim3(grid_blocks), dim3(NTHR), args, 0, stream);
#else
  const int grid = 512;
#define LAUNCH(PH, layer, chunk) k_one<PH><<<grid, NTHR, 0, stream>>>(p, layer, chunk)
  LAUNCH(0, 0, 0);
  for (int chunk = 0; chunk < NCH; ++chunk) {
    LAUNCH(1, 0, chunk);
    for (int layer = 0; layer < DEPTH; ++layer) {
      LAUNCH(2, layer, chunk); LAUNCH(3, layer, chunk); LAUNCH(4, layer, chunk); LAUNCH(5, layer, chunk);
      LAUNCH(6, layer, chunk); LAUNCH(7, layer, chunk); LAUNCH(8, layer, chunk); LAUNCH(9, layer, chunk);
      LAUNCH(10, layer, chunk); LAUNCH(11, layer, chunk); LAUNCH(12, layer, chunk);
    }
  }
#endif
}
```

```cpp
#include <hip/hip_runtime.h>
#include <hip/hip_cooperative_groups.h>
namespace cg = cooperative_groups;

#ifndef MEGA
#define MEGA 1
#endif

typedef unsigned short bf16_t;
typedef short bf16x8 __attribute__((ext_vector_type(8)));
typedef float f32x4 __attribute__((ext_vector_type(4)));
typedef unsigned long long u64;

constexpr int DM = 1024, NB = 8, SEQ = 4096, DEPTH = 2;
constexpr int CHB = 4;
constexpr int NCH = NB / CHB;
constexpr int MC = CHB * SEQ;
constexpr int INW = 5400, INP = 5504;
constexpr int C_SSM = 512, C_Q = 1024, C_KV = 1536, C_GN = 2304, C_GM = 2328;
constexpr int NROW = CHB * 64;
constexpr float ALPHA = 1.4142135623730951f;
constexpr int LDS_BYTES = 57344;
constexpr int NTHR = 256;

constexpr size_t al256(size_t x) { return (x + 255) & ~(size_t)255; }
constexpr size_t O_WIN = 0;
constexpr size_t O_WPOOL = O_WIN + (size_t)INP * 1024 * 2;
constexpr size_t O_WGLU = O_WPOOL + 4 * 128 * 128 * 2;
constexpr size_t O_WUP = O_WGLU + 512 * 512 * 2;
constexpr size_t O_WOUT = O_WUP + 3 * 1024 * 512 * 2;
constexpr size_t O_WFF1 = O_WOUT + 1024 * 1024 * 2;
constexpr size_t O_WFF2 = O_WFF1 + 4096 * 1024 * 2;
constexpr size_t O_WCK1 = O_WFF2 + 4096 * 1024 * 2;
constexpr size_t O_WCV1 = O_WCK1 + 128 * 2048 * 2;
constexpr size_t O_WCK2 = O_WCV1 + 128 * 2048 * 2;
constexpr size_t O_WCV2 = O_WCK2 + 64 * 128 * 2;
constexpr size_t O_BCK1 = O_WCV2 + 64 * 128 * 2;
constexpr size_t O_BCV1 = O_BCK1 + 512;
constexpr size_t O_KMAT = O_BCV1 + 512;
constexpr size_t O_EMAT = O_KMAT + 32 * 64 * 256 * 2;
constexpr size_t O_FMAT = O_EMAT + (size_t)32 * 128 * 1024 * 2;
constexpr size_t O_A64 = O_FMAT + (size_t)32 * 1024 * 128 * 2;
constexpr size_t WL_SIZE = al256(O_A64 + 32 * 64 * 2 * 4);
constexpr size_t G_WL = 0;
constexpr size_t G_ROPE = G_WL + 2 * WL_SIZE;
constexpr size_t G_XB = al256(G_ROPE + 4096 * 16 * 4);
constexpr size_t G_PROJ = al256(G_XB + (size_t)MC * 1024 * 2);
constexpr size_t G_Y = al256(G_PROJ + (size_t)MC * INP * 2);
constexpr size_t G_ZS = al256(G_Y + (size_t)MC * 1536 * 2);
constexpr size_t G_ONSA = al256(G_ZS + (size_t)MC * 512 * 2);
constexpr size_t G_MERGED = al256(G_ONSA + (size_t)MC * 512 * 4);
constexpr size_t G_S = al256(G_MERGED + (size_t)MC * 1024 * 2);
constexpr size_t G_HIN = al256(G_S + (size_t)32 * NROW * 128 * 4);
constexpr size_t G_KCMP = al256(G_HIN + (size_t)32 * NROW * 128 * 2);
constexpr size_t G_VCMPT = al256(G_KCMP + (size_t)CHB * 2 * 256 * 64 * 2);
constexpr size_t G_H1 = al256(G_VCMPT + (size_t)CHB * 2 * 256 * 64 * 2);
constexpr size_t G_SEL = al256(G_H1 + (size_t)2 * CHB * 512 * 128 * 2);
constexpr size_t G_END = al256(G_SEL + (size_t)MC * 2 * 8);

struct Params {
  const float* in[32];
  float* out;
  unsigned char* ws;
};

__device__ __forceinline__ int otid() { int t = threadIdx.x; asm volatile("" : "+v"(t)); return t; }
__device__ __forceinline__ float bf2f(bf16_t h) { return __uint_as_float(((unsigned)h) << 16); }
__device__ __forceinline__ bf16_t f2bf(float f) {
  unsigned u = __float_as_uint(f);
  u += 0x7fffu + ((u >> 16) & 1u);
  return (bf16_t)(u >> 16);
}
__device__ __forceinline__ unsigned pack2(float a, float b) { return (unsigned)f2bf(a) | ((unsigned)f2bf(b) << 16); }
__device__ __forceinline__ uint2 pack4(f32x4 v) { uint2 r; r.x = pack2(v[0], v[1]); r.y = pack2(v[2], v[3]); return r; }
__device__ __forceinline__ f32x4 unpack4(uint2 u) {
  f32x4 r; r[0] = __uint_as_float(u.x << 16); r[1] = __uint_as_float(u.x & 0xffff0000u);
  r[2] = __uint_as_float(u.y << 16); r[3] = __uint_as_float(u.y & 0xffff0000u); return r;
}
__device__ __forceinline__ float sigmoidf_(float x) { return 1.0f / (1.0f + __expf(-x)); }
__device__ __forceinline__ float gelu_tanh(float x) {
  float u = 0.7978845608028654f * (x + 0.044715f * x * x * x);
  return x / (1.0f + __expf(-2.0f * u));
}
__device__ __forceinline__ float wave_sum(float v) {
#pragma unroll
  for (int o = 32; o >= 1; o >>= 1) v += __shfl_xor(v, o);
  return v;
}

template <class LA, class LB>
__device__ __forceinline__ void gemm_acc(unsigned char* lds, int nk, const LA& la, const LB& lb, f32x4 (&acc)[4][4]) {
  const int tid = otid(), lane = tid & 63, wid = tid >> 6, wr = wid >> 1, wc = wid & 1, fr = lane & 15, fq = lane >> 4;
  bf16_t* sA = (bf16_t*)lds;
  bf16_t* sB = sA + 128 * 72;
  const int lrow = tid >> 3, lk = (tid & 7) * 8;
  uint4 ra[4], rb[4];
#pragma unroll
  for (int i = 0; i < 4; ++i) { ra[i] = la(lrow + i * 32, lk); rb[i] = lb(lrow + i * 32, lk); }
  for (int kt = 0; kt < nk; ++kt) {
    __syncthreads();
#pragma unroll
    for (int i = 0; i < 4; ++i) {
      *(uint4*)(sA + (lrow + i * 32) * 72 + lk) = ra[i];
      *(uint4*)(sB + (lrow + i * 32) * 72 + lk) = rb[i];
    }
    __syncthreads();
    if (kt + 1 < nk) {
#pragma unroll
      for (int i = 0; i < 4; ++i) { ra[i] = la(lrow + i * 32, (kt + 1) * 64 + lk); rb[i] = lb(lrow + i * 32, (kt + 1) * 64 + lk); }
    }
#pragma unroll
    for (int ks = 0; ks < 2; ++ks) {
      bf16x8 af[4], bfr[4];
#pragma unroll
      for (int mi = 0; mi < 4; ++mi) af[mi] = *(const bf16x8*)(sA + (wr * 64 + mi * 16 + fr) * 72 + ks * 32 + fq * 8);
#pragma unroll
      for (int ni = 0; ni < 4; ++ni) bfr[ni] = *(const bf16x8*)(sB + (wc * 64 + ni * 16 + fr) * 72 + ks * 32 + fq * 8);
#pragma unroll
      for (int mi = 0; mi < 4; ++mi)
#pragma unroll
        for (int ni = 0; ni < 4; ++ni) acc[mi][ni] = __builtin_amdgcn_mfma_f32_16x16x32_bf16(bfr[ni], af[mi], acc[mi][ni], 0, 0, 0);
    }
  }
}
__device__ __forceinline__ void zero_acc(f32x4 (&acc)[4][4]) {
#pragma unroll
  for (int i = 0; i < 4; ++i)
#pragma unroll
    for (int j = 0; j < 4; ++j) acc[i][j] = (f32x4){0.f, 0.f, 0.f, 0.f};
}
template <class EP>
__device__ __forceinline__ void gemm_epi(const f32x4 (&acc)[4][4], const EP& ep) {
  const int tid = otid(), lane = tid & 63, wid = tid >> 6, wr = wid >> 1, wc = wid & 1, fr = lane & 15, fq = lane >> 4;
#pragma unroll
  for (int mi = 0; mi < 4; ++mi)
#pragma unroll
    for (int ni = 0; ni < 4; ++ni) ep(wr * 64 + mi * 16 + fr, wc * 64 + ni * 16 + fq * 4, acc[mi][ni], ni);
}

__device__ void transpose_job(unsigned char* lds, const float* src, bf16_t* dst, int K, int N, int Npad, int bid, int nblk) {
  float* sm = (float*)lds;
  const int tid = otid();
  const int tk = K / 64, tn = Npad / 64;
  for (int t = bid; t < tk * tn; t += nblk) {
    const int k0 = (t % tk) * 64, n0 = (t / tk) * 64;
    __syncthreads();
#pragma unroll
    for (int i = 0; i < 16; ++i) {
      int r = (tid >> 6) + 4 * i, c = tid & 63;
      sm[r * 65 + c] = (n0 + c < N) ? src[(size_t)(k0 + r) * N + n0 + c] : 0.f;
    }
    __syncthreads();
#pragma unroll
    for (int i = 0; i < 16; ++i) {
      int n = (tid >> 6) + 4 * i, k = tid & 63;
      dst[(size_t)(n0 + n) * K + k0 + k] = f2bf(sm[k * 65 + n]);
    }
  }
}

__device__ __forceinline__ void sincos_red(double ang, double& s, double& c) {
  const double TWO_PI_HI = 6.283185307179586232, TWO_PI_LO = 2.4492935982947064e-16;
  double q = rint(ang * 0.15915494309189535);
  double r = fma(-q, TWO_PI_HI, ang);
  r = fma(-q, TWO_PI_LO, r);
  double x2 = r * r;
  double ss = r, term = r;
#pragma unroll 1
  for (int n = 1; n <= 14; ++n) { term *= -x2 / (double)((2 * n) * (2 * n + 1)); ss += term; }
  double cc = 1.0; term = 1.0;
#pragma unroll 1
  for (int n = 1; n <= 15; ++n) { term *= -x2 / (double)((2 * n - 1) * (2 * n)); cc += term; }
  s = ss; c = cc;
}

__device__ void phase0(const Params& p, unsigned char* lds, int bid, int nblk) {
  const int tid = otid();
  for (int layer = 0; layer < DEPTH; ++layer) {
    unsigned char* wl = p.ws + G_WL + layer * WL_SIZE;
    transpose_job(lds, p.in[3] + (size_t)layer * 1024 * INW, (bf16_t*)(wl + O_WIN), 1024, INW, INP, bid, nblk);
    for (int g = 0; g < 4; ++g)
      transpose_job(lds, p.in[4] + (size_t)(layer * 4 + g) * 128 * 128, (bf16_t*)(wl + O_WPOOL) + g * 128 * 128, 128, 128, 128, bid, nblk);
    transpose_job(lds, p.in[14] + (size_t)layer * 512 * 512, (bf16_t*)(wl + O_WGLU), 512, 512, 512, bid, nblk);
    for (int i = 0; i < 3; ++i)
      transpose_job(lds, p.in[22 + i] + (size_t)layer * 512 * 1024, (bf16_t*)(wl + O_WUP) + (size_t)i * 1024 * 512, 512, 1024, 1024, bid, nblk);
    transpose_job(lds, p.in[25] + (size_t)layer * 1024 * 1024, (bf16_t*)(wl + O_WOUT), 1024, 1024, 1024, bid, nblk);
    transpose_job(lds, p.in[28] + (size_t)layer * 1024 * 4096, (bf16_t*)(wl + O_WFF1), 1024, 4096, 4096, bid, nblk);
    transpose_job(lds, p.in[29] + (size_t)layer * 4096 * 1024, (bf16_t*)(wl + O_WFF2), 4096, 1024, 1024, bid, nblk);
    transpose_job(lds, p.in[18] + (size_t)layer * 2048 * 128, (bf16_t*)(wl + O_WCK1), 2048, 128, 128, bid, nblk);
    transpose_job(lds, p.in[20] + (size_t)layer * 2048 * 128, (bf16_t*)(wl + O_WCV1), 2048, 128, 128, bid, nblk);
    transpose_job(lds, p.in[19] + (size_t)layer * 128 * 64, (bf16_t*)(wl + O_WCK2), 128, 64, 64, bid, nblk);
    transpose_job(lds, p.in[21] + (size_t)layer * 128 * 64, (bf16_t*)(wl + O_WCV2), 128, 64, 64, bid, nblk);
  }
  {
    float* rope = (float*)(p.ws + G_ROPE);
    for (int idx = bid * NTHR + tid; idx < 4096 * 8; idx += nblk * NTHR) {
      int pos = idx >> 3, i = idx & 7;
      float inv = (float)exp(-(double)i * 0.125 * 13.122363377404328);
      double ang = (double)((float)pos * inv);
      double s, c; sincos_red(ang, s, c);
      rope[pos * 16 + i] = (float)c; rope[pos * 16 + 8 + i] = (float)s;
    }
  }
  for (int it = bid; it < DEPTH * 2; it += nblk) {
    const int layer = it >> 1, kv = it & 1;
    const float* pe = p.in[16 + kv] + (size_t)layer * 2048;
    const float* w1 = p.in[kv ? 20 : 18] + (size_t)layer * 2048 * 128;
    float* sm = (float*)lds;
    const int j = tid & 127, half = tid >> 7;
    float acc = 0.f;
    for (int kk = half * 1024; kk < half * 1024 + 1024; ++kk) acc += pe[kk] * w1[(size_t)kk * 128 + j];
    __syncthreads();
    sm[tid] = acc;
    __syncthreads();
    if (tid < 128) ((float*)(p.ws + G_WL + layer * WL_SIZE + (kv ? O_BCV1 : O_BCK1)))[tid] = sm[tid] + sm[tid + 128];
    __syncthreads();
  }
  for (int it = bid; it < DEPTH * 32 * 65; it += nblk) {
    const int layer = it / (32 * 65), rem = it % (32 * 65), g = rem / 65, d = rem % 65;
    unsigned char* wl = p.ws + G_WL + layer * WL_SIZE;
    float* pwr = (float*)lds; float* pwi = pwr + 64; float* kr = pwi + 64; float* ki = kr + 64;
    float* bbr = ki + 64; float* bbi = bbr + 1024;
    const size_t gp = (size_t)(layer * 32 + g) * 64;
    __syncthreads();
    if (tid < 64) {
      double lr = p.in[6][gp + tid], li = p.in[7][gp + tid];
      double step = exp((double)p.in[8][layer * 32 + g]);
      double s1, c1; sincos_red(li * step, s1, c1);
      double mag = exp(lr * step);
      double abr = mag * c1, abi = mag * s1;
      double den = lr * lr + li * li;
      double nr = abr - 1.0, ni = abi;
      kr[tid] = (float)((nr * lr + ni * li) / den);
      ki[tid] = (float)((ni * lr - nr * li) / den);
      double sd, cd; sincos_red(li * step * (double)d, sd, cd);
      double md = exp(lr * step * (double)d);
      pwr[tid] = (float)(md * cd); pwi[tid] = (float)(md * sd);
    }
    __syncthreads();
    for (int idx = tid; idx < 1024; idx += NTHR) {
      int pp = idx >> 4;
      float br = p.in[9][gp * 16 + idx], bi = p.in[10][gp * 16 + idx];
      bbr[idx] = kr[pp] * br - ki[pp] * bi;
      bbi[idx] = kr[pp] * bi + ki[pp] * br;
    }
    __syncthreads();
    if (d <= 63) {
      {
        const int co = tid >> 4, ci = tid & 15;
        const float* cre = p.in[11] + ((size_t)(layer * 32 + g) * 16 + co) * 64;
        const float* cim = p.in[12] + ((size_t)(layer * 32 + g) * 16 + co) * 64;
        float val = 0.f;
        for (int pp = 0; pp < 64; ++pp) {
          float cr = cre[pp], cm = cim[pp];
          float wr_ = cr * pwr[pp] - cm * pwi[pp], wi_ = cr * pwi[pp] + cm * pwr[pp];
          val += wr_ * bbr[pp * 16 + ci] - wi_ * bbi[pp * 16 + ci];
        }
        ((bf16_t*)(wl + O_KMAT))[(((size_t)g * 64 + d) * 16 + co) * 16 + ci] = f2bf(val);
      }
      const int s = 63 - d;
      bf16_t* em = (bf16_t*)(wl + O_EMAT);
      for (int idx = tid; idx < 1024; idx += NTHR) {
        int pp = idx >> 4, ci = idx & 15;
        float re = pwr[pp] * bbr[idx] - pwi[pp] * bbi[idx], im = pwr[pp] * bbi[idx] + pwi[pp] * bbr[idx];
        em[((size_t)g * 128 + pp) * 1024 + s * 16 + ci] = f2bf(re);
        em[((size_t)g * 128 + 64 + pp) * 1024 + s * 16 + ci] = f2bf(im);
      }
    }
    if (d >= 1) {
      const int t = d - 1;
      bf16_t* fm = (bf16_t*)(wl + O_FMAT);
      for (int idx = tid; idx < 1024; idx += NTHR) {
        int co = idx >> 6, pp = idx & 63;
        float cr = p.in[11][((size_t)(layer * 32 + g) * 16 + co) * 64 + pp], cm = p.in[12][((size_t)(layer * 32 + g) * 16 + co) * 64 + pp];
        float wr_ = cr * pwr[pp] - cm * pwi[pp], wi_ = cr * pwi[pp] + cm * pwr[pp];
        fm[((size_t)g * 1024 + t * 16 + co) * 128 + pp] = f2bf(wr_);
        fm[((size_t)g * 1024 + t * 16 + co) * 128 + 64 + pp] = f2bf(-wi_);
      }
    }
    if (d == 64 && tid < 64) {
      float* a64 = (float*)(wl + O_A64);
      a64[(g * 64 + tid) * 2] = pwr[tid]; a64[(g * 64 + tid) * 2 + 1] = pwi[tid];
    }
  }
}

__device__ void ln_rows(const float* src, float* dst, bf16_t* dstb, const float* gam, const float* bet, int nrows, int bid, int nblk) {
  const int tid = otid(), lane = tid & 63, wid = tid >> 6;
  for (int row = bid * 4 + wid; row < nrows; row += nblk * 4) {
    const float4* s4 = (const float4*)(src + (size_t)row * 1024);
    float4 v[4];
    float sum = 0.f;
#pragma unroll
    for (int i = 0; i < 4; ++i) { v[i] = s4[i * 64 + lane]; sum += (v[i].x + v[i].y) + (v[i].z + v[i].w); }
    const float mean = wave_sum(sum) * (1.0f / 1024.0f);
    float sq = 0.f;
#pragma unroll
    for (int i = 0; i < 4; ++i) {
      float a = v[i].x - mean, b = v[i].y - mean, c = v[i].z - mean, d = v[i].w - mean;
      sq += (a * a + b * b) + (c * c + d * d);
    }
    const float rstd = rsqrtf(wave_sum(sq) * (1.0f / 1024.0f) + 1e-5f);
#pragma unroll
    for (int i = 0; i < 4; ++i) {
      float4 gg = ((const float4*)gam)[i * 64 + lane], bb = ((const float4*)bet)[i * 64 + lane];
      float4 o;
      o.x = (v[i].x - mean) * rstd * gg.x + bb.x; o.y = (v[i].y - mean) * rstd * gg.y + bb.y;
      o.z = (v[i].z - mean) * rstd * gg.z + bb.z; o.w = (v[i].w - mean) * rstd * gg.w + bb.w;
      ((float4*)(dst + (size_t)row * 1024))[i * 64 + lane] = o;
      uint2 pk; pk.x = pack2(o.x, o.y); pk.y = pack2(o.z, o.w);
      ((uint2*)(dstb + (size_t)row * 1024))[i * 64 + lane] = pk;
    }
  }
}

__device__ void phase_proj(const Params& p, unsigned char* lds, int layer, int bid, int nblk) {
  const bf16_t* A = (const bf16_t*)(p.ws + G_XB);
  const bf16_t* Bt = (const bf16_t*)(p.ws + G_WL + layer * WL_SIZE + O_WIN);
  bf16_t* PROJ = (bf16_t*)(p.ws + G_PROJ);
  const float* rope = (const float*)(p.ws + G_ROPE);
  const int wid = otid() >> 6, lane = otid() & 63, fq = lane >> 4;
  constexpr int NT = INP / 128, MT = MC / 128;
  for (int t = bid; t < NT * MT; t += nblk) {
    const int nt = t % NT, mt = t / NT;
    const int m0 = mt * 128, n0 = nt * 128;
    f32x4 acc[4][4]; zero_acc(acc);
    auto la = [=](int r, int kk) -> uint4 { return *(const uint4*)(A + (size_t)(m0 + r) * 1024 + kk); };
    auto lb = [=](int n, int kk) -> uint4 { return *(const uint4*)(Bt + (size_t)(n0 + n) * 1024 + kk); };
    gemm_acc(lds, 16, la, lb, acc);
    const int cb = n0 + (wid & 1) * 64;
    const int jg = (cb - C_Q) >> 6;
    const bool roped = (cb >= C_Q) && (cb < C_GN) && (jg < 8 || (((jg - 8) & 2) == 0));
    const bool isq = (cb >= C_Q) && (cb < C_KV);
    const bool isgate = cb >= C_GN;
    gemm_epi(acc, [=](int r, int c, f32x4 v, int ni) {
      const int row = m0 + r, col = n0 + c;
      if (isgate) {
#pragma unroll
        for (int e = 0; e < 4; ++e) v[e] = sigmoidf_(v[e]);
      } else if (roped) {
        if (ni == 0) {
          const int pos = row & (SEQ - 1);
          const float4 cs = *(const float4*)(rope + pos * 16 + (fq & 1) * 4);
          const float4 sn = *(const float4*)(rope + pos * 16 + 8 + (fq & 1) * 4);
          const float csv[4] = {cs.x, cs.y, cs.z, cs.w}, snv[4] = {sn.x, sn.y, sn.z, sn.w};
#pragma unroll
          for (int e = 0; e < 4; ++e) {
            float pv = __shfl_xor(v[e], 32);
            v[e] = (fq < 2) ? (v[e] * csv[e] - pv * snv[e]) : (pv * snv[e] + v[e] * csv[e]);
          }
        }
      }
      if (isq) {
#pragma unroll
        for (int e = 0; e < 4; ++e) v[e] *= 0.125f;
      }
      *(uint2*)(PROJ + (size_t)row * INP + col) = pack4(v);
    });
  }
}

__device__ void phase2(const Params& p, unsigned char* lds, int layer, int bid, int nblk) {
  unsigned char* wl = p.ws + G_WL + layer * WL_SIZE;
  const bf16_t* PROJ = (const bf16_t*)(p.ws + G_PROJ);
  constexpr int T_CMP = 32, T_S5 = 64, T_POOL = (MC / 128) * 4;
  for (int t = bid; t < T_CMP + T_S5 + T_POOL; t += nblk) {
    f32x4 acc[4][4]; zero_acc(acc);
    if (t < T_CMP) {
      const int kv = t & 1, mt = t >> 1, m0 = mt * 128;
      const bf16_t* Bt = (const bf16_t*)(wl + (kv ? O_WCV1 : O_WCK1));
      const float* bias = (const float*)(wl + (kv ? O_BCV1 : O_BCK1));
      bf16_t* H1 = (bf16_t*)(p.ws + G_H1) + (size_t)kv * CHB * 512 * 128;
      const int col0 = C_KV + kv * 128;
      auto la = [=](int r, int kk) -> uint4 {
        const int row = m0 + r;
        int n = row & 255; if (n > 254) n = 254;
        const int k = (row >> 8) & 1, bl = row >> 9;
        return *(const uint4*)(PROJ + ((size_t)bl * SEQ + 16 * n + (kk >> 6)) * INP + col0 + k * 64 + (kk & 63));
      };
      auto lb = [=](int n, int kk) -> uint4 { return *(const uint4*)(Bt + (size_t)n * 2048 + kk); };
      gemm_acc(lds, 32, la, lb, acc);
      gemm_epi(acc, [=](int r, int c, f32x4 v, int) {
        const float4 b4 = *(const float4*)(bias + c);
        v[0] = gelu_tanh(v[0] + b4.x); v[1] = gelu_tanh(v[1] + b4.y); v[2] = gelu_tanh(v[2] + b4.z); v[3] = gelu_tanh(v[3] + b4.w);
        *(uint2*)(H1 + (size_t)(m0 + r) * 128 + c) = pack4(v);
      });
    } else if (t < T_CMP + T_S5) {
      const int tt = t - T_CMP, g = tt >> 1, m0 = (tt & 1) * 128;
      const bf16_t* Bt = (const bf16_t*)(wl + O_EMAT) + (size_t)g * 128 * 1024;
      float* S = (float*)(p.ws + G_S);
      auto la = [=](int r, int kk) -> uint4 {
        return *(const uint4*)(PROJ + ((size_t)(m0 + r) * 64 + (kk >> 4)) * INP + C_SSM + g * 16 + (kk & 15));
      };
      auto lb = [=](int n, int kk) -> uint4 { return *(const uint4*)(Bt + (size_t)n * 1024 + kk); };
      gemm_acc(lds, 16, la, lb, acc);
      gemm_epi(acc, [=](int r, int c, f32x4 v, int) {
        *(float4*)(S + ((size_t)g * NROW + m0 + r) * 128 + c) = make_float4(v[0], v[1], v[2], v[3]);
      });
    } else {
      const int tt = t - T_CMP - T_S5, g = tt & 3, m0 = (tt >> 2) * 128;
      const bf16_t* Bt = (const bf16_t*)(wl + O_WPOOL) + g * 128 * 128;
      const float* pscale = p.in[5] + (size_t)layer * 512 + g * 128;
      bf16_t* Y = (bf16_t*)(p.ws + G_Y);
      const int w = 2 << g;
      auto la = [=](int r, int kk) -> uint4 {
        const int row = m0 + r, tpos = row & (SEQ - 1);
        const int cnt = (tpos + 1 < w) ? (tpos + 1) : w;
        const bf16_t* base = PROJ + (size_t)row * INP + g * 128 + kk;
        float sum[8];
        const uint4 u0 = *(const uint4*)base;
        float uf[8];
        uf[0] = __uint_as_float(u0.x << 16); uf[1] = __uint_as_float(u0.x & 0xffff0000u);
        uf[2] = __uint_as_float(u0.y << 16); uf[3] = __uint_as_float(u0.y & 0xffff0000u);
        uf[4] = __uint_as_float(u0.z << 16); uf[5] = __uint_as_float(u0.z & 0xffff0000u);
        uf[6] = __uint_as_float(u0.w << 16); uf[7] = __uint_as_float(u0.w & 0xffff0000u);
#pragma unroll
        for (int e = 0; e < 8; ++e) sum[e] = uf[e];
        for (int j = 1; j < cnt; ++j) {
          const uint4 u = *(const uint4*)(base - (size_t)j * INP);
          sum[0] += __uint_as_float(u.x << 16); sum[1] += __uint_as_float(u.x & 0xffff0000u);
          sum[2] += __uint_as_float(u.y << 16); sum[3] += __uint_as_float(u.y & 0xffff0000u);
          sum[4] += __uint_as_float(u.z << 16); sum[5] += __uint_as_float(u.z & 0xffff0000u);
          sum[6] += __uint_as_float(u.w << 16); sum[7] += __uint_as_float(u.w & 0xffff0000u);
        }
        const float ic = 1.0f / (float)cnt;
        uint4 o;
        o.x = pack2(sum[0] * ic - uf[0], sum[1] * ic - uf[1]); o.y = pack2(sum[2] * ic - uf[2], sum[3] * ic - uf[3]);
        o.z = pack2(sum[4] * ic - uf[4], sum[5] * ic - uf[5]); o.w = pack2(sum[6] * ic - uf[6], sum[7] * ic - uf[7]);
        return o;
      };
      auto lb = [=](int n, int kk) -> uint4 { return *(const uint4*)(Bt + (size_t)n * 128 + kk); };
      gemm_acc(lds, 2, la, lb, acc);
      gemm_epi(acc, [=](int r, int c, f32x4 v, int) {
        const float4 s4 = *(const float4*)(pscale + c);
        v[0] *= s4.x; v[1] *= s4.y; v[2] *= s4.z; v[3] *= s4.w;
        *(uint2*)(Y + (size_t)(m0 + r) * 1536 + g * 128 + c) = pack4(v);
      });
    }
  }
}

__device__ void phase3(const Params& p, unsigned char* lds, int layer, int bid, int nblk) {
  unsigned char* wl = p.ws + G_WL + layer * WL_SIZE;
  constexpr int T_CMP = 32, T_SCAN = 32 * CHB * 64 / NTHR;
  for (int t = bid; t < T_CMP + T_SCAN; t += nblk) {
    if (t < T_CMP) {
      const int kv = t & 1, m0 = (t >> 1) * 128;
      const bf16_t* A = (const bf16_t*)(p.ws + G_H1) + (size_t)kv * CHB * 512 * 128;
      const bf16_t* Bt = (const bf16_t*)(wl + (kv ? O_WCV2 : O_WCK2));
      bf16_t* KC = (bf16_t*)(p.ws + G_KCMP);
      bf16_t* VT = (bf16_t*)(p.ws + G_VCMPT);
      f32x4 acc[4][4]; zero_acc(acc);
      auto la = [=](int r, int kk) -> uint4 { return *(const uint4*)(A + (size_t)(m0 + r) * 128 + kk); };
      auto lb = [=](int n, int kk) -> uint4 { return *(const uint4*)(Bt + (size_t)(n & 63) * 128 + kk); };
      gemm_acc(lds, 2, la, lb, acc);
      gemm_epi(acc, [=](int r, int c, f32x4 v, int) {
        if (c < 64) {
          const int row = m0 + r;
          if (kv == 0) {
            *(uint2*)(KC + (size_t)row * 64 + c) = pack4(v);
          } else {
            const int bk = row >> 8, n = row & 255;
#pragma unroll
            for (int e = 0; e < 4; ++e) VT[((size_t)bk * 64 + c + e) * 256 + n] = f2bf(v[e]);
          }
        }
      });
    } else {
      const int idx = (t - T_CMP) * NTHR + otid();
      const int pp = idx & 63, bl = (idx >> 6) % CHB, g = idx / (64 * CHB);
      const float* a64 = (const float*)(wl + O_A64);
      const float ar = a64[(g * 64 + pp) * 2], ai = a64[(g * 64 + pp) * 2 + 1];
      const float* S = (const float*)(p.ws + G_S) + ((size_t)g * NROW + bl * 64) * 128;
      bf16_t* HIN = (bf16_t*)(p.ws + G_HIN) + ((size_t)g * NROW + bl * 64) * 128;
      float hr = 0.f, hi = 0.f;
      for (int c = 0; c < 64; ++c) {
        HIN[c * 128 + pp] = f2bf(hr); HIN[c * 128 + 64 + pp] = f2bf(hi);
        const float sr = S[c * 128 + pp], si = S[c * 128 + 64 + pp];
        const float nr = ar * hr - ai * hi + sr, ni = ar * hi + ai * hr + si;
        hr = nr; hi = ni;
      }
    }
  }
}

__device__ void cmp_attn_item(const Params& p, unsigned char* lds, int item) {
  const int tid = otid(), lane = tid & 63, g = tid >> 6, fr = lane & 15, fq = lane >> 4;
  const int tg = item & 255, k = (item >> 8) & 1, bl = item >> 9;
  const bf16_t* PROJ = (const bf16_t*)(p.ws + G_PROJ);
  const bf16_t* KC = (const bf16_t*)(p.ws + G_KCMP) + (size_t)(bl * 2 + k) * 256 * 64;
  const bf16_t* VT = (const bf16_t*)(p.ws + G_VCMPT) + (size_t)(bl * 2 + k) * 64 * 256;
  float* ONSA = (float*)(p.ws + G_ONSA);
  u64* SEL = (u64*)(p.ws + G_SEL);
  bf16_t* sP = (bf16_t*)lds + g * 16 * 264;
  float* simp = (float*)(lds + 4 * 16 * 264 * 2);
  const int h = k * 4 + g, t0 = tg * 16;
  const size_t tok = (size_t)bl * SEQ + t0 + fr;
  const int nvr = (tg == 0) ? 0 : ((fr == 15) ? tg : tg - 1);
  bf16x8 qf[2];
#pragma unroll
  for (int ks = 0; ks < 2; ++ks) qf[ks] = *(const bf16x8*)(PROJ + tok * INP + C_Q + h * 64 + ks * 32 + fq * 8);
  f32x4 s[16];
#pragma unroll
  for (int ni = 0; ni < 16; ++ni) {
    s[ni] = (f32x4){0.f, 0.f, 0.f, 0.f};
    if (ni * 16 < tg) {
#pragma unroll
      for (int ks = 0; ks < 2; ++ks) {
        const bf16x8 kf = *(const bf16x8*)(KC + (size_t)(ni * 16 + fr) * 64 + ks * 32 + fq * 8);
        s[ni] = __builtin_amdgcn_mfma_f32_16x16x32_bf16(kf, qf[ks], s[ni], 0, 0, 0);
      }
    }
  }
  float rmax = -1e30f;
#pragma unroll
  for (int ni = 0; ni < 16; ++ni)
#pragma unroll
    for (int e = 0; e < 4; ++e) {
      const int n = ni * 16 + fq * 4 + e;
      if (n < nvr) rmax = fmaxf(rmax, s[ni][e]);
    }
  rmax = fmaxf(rmax, __shfl_xor(rmax, 16)); rmax = fmaxf(rmax, __shfl_xor(rmax, 32));
  float rsum = 0.f;
#pragma unroll
  for (int ni = 0; ni < 16; ++ni)
#pragma unroll
    for (int e = 0; e < 4; ++e) {
      const int n = ni * 16 + fq * 4 + e;
      const float pv = (n < nvr) ? __expf(s[ni][e] - rmax) : 0.f;
      s[ni][e] = pv; rsum += pv;
    }
  rsum += __shfl_xor(rsum, 16); rsum += __shfl_xor(rsum, 32);
  const float inv = (rsum > 0.f) ? 1.0f / rsum : 0.f;
  __syncthreads();
  const int src = (lane + 48) & 63;
#pragma unroll
  for (int ni = 0; ni < 16; ++ni) {
#pragma unroll
    for (int e = 0; e < 4; ++e) s[ni][e] *= inv;
    *(uint2*)(sP + fr * 264 + ni * 16 + fq * 4) = pack4(s[ni]);
    const float a = __shfl(s[ni][3], src);
    const float b = (ni > 0) ? __shfl(s[ni > 0 ? ni - 1 : 0][3], src) : 0.f;
    const float prev = (fq > 0) ? a : b;
    simp[(g * 16 + fr) * 64 + ni * 4 + fq] = 2.0f * (s[ni][0] + s[ni][1] + s[ni][2]) + s[ni][3] + prev;
  }
  __syncthreads();
  f32x4 o[4];
#pragma unroll
  for (int nd = 0; nd < 4; ++nd) o[nd] = (f32x4){0.f, 0.f, 0.f, 0.f};
  for (int ks = 0; ks * 32 < tg; ++ks) {
    const bf16x8 pf = *(const bf16x8*)(sP + fr * 264 + ks * 32 + fq * 8);
#pragma unroll
    for (int nd = 0; nd < 4; ++nd) {
      const bf16x8 vf = *(const bf16x8*)(VT + (size_t)(nd * 16 + fr) * 256 + ks * 32 + fq * 8);
      o[nd] = __builtin_amdgcn_mfma_f32_16x16x32_bf16(vf, pf, o[nd], 0, 0, 0);
    }
  }
  const float gt = bf2f(PROJ[tok * INP + C_GN + h * 3 + 0]);
#pragma unroll
  for (int nd = 0; nd < 4; ++nd)
    *(float4*)(ONSA + tok * 512 + h * 64 + nd * 16 + fq * 4) = make_float4(gt * o[nd][0], gt * o[nd][1], gt * o[nd][2], gt * o[nd][3]);
#pragma unroll 1
  for (int i = 0; i < 4; ++i) {
    const int r = g * 4 + i, t = t0 + r, cur = t >> 6, sb = lane;
    const float imp = simp[(0 * 16 + r) * 64 + sb] + simp[(1 * 16 + r) * 64 + sb] + simp[(2 * 16 + r) * 64 + sb] + simp[(3 * 16 + r) * 64 + sb];
    const bool forced = (sb == 0) || (sb == cur) || (sb == cur - 1);
    const float score = forced ? 1e6f : ((sb <= cur) ? imp : -1e6f);
    int rank = 0;
    for (int j = 0; j < 64; ++j) {
      const float sj = __shfl(score, j);
      rank += (sj > score || (sj == score && j < sb)) ? 1 : 0;
    }
    const u64 m = __ballot(rank < 16);
    if (lane == 0) SEL[((size_t)bl * SEQ + t) * 2 + k] = m;
  }
}

__device__ void phase4(const Params& p, unsigned char* lds, int layer, int bid, int nblk) {
  unsigned char* wl = p.ws + G_WL + layer * WL_SIZE;
  const bf16_t* PROJ = (const bf16_t*)(p.ws + G_PROJ);
  constexpr int T_S5 = 32 * 2 * 8, T_CMP = CHB * 2 * 256;
  for (int t = bid; t < T_S5 + T_CMP; t += nblk) {
    if (t < T_S5) {
      const int nt = 7 - (t & 7), mt = (t >> 3) & 1, g = t >> 4;
      const int m0 = mt * 128, n0 = nt * 128, nk1 = 2 * nt + 2;
      const bf16_t* HIN = (const bf16_t*)(p.ws + G_HIN) + (size_t)g * NROW * 128;
      const bf16_t* KM = (const bf16_t*)(wl + O_KMAT) + (size_t)g * 64 * 256;
      const bf16_t* FM = (const bf16_t*)(wl + O_FMAT) + (size_t)g * 1024 * 128;
      const float* dsk = p.in[13] + (size_t)(layer * 32 + g) * 16;
      bf16_t* ZS = (bf16_t*)(p.ws + G_ZS);
      f32x4 acc[4][4]; zero_acc(acc);
      auto la = [=](int r, int kk) -> uint4 {
        const int k2 = (kk >= nk1 * 64) ? (kk - nk1 * 64 + 1024) : kk;
        if (k2 < 1024) return *(const uint4*)(PROJ + ((size_t)(m0 + r) * 64 + (k2 >> 4)) * INP + C_SSM + g * 16 + (k2 & 15));
        return *(const uint4*)(HIN + (size_t)(m0 + r) * 128 + (k2 - 1024));
      };
      auto lb = [=](int n, int kk) -> uint4 {
        const int k2 = (kk >= nk1 * 64) ? (kk - nk1 * 64 + 1024) : kk;
        const int nn = n0 + n, tt = nn >> 4, co = nn & 15;
        if (k2 < 1024) {
          const int s = k2 >> 4;
          if (s > tt) return make_uint4(0, 0, 0, 0);
          return *(const uint4*)(KM + ((size_t)(tt - s) * 16 + co) * 16 + (k2 & 15));
        }
        return *(const uint4*)(FM + (size_t)nn * 128 + (k2 - 1024));
      };
      gemm_acc(lds, nk1 + 2, la, lb, acc);
      gemm_epi(acc, [=](int r, int c, f32x4 v, int) {
        const int nn = n0 + c, tt = nn >> 4, co = nn & 15;
        const size_t tok = (size_t)(m0 + r) * 64 + tt;
        const f32x4 u = unpack4(*(const uint2*)(PROJ + tok * INP + C_SSM + g * 16 + co));
        const float4 d4 = *(const float4*)(dsk + co);
        v[0] = gelu_tanh(v[0] + d4.x * u[0]); v[1] = gelu_tanh(v[1] + d4.y * u[1]);
        v[2] = gelu_tanh(v[2] + d4.z * u[2]); v[3] = gelu_tanh(v[3] + d4.w * u[3]);
        *(uint2*)(ZS + tok * 512 + g * 16 + co) = pack4(v);
      });
    } else {
      cmp_attn_item(p, lds, t - T_S5);
    }
  }
}

constexpr int AMI = 2;
constexpr int AQ = AMI * 16;
__device__ void attn_item(const Params& p, unsigned char* lds, int item) {
  const int tid = otid(), lane = tid & 63, g = __builtin_amdgcn_readfirstlane(tid >> 6), fr = lane & 15, fq = lane >> 4;
  const int qb = (SEQ / AQ - 1) - (item >> 3), k = item & 1, bl = (item >> 1) & 3;
  const bf16_t* PROJ = (const bf16_t*)(p.ws + G_PROJ);
  float* ONSA = (float*)(p.ws + G_ONSA);
  bf16_t* Y = (bf16_t*)(p.ws + G_Y);
  const u64* SEL = (const u64*)(p.ws + G_SEL);
  bf16_t* sK = (bf16_t*)lds;
  bf16_t* sVt = sK + 64 * 72;
  bf16_t* sP = sVt + 64 * 72 + g * AQ * 72;
  const int h = k * 4 + g, t0 = qb * AQ;
  const int jq = (t0 + AQ - 1) >> 6;
  const size_t tokb = (size_t)bl * SEQ;
  bf16x8 qf[AMI][2];
#pragma unroll
  for (int mi = 0; mi < AMI; ++mi)
#pragma unroll
    for (int ks = 0; ks < 2; ++ks) qf[mi][ks] = *(const bf16x8*)(PROJ + (tokb + t0 + mi * 16 + fr) * INP + C_Q + h * 64 + ks * 32 + fq * 8);
  u64 mrow[AMI];
#pragma unroll
  for (int mi = 0; mi < AMI; ++mi) mrow[mi] = SEL[(tokb + t0 + mi * 16 + fr) * 2 + k];
  u64 um;
  {
    const u64 mm = SEL[(tokb + t0 + (lane & (AQ - 1))) * 2 + k];
    unsigned lo = (unsigned)mm, hi = (unsigned)(mm >> 32);
#pragma unroll
    for (int o = 32; o >= 1; o >>= 1) { lo |= __shfl_xor(lo, o); hi |= __shfl_xor(hi, o); }
    lo = __builtin_amdgcn_readfirstlane(lo); hi = __builtin_amdgcn_readfirstlane(hi);
    um = ((u64)hi << 32) | lo;
  }
  const u64 causal = (jq == 63) ? ~0ull : ((1ull << (jq + 1)) - 1ull);
  um &= causal;
#pragma unroll 1
  for (int pass = 0; pass < 2; ++pass) {
    const int kcol = C_KV + (pass == 0 ? 512 : 256) + k * 64, vcol = kcol + 128;
    u64 blk;
    if (pass == 0) {
      const int lo = (t0 >= 511) ? ((t0 - 511) >> 6) : 0;
      blk = causal & ~((1ull << lo) - 1ull);
    } else blk = um;
    f32x4 o[AMI][4];
#pragma unroll
    for (int i = 0; i < AMI; ++i)
#pragma unroll
      for (int j = 0; j < 4; ++j) o[i][j] = (f32x4){0.f, 0.f, 0.f, 0.f};
    float mst[AMI], lst[AMI];
#pragma unroll
    for (int i = 0; i < AMI; ++i) { mst[i] = -1e30f; lst[i] = 0.f; }
    while (blk) {
      const int j = 63 - __builtin_clzll(blk);
      blk &= ~(1ull << j);
      __syncthreads();
#pragma unroll
      for (int i = 0; i < 2; ++i) {
        const int idx = tid + i * 256, row = idx >> 3, c8 = (idx & 7) * 8;
        const bf16_t* src = PROJ + (tokb + j * 64 + row) * INP;
        *(uint4*)(sK + row * 72 + c8) = *(const uint4*)(src + kcol + c8);
        const uint4 vv = *(const uint4*)(src + vcol + c8);
        const unsigned w[4] = {vv.x, vv.y, vv.z, vv.w};
#pragma unroll
        for (int e = 0; e < 4; ++e) {
          sVt[(c8 + 2 * e) * 72 + row] = (bf16_t)(w[e] & 0xffffu);
          sVt[(c8 + 2 * e + 1) * 72 + row] = (bf16_t)(w[e] >> 16);
        }
      }
      __syncthreads();
#pragma unroll
      for (int mi = 0; mi < AMI; ++mi) {
        f32x4 s[4];
#pragma unroll
        for (int ni = 0; ni < 4; ++ni) s[ni] = (f32x4){0.f, 0.f, 0.f, 0.f};
#pragma unroll
        for (int ks = 0; ks < 2; ++ks)
#pragma unroll
          for (int ni = 0; ni < 4; ++ni) {
            const bf16x8 kf = *(const bf16x8*)(sK + (ni * 16 + fr) * 72 + ks * 32 + fq * 8);
            s[ni] = __builtin_amdgcn_mfma_f32_16x16x32_bf16(kf, qf[mi][ks], s[ni], 0, 0, 0);
          }
        const int t = t0 + mi * 16 + fr;
        const bool rowsel = (pass == 0) || ((mrow[mi] >> j) & 1ull);
        float rmax = -1e30f;
#pragma unroll
        for (int ni = 0; ni < 4; ++ni)
#pragma unroll
          for (int e = 0; e < 4; ++e) {
            const int key = j * 64 + ni * 16 + fq * 4 + e;
            bool valid = rowsel && (key <= t);
            if (pass == 0) valid = valid && (key + 512 > t);
            const float v = valid ? s[ni][e] : -1e30f;
            s[ni][e] = v; rmax = fmaxf(rmax, v);
          }
        rmax = fmaxf(rmax, __shfl_xor(rmax, 16)); rmax = fmaxf(rmax, __shfl_xor(rmax, 32));
        const float mnew = fmaxf(mst[mi], rmax);
        const float alpha = __expf(mst[mi] - mnew);
        mst[mi] = mnew;
        float rsum = 0.f;
#pragma unroll
        for (int ni = 0; ni < 4; ++ni) {
#pragma unroll
          for (int e = 0; e < 4; ++e) { const float pv = __expf(s[ni][e] - mnew); s[ni][e] = pv; rsum += pv; }
          *(uint2*)(sP + (mi * 16 + fr) * 72 + ni * 16 + fq * 4) = pack4(s[ni]);
        }
        rsum += __shfl_xor(rsum, 16); rsum += __shfl_xor(rsum, 32);
        lst[mi] = lst[mi] * alpha + rsum;
#pragma unroll
        for (int nd = 0; nd < 4; ++nd)
#pragma unroll
          for (int e = 0; e < 4; ++e) o[mi][nd][e] *= alpha;
      }
      __syncthreads();
#pragma unroll
      for (int ks = 0; ks < 2; ++ks) {
        bf16x8 vf[4], pf[AMI];
#pragma unroll
        for (int nd = 0; nd < 4; ++nd) vf[nd] = *(const bf16x8*)(sVt + (nd * 16 + fr) * 72 + ks * 32 + fq * 8);
#pragma unroll
        for (int mi = 0; mi < AMI; ++mi) pf[mi] = *(const bf16x8*)(sP + (mi * 16 + fr) * 72 + ks * 32 + fq * 8);
#pragma unroll
        for (int mi = 0; mi < AMI; ++mi)
#pragma unroll
          for (int nd = 0; nd < 4; ++nd) o[mi][nd] = __builtin_amdgcn_mfma_f32_16x16x32_bf16(vf[nd], pf[mi], o[mi][nd], 0, 0, 0);
      }
    }
#pragma unroll
    for (int mi = 0; mi < AMI; ++mi) {
      const size_t tok = tokb + t0 + mi * 16 + fr;
      const float gt = bf2f(PROJ[tok * INP + C_GN + h * 3 + (pass == 0 ? 2 : 1)]) / lst[mi];
#pragma unroll
      for (int nd = 0; nd < 4; ++nd) {
        float4* op = (float4*)(ONSA + tok * 512 + h * 64 + nd * 16 + fq * 4);
        float4 prev = *op;
        f32x4 r;
        r[0] = prev.x + gt * o[mi][nd][0]; r[1] = prev.y + gt * o[mi][nd][1];
        r[2] = prev.z + gt * o[mi][nd][2]; r[3] = prev.w + gt * o[mi][nd][3];
        if (pass == 0) *op = make_float4(r[0], r[1], r[2], r[3]);
        else *(uint2*)(Y + tok * 1536 + 1024 + h * 64 + nd * 16 + fq * 4) = pack4(r);
      }
    }
  }
}

__device__ void phase5(const Params& p, unsigned char* lds, int layer, int bid, int nblk) {
  unsigned char* wl = p.ws + G_WL + layer * WL_SIZE;
  constexpr int T_ATT = CHB * 2 * (SEQ / AQ), T_GLU = (MC / 128) * 4;
  for (int t = bid; t < T_ATT + T_GLU; t += nblk) {
    if (t < T_ATT) {
      attn_item(p, lds, t);
    } else {
      const int tt = t - T_ATT, nt = tt & 3, m0 = (tt >> 2) * 128, n0 = nt * 128;
      const bf16_t* ZS = (const bf16_t*)(p.ws + G_ZS);
      const bf16_t* Bt = (const bf16_t*)(wl + O_WGLU);
      const float* bg = p.in[15] + (size_t)layer * 512;
      bf16_t* Y = (bf16_t*)(p.ws + G_Y);
      f32x4 acc[4][4]; zero_acc(acc);
      auto la = [=](int r, int kk) -> uint4 { return *(const uint4*)(ZS + (size_t)(m0 + r) * 512 + kk); };
      auto lb = [=](int n, int kk) -> uint4 { return *(const uint4*)(Bt + (size_t)(n0 + n) * 512 + kk); };
      gemm_acc(lds, 8, la, lb, acc);
      gemm_epi(acc, [=](int r, int c, f32x4 v, int) {
        const float4 b4 = *(const float4*)(bg + n0 + c);
        const f32x4 z = unpack4(*(const uint2*)(ZS + (size_t)(m0 + r) * 512 + n0 + c));
        v[0] = z[0] * sigmoidf_(v[0] + b4.x); v[1] = z[1] * sigmoidf_(v[1] + b4.y);
        v[2] = z[2] * sigmoidf_(v[2] + b4.z); v[3] = z[3] * sigmoidf_(v[3] + b4.w);
        *(uint2*)(Y + (size_t)(m0 + r) * 1536 + 512 + n0 + c) = pack4(v);
      });
    }
  }
}

__device__ void phase6(const Params& p, unsigned char* lds, int layer, int bid, int nblk) {
  unsigned char* wl = p.ws + G_WL + layer * WL_SIZE;
  const bf16_t* Y = (const bf16_t*)(p.ws + G_Y);
  const bf16_t* PROJ = (const bf16_t*)(p.ws + G_PROJ);
  bf16_t* MG = (bf16_t*)(p.ws + G_MERGED);
  const int tid = otid(), lane = tid & 63, wid = tid >> 6, wr = wid >> 1, wc = wid & 1, fr = lane & 15, fq = lane >> 4;
  constexpr int NT = 8, MT = MC / 128;
  for (int t = bid; t < NT * MT; t += nblk) {
    const int nt = t % NT, m0 = (t / NT) * 128, n0 = nt * 128;
    f32x4 tot[4][4]; zero_acc(tot);
#pragma unroll 1
    for (int i = 0; i < 3; ++i) {
      const bf16_t* Bt = (const bf16_t*)(wl + O_WUP) + (size_t)i * 1024 * 512;
      f32x4 acc[4][4]; zero_acc(acc);
      auto la = [=](int r, int kk) -> uint4 { return *(const uint4*)(Y + (size_t)(m0 + r) * 1536 + i * 512 + kk); };
      auto lb = [=](int n, int kk) -> uint4 { return *(const uint4*)(Bt + (size_t)(n0 + n) * 512 + kk); };
      gemm_acc(lds, 8, la, lb, acc);
#pragma unroll
      for (int mi = 0; mi < 4; ++mi)
#pragma unroll
        for (int ni = 0; ni < 4; ++ni) {
          const int row = m0 + wr * 64 + mi * 16 + fr, col = n0 + wc * 64 + ni * 16 + fq * 4;
          const f32x4 gt = unpack4(*(const uint2*)(PROJ + (size_t)row * INP + C_GM + i * 1024 + col));
#pragma unroll
          for (int e = 0; e < 4; ++e) tot[mi][ni][e] += gt[e] * acc[mi][ni][e];
        }
    }
    gemm_epi(tot, [=](int r, int c, f32x4 v, int) { *(uint2*)(MG + (size_t)(m0 + r) * 1024 + n0 + c) = pack4(v); });
  }
}

template <int K>
__device__ void phase_resid(const Params& p, unsigned char* lds, const bf16_t* A, const bf16_t* Bt, float* X, int bid, int nblk) {
  constexpr int NT = 8, MT = MC / 128;
  for (int t = bid; t < NT * MT; t += nblk) {
    const int nt = t % NT, m0 = (t / NT) * 128, n0 = nt * 128;
    f32x4 acc[4][4]; zero_acc(acc);
    auto la = [=](int r, int kk) -> uint4 { return *(const uint4*)(A + (size_t)(m0 + r) * K + kk); };
    auto lb = [=](int n, int kk) -> uint4 { return *(const uint4*)(Bt + (size_t)(n0 + n) * K + kk); };
    gemm_acc(lds, K / 64, la, lb, acc);
    gemm_epi(acc, [=](int r, int c, f32x4 v, int) {
      float4* xp = (float4*)(X + (size_t)(m0 + r) * 1024 + n0 + c);
      const float4 x = *xp;
      *xp = make_float4(ALPHA * x.x + v[0], ALPHA * x.y + v[1], ALPHA * x.z + v[2], ALPHA * x.w + v[3]);
    });
  }
}

__device__ void phase_ff1(const Params& p, unsigned char* lds, int layer, int bid, int nblk) {
  const bf16_t* A = (const bf16_t*)(p.ws + G_XB);
  const bf16_t* Bt = (const bf16_t*)(p.ws + G_WL + layer * WL_SIZE + O_WFF1);
  bf16_t* H = (bf16_t*)(p.ws + G_PROJ);
  constexpr int NT = 32, MT = MC / 128;
  for (int t = bid; t < NT * MT; t += nblk) {
    const int nt = t % NT, m0 = (t / NT) * 128, n0 = nt * 128;
    f32x4 acc[4][4]; zero_acc(acc);
    auto la = [=](int r, int kk) -> uint4 { return *(const uint4*)(A + (size_t)(m0 + r) * 1024 + kk); };
    auto lb = [=](int n, int kk) -> uint4 { return *(const uint4*)(Bt + (size_t)(n0 + n) * 1024 + kk); };
    gemm_acc(lds, 16, la, lb, acc);
    gemm_epi(acc, [=](int r, int c, f32x4 v, int) {
#pragma unroll
      for (int e = 0; e < 4; ++e) { const float x = fmaxf(v[e], 0.f); v[e] = x * x; }
      *(uint2*)(H + (size_t)(m0 + r) * 4096 + n0 + c) = pack4(v);
    });
  }
}

__device__ void run_phase(const Params& p, unsigned char* lds, int ph, int layer, int chunk, int bid, int nblk) {
  float* X = p.out + (size_t)chunk * MC * 1024;
  unsigned char* wl = p.ws + G_WL + layer * WL_SIZE;
  switch (ph) {
    case 0: phase0(p, lds, bid, nblk); break;
    case 1: ln_rows(p.in[0] + (size_t)chunk * MC * 1024, X, (bf16_t*)(p.ws + G_XB), p.in[1], p.in[2], MC, bid, nblk); break;
    case 2: phase_proj(p, lds, layer, bid, nblk); break;
    case 3: phase2(p, lds, layer, bid, nblk); break;
    case 4: phase3(p, lds, layer, bid, nblk); break;
    case 5: phase4(p, lds, layer, bid, nblk); break;
    case 6: phase5(p, lds, layer, bid, nblk); break;
    case 7: phase6(p, lds, layer, bid, nblk); break;
    case 8: phase_resid<1024>(p, lds, (const bf16_t*)(p.ws + G_MERGED), (const bf16_t*)(wl + O_WOUT), X, bid, nblk); break;
    case 9: ln_rows(X, X, (bf16_t*)(p.ws + G_XB), p.in[26] + layer * 1024, p.in[27] + layer * 1024, MC, bid, nblk); break;
    case 10: phase_ff1(p, lds, layer, bid, nblk); break;
    case 11: phase_resid<4096>(p, lds, (const bf16_t*)(p.ws + G_PROJ), (const bf16_t*)(wl + O_WFF2), X, bid, nblk); break;
    case 12: ln_rows(X, X, (bf16_t*)(p.ws + G_XB), p.in[30] + layer * 1024, p.in[31] + layer * 1024, MC, bid, nblk); break;
    default: break;
  }
}

#if !MEGA
template <int PH>
__global__ void __launch_bounds__(NTHR) k_one(Params p, int layer, int chunk) {
  __shared__ __attribute__((aligned(16))) unsigned char lds[LDS_BYTES];
  run_phase(p, lds, PH, layer, chunk, blockIdx.x, gridDim.x);
}
#else
__global__ void __launch_bounds__(NTHR, 2) k_mega(Params p) {
  __shared__ __attribute__((aligned(16))) unsigned char lds[LDS_BYTES];
  cg::grid_group grid = cg::this_grid();
  const int bid = blockIdx.x, nblk = gridDim.x;
  constexpr int PER_CHUNK = 1 + DEPTH * 11, NSTEP = 1 + NCH * PER_CHUNK;
#pragma unroll 1
  for (int step = 0; step < NSTEP; ++step) {
    int ph = 0, layer = 0, chunk = 0;
    if (step > 0) {
      const int s = step - 1, r = s % PER_CHUNK;
      chunk = s / PER_CHUNK;
      if (r == 0) ph = 1;
      else { layer = (r - 1) / 11; ph = 2 + (r - 1) % 11; }
    }
    run_phase(p, lds, ph, layer, chunk, bid, nblk);
    if (step + 1 < NSTEP) grid.sync();
  }
}
#endif

extern "C" void kernel_launch(void* const* d_in, const int* in_sizes, int n_in, void* d_out, int out_size, void* d_ws, size_t ws_size,
                              hipStream_t stream) {
  Params p{};
  for (int i = 0; i < 32; ++i) p.in[i] = (const float*)d_in[i];
  p.out = (float*)d_out;
  p.ws = (unsigned char*)d_ws;
#if MEGA
  static int grid_blocks = 0;
  if (!grid_blocks) {
    int dev = 0, cus = 0, per_cu = 0;
    hipGetDevice(&dev);
    hipDeviceGetAttribute(&cus, hipDeviceAttributeMultiprocessorCount, dev);
    hipOccupancyMaxActiveBlocksPerMultiprocessor(&per_cu, k_mega, NTHR, 0);
    if (per_cu > 2) per_cu = 2;
    grid_blocks = cus * per_cu;
  }
  void* args[] = {&p};
  hipLaunchCooperativeKernel((void*)k_mega, dim3(grid_blocks), dim3(NTHR), args, 0, stream);
#else
  const int grid = 512;
#define LAUNCH(PH, layer, chunk) k_one<PH><<<grid, NTHR, 0, stream>>>(p, layer, chunk)
  LAUNCH(0, 0, 0);
  for (int chunk = 0; chunk < NCH; ++chunk) {
    LAUNCH(1, 0, chunk);
    for (int layer = 0; layer < DEPTH; ++layer) {
      LAUNCH(2, layer, chunk); LAUNCH(3, layer, chunk); LAUNCH(4, layer, chunk); LAUNCH(5, layer, chunk);
      LAUNCH(6, layer, chunk); LAUNCH(7, layer, chunk); LAUNCH(8, layer, chunk); LAUNCH(9, layer, chunk);
      LAUNCH(10, layer, chunk); LAUNCH(11, layer, chunk); LAUNCH(12, layer, chunk);
    }
  }
#endif
}
```

```cpp
#include <hip/hip_runtime.h>
#include <hip/hip_cooperative_groups.h>
#include <type_traits>
namespace cg = cooperative_groups;

typedef unsigned short bf16_t;
typedef short bf16x8 __attribute__((ext_vector_type(8)));
typedef float f32x4 __attribute__((ext_vector_type(4)));
typedef unsigned long long u64;
typedef unsigned u32x4v __attribute__((ext_vector_type(4)));
typedef unsigned u32x2v __attribute__((ext_vector_type(2)));

constexpr int DM = 1024, NB = 8, SEQ = 4096, DEPTH = 2;
constexpr int CHB = 4;
constexpr int NCH = NB / CHB;
constexpr int MC = CHB * SEQ;
constexpr int INW = 5400, INP = 5632;
constexpr int C_SSM = 512, C_Q = 1024, C_KV = 1536, C_GN = 2304, C_GM = 2328;
constexpr int NROW = CHB * 64;
constexpr float ALPHA = 1.4142135623730951f;
constexpr int LDS_BYTES = 131072;
constexpr int NTHR = 512;
constexpr int NWV = NTHR / 64;

constexpr size_t al256(size_t x) { return (x + 255) & ~(size_t)255; }
constexpr size_t O_WIN = 0;
constexpr size_t O_WPOOL = O_WIN + (size_t)INP * 1024 * 2;
constexpr size_t O_WGLU = O_WPOOL + 4 * 128 * 128 * 2;
constexpr size_t O_WUP = O_WGLU + 512 * 512 * 2;
constexpr size_t O_WOUT = O_WUP + 3 * 1024 * 512 * 2;
constexpr size_t O_WFF1 = O_WOUT + 1024 * 1024 * 2;
constexpr size_t O_WFF2 = O_WFF1 + 4096 * 1024 * 2;
constexpr size_t O_WCK1 = O_WFF2 + 4096 * 1024 * 2;
constexpr size_t O_WCV1 = O_WCK1 + 128 * 2048 * 2;
constexpr size_t O_WCK2 = O_WCV1 + 128 * 2048 * 2;
constexpr size_t O_WCV2 = O_WCK2 + 64 * 128 * 2;
constexpr size_t O_BCK1 = O_WCV2 + 64 * 128 * 2;
constexpr size_t O_BCV1 = O_BCK1 + 512;
constexpr size_t O_KMAT = O_BCV1 + 512;
constexpr size_t O_EMAT = O_KMAT + 32 * 64 * 256 * 2;
constexpr size_t O_FMAT = O_EMAT + (size_t)32 * 128 * 1024 * 2;
constexpr size_t O_A64 = O_FMAT + (size_t)32 * 1024 * 128 * 2;
constexpr size_t WL_SIZE = al256(O_A64 + 32 * 64 * 2 * 4);
constexpr size_t G_WL = 0;
constexpr size_t G_ROPE = G_WL + 2 * WL_SIZE;
constexpr size_t G_XB = al256(G_ROPE + 4096 * 16 * 4);
constexpr size_t G_PROJ = al256(G_XB + (size_t)MC * 1024 * 4);
constexpr size_t G_Y = al256(G_PROJ + (size_t)MC * INP * 2);
constexpr size_t G_ZS = al256(G_Y + (size_t)MC * 1536 * 2);
constexpr size_t G_ONSA = al256(G_ZS + (size_t)MC * 512 * 2);
constexpr size_t G_S = al256(G_ONSA + (size_t)MC * 512 * 4);
constexpr size_t G_HIN = al256(G_S + (size_t)32 * NROW * 128 * 4);
constexpr size_t G_KCMP = al256(G_HIN + (size_t)32 * NROW * 128 * 2);
constexpr size_t G_VCMPT = al256(G_KCMP + (size_t)CHB * 2 * 256 * 64 * 2);
constexpr size_t G_H1 = al256(G_VCMPT + (size_t)CHB * 2 * 256 * 64 * 2);
constexpr size_t G_SEL = al256(G_H1 + (size_t)2 * CHB * 512 * 128 * 2);
constexpr size_t G_BAR = al256(G_SEL + (size_t)MC * 2 * 8);
constexpr size_t G_USSM = al256(G_BAR + 3456 * 4);
constexpr size_t G_END = al256(G_USSM + (size_t)32 * MC * 16 * 2);
static_assert(G_END <= (size_t)536870912, "workspace budget");
static_assert((size_t)MC * 4096 * 2 <= (size_t)MC * INP * 2, "H aliases PROJ");

struct Params {
  const float* in[32];
  float* out;
  unsigned char* ws;
};

__device__ __forceinline__ unsigned char* launder_ws(unsigned char* lds) {
  const volatile __attribute__((address_space(3))) unsigned* q = (const volatile __attribute__((address_space(3))) unsigned*)(lds + LDS_BYTES + 16);
  const unsigned lo = (unsigned)__builtin_amdgcn_readfirstlane((int)q[0]), hi = (unsigned)__builtin_amdgcn_readfirstlane((int)q[1]);
  return (unsigned char*)(((unsigned long long)hi << 32) | (unsigned long long)lo);
}
__device__ __forceinline__ int otid() { int t = threadIdx.x; asm volatile("" : "+v"(t)); return t; }
__device__ __forceinline__ float bf2f(bf16_t h) { return __uint_as_float(((unsigned)h) << 16); }
__device__ __forceinline__ bf16_t f2bf(float f) {
  unsigned u = __float_as_uint(f);
  u += 0x7fffu + ((u >> 16) & 1u);
  return (bf16_t)(u >> 16);
}
__device__ __forceinline__ unsigned pack2(float a, float b) { unsigned r; asm volatile("v_cvt_pk_bf16_f32 %0, %1, %2" : "=v"(r) : "v"(a), "v"(b)); return r; }
__device__ __forceinline__ uint2 pack4(f32x4 v) { uint2 r; r.x = pack2(v[0], v[1]); r.y = pack2(v[2], v[3]); return r; }
__device__ __forceinline__ f32x4 unpack4(uint2 u) {
  f32x4 r; r[0] = __uint_as_float(u.x << 16); r[1] = __uint_as_float(u.x & 0xffff0000u);
  r[2] = __uint_as_float(u.y << 16); r[3] = __uint_as_float(u.y & 0xffff0000u); return r;
}
__device__ __forceinline__ f32x4 unpack4v(u32x2v u) { uint2 t; t.x = u.x; t.y = u.y; return unpack4(t); }
__device__ __forceinline__ u32x2v pack4v(f32x4 v) { const uint2 t = pack4(v); u32x2v r; r.x = t.x; r.y = t.y; return r; }
#define GASQ __attribute__((address_space(1)))
__device__ __forceinline__ uint4 gld16(const void* q) { const u32x4v v = *(const GASQ u32x4v*)q; return make_uint4(v.x, v.y, v.z, v.w); }
__device__ __forceinline__ uint2 gld8(const void* q) { const u32x2v v = *(const GASQ u32x2v*)q; uint2 r; r.x = v.x; r.y = v.y; return r; }
__device__ __forceinline__ bf16x8 gld16b(const void* q) { return *(const GASQ bf16x8*)q; }
__device__ __forceinline__ float4 gldf4(const void* q) { const f32x4 v = *(const GASQ f32x4*)q; return make_float4(v[0], v[1], v[2], v[3]); }
__device__ __forceinline__ void gst8(void* q, uint2 v) { u32x2v t; t.x = v.x; t.y = v.y; *(GASQ u32x2v*)q = t; }
__device__ __forceinline__ void gstf4(void* q, float4 v) { *(GASQ f32x4*)q = (f32x4){v.x, v.y, v.z, v.w}; }
__device__ __forceinline__ float sigmoidf_(float x) { return __builtin_amdgcn_rcpf(1.0f + __builtin_amdgcn_exp2f(-1.4426950408889634f * x)); }
__device__ __forceinline__ float gelu_tanh(float x) {
  float u = 0.7978845608028654f * (x + 0.044715f * x * x * x);
  return x * __builtin_amdgcn_rcpf(1.0f + __builtin_amdgcn_exp2f(-2.8853900817779268f * u));
}
__device__ __forceinline__ float shx(float v, int mask, int lane) { return __int_as_float(__builtin_amdgcn_ds_bpermute((lane ^ mask) << 2, __float_as_int(v))); }
__device__ __forceinline__ unsigned shxu(unsigned v, int mask, int lane) { return (unsigned)__builtin_amdgcn_ds_bpermute((lane ^ mask) << 2, (int)v); }
__device__ __forceinline__ float wave_sum(float v, int lane) {
#pragma unroll
  for (int o = 32; o >= 1; o >>= 1) v += shx(v, o, lane);
  return v;
}

namespace pg8 {
#define PG8_LAS __attribute__((address_space(3)))
typedef unsigned short bf16_t;
typedef short bf16x8 __attribute__((ext_vector_type(8)));
typedef float f32x4 __attribute__((ext_vector_type(4)));
typedef unsigned u32x4 __attribute__((ext_vector_type(4)));
constexpr int BM = 256, BK = 64, HALF = 128, HTB = HALF * BK * 2  , STAGE_BYTES = 8 * HTB, NXCD = 8, WGM = 8;

__host__ __device__ __forceinline__ int lds_byte(int r, int c) { const int st = (r >> 4) * 2 + (c >> 5), rr = r & 15, cc = c & 31, ob = rr * 64 + cc * 2; return st * 1024 + (ob ^ (((ob >> 9) & 1) << 5)); }
__host__ __device__ __forceinline__ void stage_rc(int b, int& R, int& C) { const int st = b / 1024, sb = b % 1024, swz = sb ^ (((sb >> 9) & 1) << 5); R = (st >> 1) * 16 + swz / 64; C = (st & 1) * 32 + (swz % 64) / 2; }
__host__ __device__ __forceinline__ int perm32(int rho) { const int n = rho >> 4, i = rho & 15; return 8 * (i >> 2) + 4 * n + (i & 3); }

struct Gemm { const bf16_t* A; const bf16_t* Bt; int M, N, K; };

struct Unit { int pm, pn; };
struct StaticOrder {
    int nM, nN, nwg, G, c;
    __host__ __device__ void init(int M, int N, int G_, int c_) { nM = M / BM; nN = N / BM; nwg = nM * nN; G = G_; c = c_; }
    __host__ __device__ bool next(int i, Unit& u) const {
        const long L = (long)i * G + c; if (L >= nwg) return false;
        int wgid = (int)L; { const int q = nwg / NXCD, r = nwg % NXCD, xcd = wgid % NXCD, off = wgid / NXCD; wgid = (xcd < r ? xcd * (q + 1) : r * (q + 1) + (xcd - r) * q) + off; }
        const int nig = WGM * nN, gid = wgid / nig, fm = gid * WGM, gsz = (nM - fm) < WGM ? (nM - fm) : WGM;
        u.pm = fm + ((wgid % nig) % gsz); u.pn = (wgid % nig) / gsz; return true;
    }
    __device__ __forceinline__ void a_ready(const Unit&) const {}
    __device__ __forceinline__ size_t a_off(const Unit&) const { return 0; }
    __device__ __forceinline__ void done(const Unit&) const {}
};

struct MergeOrder {
    StaticOrder base;
    __host__ __device__ void init(int G_, int c_) { base.init(MC, 1024, G_, c_); }
    __host__ __device__ bool next(int i, Unit& u) const { Unit b; if (!base.next(i / 3, b)) return false; u.pm = b.pm; u.pn = (i % 3) * 4 + b.pn; return true; }
    __device__ __forceinline__ void a_ready(const Unit&) const {}
    __device__ __forceinline__ void done(const Unit&) const {}
    __device__ __forceinline__ size_t a_off(const Unit& u) const { return (size_t)(u.pn >> 2) * ((size_t)MC * 512 * 2); }
};
struct EpiProj {
  static constexpr bool PERM = false, AFTER_DRAIN = false, MID = false;
  bf16_t* PROJ; const float* rope; int coff; bf16_t* USSM;
  __device__ __forceinline__ void operator()(const f32x4 (&acc)[2][2][4][2], const Unit& u, int wr, int wc, int fr, int fq) const {
#pragma unroll
    for (int bj = 0; bj < 2; ++bj) {
      const int cb = coff + u.pn * BM + bj * HALF + wc * 32;
      const int jg = (cb - C_Q) >> 6;
      const bool inqkv = (cb >= C_Q) && (cb < C_GN);
      const bool roped = inqkv && ((cb & 32) == 0) && (jg < 8 || (((jg - 8) & 2) == 0));
      const bool isq = (cb >= C_Q) && (cb < C_KV);
      const bool isgate = cb >= C_GN;
      const bool isssm = (cb >= C_SSM) && (cb < C_Q);
#pragma unroll
      for (int ai = 0; ai < 2; ++ai) {
        float4 csr[4], snr[4];
#pragma unroll
        for (int m = 0; m < 4; ++m) {
          if (roped) {
            const int pos = (u.pm * BM + ai * HALF + wr * 64 + m * 16 + fr) & (SEQ - 1);
            csr[m] = gldf4(rope + pos * 16 + (fq & 1) * 4); snr[m] = gldf4(rope + pos * 16 + 8 + (fq & 1) * 4);
          } else { csr[m] = make_float4(0.f, 0.f, 0.f, 0.f); snr[m] = make_float4(0.f, 0.f, 0.f, 0.f); }
        }
#pragma unroll
        for (int m = 0; m < 4; ++m) {
          const int row = u.pm * BM + ai * HALF + wr * 64 + m * 16 + fr;
#pragma unroll
          for (int n = 0; n < 2; ++n) {
            f32x4 v = acc[ai][bj][m][n];
            if (isgate) {
#pragma unroll
              for (int e = 0; e < 4; ++e) v[e] = sigmoidf_(v[e]);
            } else if (roped && n == 0) {
              const float csv[4] = {csr[m].x, csr[m].y, csr[m].z, csr[m].w}, snv[4] = {snr[m].x, snr[m].y, snr[m].z, snr[m].w};
#pragma unroll
              for (int e = 0; e < 4; ++e) {
                const float pv = shx(v[e], 32, fq * 16 + fr);
                v[e] = (fq < 2) ? (v[e] * csv[e] - pv * snv[e]) : (pv * snv[e] + v[e] * csv[e]);
              }
            }
            if (isq) {
#pragma unroll
              for (int e = 0; e < 4; ++e) v[e] *= 0.18033688011112042f;
            }
            if (isssm) gst8(USSM + ((size_t)(((cb - C_SSM) >> 4) + n) * MC + row) * 16 + 4 * fq, pack4(v));
            else gst8(PROJ + (size_t)row * INP + cb + n * 16 + 4 * fq, pack4(v));
          }
        }
        asm volatile("" ::: "memory");
      }
    }
  }
};
struct EpiRelu2 {
  static constexpr bool PERM = true, AFTER_DRAIN = false, MID = false;
  bf16_t* O; int ldc;
  __device__ __forceinline__ void operator()(const f32x4 (&acc)[2][2][4][2], const Unit& u, int wr, int wc, int fr, int fq) const {
    int row0 = u.pm * BM + wr * 64 + fr, col0 = u.pn * BM + wc * 32 + 8 * fq;
    asm volatile("" : "+v"(row0), "+v"(col0));
#pragma unroll
    for (int ai = 0; ai < 2; ++ai)
#pragma unroll
      for (int m = 0; m < 4; ++m) {
        bf16_t* rowp = O + (size_t)(row0 + ai * HALF + m * 16) * ldc + col0;
#pragma unroll
        for (int bj = 0; bj < 2; ++bj) {
          f32x4 v0 = acc[ai][bj][m][0], v1 = acc[ai][bj][m][1];
#pragma unroll
          for (int e = 0; e < 4; ++e) { const float a = fmaxf(v0[e], 0.f), b = fmaxf(v1[e], 0.f); v0[e] = a * a; v1[e] = b * b; }
          u32x4 w; w.x = pack2(v0[0], v0[1]); w.y = pack2(v0[2], v0[3]); w.z = pack2(v1[0], v1[1]); w.w = pack2(v1[2], v1[3]);
          *(u32x4*)(rowp + bj * HALF) = w;
        }
      }
  }
};
#define GAS __attribute__((address_space(1)))
struct EpiResid {
  static constexpr bool PERM = false, AFTER_DRAIN = false, MID = false;
  float* X; const bf16_t* XBr;
  __device__ __forceinline__ void operator()(const f32x4 (&acc)[2][2][4][2], const Unit& u, int wr, int wc, int fr, int fq) const {
    int row0 = u.pm * BM + wr * 64 + fr, col0 = u.pn * BM + wc * 32 + 4 * fq;
    asm volatile("" : "+v"(row0), "+v"(col0));
    const GAS bf16_t* xb = (const GAS bf16_t*)XBr; GAS float* xo = (GAS float*)X;
#pragma unroll
    for (int ai = 0; ai < 2; ++ai) {
      u32x2v xv[4][2][2];
#pragma unroll
      for (int m = 0; m < 4; ++m)
#pragma unroll
        for (int bj = 0; bj < 2; ++bj)
#pragma unroll
          for (int n = 0; n < 2; ++n) xv[m][bj][n] = *(const GAS u32x2v*)(xb + (size_t)(row0 + ai * HALF + m * 16) * 1024 + col0 + bj * HALF + n * 16);
#pragma unroll
      for (int m = 0; m < 4; ++m)
#pragma unroll
        for (int bj = 0; bj < 2; ++bj)
#pragma unroll
          for (int n = 0; n < 2; ++n)
            *(GAS f32x4*)(xo + (size_t)(row0 + ai * HALF + m * 16) * 1024 + col0 + bj * HALF + n * 16) = unpack4v(xv[m][bj][n]) * ALPHA + acc[ai][bj][m][n];
      asm volatile("" ::: "memory");
    }
  }
};
struct EpiMerge {
  static constexpr bool PERM = false, AFTER_DRAIN = false, MID = true;
  const bf16_t* PROJ; bf16_t* MG;
  __device__ __forceinline__ static f32x4 clampg(f32x4 g) { f32x4 r; for (int e = 0; e < 4; ++e) r[e] = fmaxf(g[e], 1e-30f); return r; }
  __device__ __forceinline__ void mid(f32x4 (&acc)[2][2][4][2], const Unit& u, int t, int wr, int wc, int fr, int fq) const {
    const int seg = (t == 8) ? 0 : 1;
    int row0 = u.pm * BM + wr * 64 + fr, col0 = u.pn * BM + wc * 32 + 4 * fq;
    asm volatile("" : "+v"(row0), "+v"(col0));
    const GAS bf16_t* pg = (const GAS bf16_t*)PROJ;
#pragma unroll
    for (int ai = 0; ai < 2; ++ai)
#pragma unroll
      for (int mh = 0; mh < 2; ++mh) {
        u32x2v ga[2][2][2], gb[2][2][2];
#pragma unroll
        for (int mm = 0; mm < 2; ++mm)
#pragma unroll
          for (int bj = 0; bj < 2; ++bj)
#pragma unroll
            for (int n = 0; n < 2; ++n) {
              const GAS bf16_t* gp = pg + (size_t)(row0 + ai * HALF + (mh * 2 + mm) * 16) * INP + C_GM + seg * 1024 + col0 + bj * HALF + n * 16;
              ga[mm][bj][n] = *(const GAS u32x2v*)gp; gb[mm][bj][n] = *(const GAS u32x2v*)(gp + 1024);
            }
#pragma unroll
        for (int mm = 0; mm < 2; ++mm)
#pragma unroll
          for (int bj = 0; bj < 2; ++bj)
#pragma unroll
            for (int n = 0; n < 2; ++n) {
              const f32x4 a = clampg(unpack4v(ga[mm][bj][n])), b = clampg(unpack4v(gb[mm][bj][n]));
              f32x4 r;
#pragma unroll
              for (int e = 0; e < 4; ++e) r[e] = a[e] * __builtin_amdgcn_rcpf(b[e]);
              acc[ai][bj][mh * 2 + mm][n] *= r;
            }
        asm volatile("" ::: "memory");
      }
  }
  __device__ __forceinline__ void operator()(const f32x4 (&acc)[2][2][4][2], const Unit& u, int wr, int wc, int fr, int fq) const {
    int row0 = u.pm * BM + wr * 64 + fr, col0 = u.pn * BM + wc * 32 + 4 * fq;
    asm volatile("" : "+v"(row0), "+v"(col0));
    const GAS bf16_t* pg = (const GAS bf16_t*)PROJ; GAS bf16_t* mg = (GAS bf16_t*)MG;
#pragma unroll
    for (int ai = 0; ai < 2; ++ai) {
      u32x2v gv[4][2][2];
#pragma unroll
      for (int m = 0; m < 4; ++m)
#pragma unroll
        for (int bj = 0; bj < 2; ++bj)
#pragma unroll
          for (int n = 0; n < 2; ++n) gv[m][bj][n] = *(const GAS u32x2v*)(pg + (size_t)(row0 + ai * HALF + m * 16) * INP + C_GM + 2 * 1024 + col0 + bj * HALF + n * 16);
#pragma unroll
      for (int m = 0; m < 4; ++m)
#pragma unroll
        for (int bj = 0; bj < 2; ++bj)
#pragma unroll
          for (int n = 0; n < 2; ++n)
            *(GAS u32x2v*)(mg + (size_t)(row0 + ai * HALF + m * 16) * 1024 + col0 + bj * HALF + n * 16) = pack4v(clampg(unpack4v(gv[m][bj][n])) * acc[ai][bj][m][n]);
      asm volatile("" ::: "memory");
    }
  }
};
template <class Epi, class Sched, bool STAMP = false>
__device__ __forceinline__ void gemm_phase(PG8_LAS unsigned char* lds, const Gemm g, const Sched& S, const Epi& E, unsigned long long* stamps) {
    const int tid = otid(), wid = __builtin_amdgcn_readfirstlane(tid >> 6), lane = tid & 63, wr = wid >> 2, wc = wid & 3, fr = lane & 15, fq = lane >> 4;
    const int K = g.K, nt = K / BK;
    int ts_lo = 0, ts_hi = 0, nts = 0; const unsigned long long rt_entry = STAMP ? (unsigned long long)wall_clock64() : 0ull;
#define PG8_STAMP() do { if (STAMP && wid == 0 && nts < 64) { const unsigned long long _c = (unsigned long long)clock64(); \
        ts_lo = (lane == nts) ? (int)(unsigned)_c : ts_lo; ts_hi = (lane == nts) ? (int)(unsigned)(_c >> 32) : ts_hi; ++nts; } } while (0)
    PG8_STAMP();
    unsigned voffA[2], voffB[2];
#pragma unroll
    for (int i = 0; i < 2; ++i) { int R, C; stage_rc(tid * 16 + i * 8192, R, C); const int Rb = Epi::PERM ? ((R & ~31) + perm32(R & 31)) : R;
        voffA[i] = (unsigned)(R * K + C) * 2u; voffB[i] = (unsigned)(Rb * K + C) * 2u; }
    const size_t kstep = (size_t)(BK * 2);
    const size_t hstep = (size_t)HALF * K * 2;
    const size_t tstep = 2 * hstep;
    const unsigned ldsw = (unsigned)wid * 1024u;
    const int aoff = lds_byte(wr * 64 + fr, fq * 8), boff = lds_byte(wc * 32 + fr, fq * 8);
#define PG8_SA(b, h) (((b) * 2 + (h)) * HTB)
#define PG8_SB(b, h) ((4 + (b) * 2 + (h)) * HTB)
#define PG8_STAGE(bufoff, gbase, voff) do { _Pragma("unroll") for (int _i = 0; _i < 2; ++_i) \
        __builtin_amdgcn_global_load_lds((const unsigned*)((const char*)(gbase) + (voff)[_i]), (PG8_LAS unsigned*)(lds + (bufoff) + ldsw + _i * 8192), 16, 0, 0); } while (0)
#define PG8_LDA(dst, b, h) do { _Pragma("unroll") for (int m = 0; m < 4; ++m) _Pragma("unroll") for (int k = 0; k < 2; ++k) dst[m][k] = *(const PG8_LAS bf16x8*)(lds + PG8_SA(b, h) + aoff + m * 2048 + k * 1024); } while (0)
#define PG8_LDB(dst, b, h) do { _Pragma("unroll") for (int n = 0; n < 2; ++n) _Pragma("unroll") for (int k = 0; k < 2; ++k) dst[n][k] = *(const PG8_LAS bf16x8*)(lds + PG8_SB(b, h) + boff + n * 2048 + k * 1024); } while (0)
#define PG8_MMA(ai, bj, At, Bt) do { __builtin_amdgcn_s_setprio(1); _Pragma("unroll") for (int m = 0; m < 4; ++m) _Pragma("unroll") for (int n = 0; n < 2; ++n) _Pragma("unroll") for (int k = 0; k < 2; ++k) \
        acc[ai][bj][m][n] = __builtin_amdgcn_mfma_f32_16x16x32_bf16(Bt[n][k], At[m][k], acc[ai][bj][m][n], 0, 0, 0); __builtin_amdgcn_s_setprio(0); } while (0)
#define PG8_WAIT_V(n) asm volatile("s_waitcnt vmcnt(" #n ")" ::: "memory")
#define PG8_WAIT_L(n) asm volatile("s_waitcnt lgkmcnt(" #n ")" ::: "memory")
#define PG8_BAR __builtin_amdgcn_s_barrier()
#define PG8_SCHED __builtin_amdgcn_sched_barrier(0)
    Unit cur, nxt; int ui = 0;
    if (!S.next(0, cur)) return;
    f32x4 acc[2][2][4][2];
#pragma unroll
    for (int a = 0; a < 2; ++a)
#pragma unroll
        for (int b = 0; b < 2; ++b)
#pragma unroll
            for (int m = 0; m < 4; ++m)
#pragma unroll
                for (int n = 0; n < 2; ++n) acc[a][b][m][n] = (f32x4){0.f, 0.f, 0.f, 0.f};
    bf16x8 At[4][2], B0[2][2], B1[2][2];
    const char* cA = (const char*)g.A + (size_t)cur.pm * tstep + S.a_off(cur); const char* cB = (const char*)g.Bt + (size_t)cur.pn * tstep;
    S.a_ready(cur);
    PG8_STAGE(PG8_SB(0, 0), cB, voffB); PG8_STAGE(PG8_SA(0, 0), cA, voffA); PG8_STAGE(PG8_SB(0, 1), cB + hstep, voffB); PG8_STAGE(PG8_SA(0, 1), cA + hstep, voffA);
    if (wr == 1) PG8_BAR;
    PG8_WAIT_V(4); PG8_BAR;
    PG8_STAGE(PG8_SB(1, 0), cB + kstep, voffB); PG8_STAGE(PG8_SA(1, 0), cA + kstep, voffA); PG8_STAGE(PG8_SB(1, 1), cB + hstep + kstep, voffB);
    PG8_WAIT_V(6); PG8_BAR;
    PG8_STAMP();
    for (;;) {
        const bool has_next = S.next(ui + 1, nxt);
        const char* nA = has_next ? (const char*)g.A + (size_t)nxt.pm * tstep + S.a_off(nxt) : cA; const char* nB = has_next ? (const char*)g.Bt + (size_t)nxt.pn * tstep : cB;
        for (int t = 0; t < nt; t += 2) {
            if constexpr (Epi::MID) { if (t == 8 || t == 16) E.mid(acc, cur, t, wr, wc, fr, fq); }
            const bool last = (t == nt - 2);
            const char* a1 = cA + (size_t)(t + 1) * kstep;
            const char* a2 = last ? nA : cA + (size_t)(t + 2) * kstep; const char* b2 = last ? nB : cB + (size_t)(t + 2) * kstep;
            const char* a3 = a2 + kstep; const char* b3 = b2 + kstep;
            if (last && has_next) S.a_ready(nxt);
            PG8_LDB(B0, 0, 0); PG8_SCHED; PG8_LDA(At, 0, 0); PG8_STAGE(PG8_SA(1, 1), a1 + hstep, voffA);
            PG8_WAIT_L(8); PG8_BAR; PG8_WAIT_L(0); PG8_MMA(0, 0, At, B0); PG8_BAR; PG8_SCHED;
            PG8_LDB(B1, 0, 1); PG8_STAGE(PG8_SB(0, 0), b2, voffB);
            PG8_BAR; PG8_WAIT_L(0); PG8_MMA(0, 1, At, B1); PG8_BAR;
            PG8_LDA(At, 0, 1); PG8_STAGE(PG8_SA(0, 0), a2, voffA);
            PG8_BAR; PG8_WAIT_L(0); PG8_MMA(1, 0, At, B0); PG8_BAR; PG8_SCHED;
            PG8_STAGE(PG8_SB(0, 1), b2 + hstep, voffB);
            PG8_WAIT_V(6); PG8_BAR; PG8_MMA(1, 1, At, B1); PG8_BAR;
            PG8_LDB(B0, 1, 0); PG8_SCHED; PG8_LDA(At, 1, 0); PG8_STAGE(PG8_SA(0, 1), a2 + hstep, voffA);
            PG8_WAIT_L(8); PG8_BAR; PG8_WAIT_L(0); PG8_MMA(0, 0, At, B0); PG8_BAR; PG8_SCHED;
            PG8_LDB(B1, 1, 1); PG8_STAGE(PG8_SB(1, 0), b3, voffB);
            PG8_BAR; PG8_WAIT_L(0); PG8_MMA(0, 1, At, B1); PG8_BAR;
            PG8_LDA(At, 1, 1); PG8_STAGE(PG8_SA(1, 0), a3, voffA);
            PG8_BAR; PG8_WAIT_L(0); PG8_MMA(1, 0, At, B0); PG8_BAR; PG8_SCHED;
            PG8_STAGE(PG8_SB(1, 1), b3 + hstep, voffB);
            PG8_WAIT_V(6); PG8_BAR; PG8_MMA(1, 1, At, B1); PG8_BAR;
        }
        PG8_STAMP();
        if constexpr (!Epi::AFTER_DRAIN) { E(acc, cur, wr, wc, fr, fq); S.done(cur); }
        PG8_STAMP();
        if (!has_next) break;
#pragma unroll
        for (int a = 0; a < 2; ++a)
#pragma unroll
            for (int b = 0; b < 2; ++b)
#pragma unroll
                for (int m = 0; m < 4; ++m)
#pragma unroll
                    for (int n = 0; n < 2; ++n) acc[a][b][m][n] = (f32x4){0.f, 0.f, 0.f, 0.f};
        cur = nxt; cA = nA; cB = nB; ++ui;
    }
    PG8_WAIT_V(0);
    if (wr == 0) PG8_BAR;
    PG8_BAR;
    if constexpr (Epi::AFTER_DRAIN) { E.fused(acc, cur, wr, wc, fr, fq, lds, wid, lane); S.done(cur); }
    PG8_STAMP();
    if (STAMP && wid == 0) { stamps[lane] = lane < nts ? (((unsigned long long)(unsigned)ts_hi << 32) | (unsigned)ts_lo) : 0ull;
        if (lane == 62) stamps[62] = rt_entry; if (lane == 63) stamps[63] = (unsigned long long)wall_clock64(); }
#undef PG8_STAMP
#undef PG8_SA
#undef PG8_SB
#undef PG8_STAGE
#undef PG8_LDA
#undef PG8_LDB
#undef PG8_MMA
#undef PG8_WAIT_V
#undef PG8_WAIT_L
#undef PG8_BAR
#undef PG8_SCHED
}
}

template <class LA, class LB>
__device__ __forceinline__ void gemm_acc(unsigned char* lds, int nk, const LA& la, const LB& lb, f32x4 (&acc)[4][2]) {
  const int tid = otid(), lane = tid & 63, wid = tid >> 6, wr = wid >> 2, wc = wid & 3, fr = lane & 15, fq = lane >> 4;
  bf16_t* sA = (bf16_t*)lds;
  bf16_t* sB = sA + 128 * 72;
  const int lrow = tid >> 3, lk = (tid & 7) * 8;
  uint4 ra[2][2], rb[2][2];
#pragma unroll
  for (int i = 0; i < 2; ++i) { ra[0][i] = la(lrow + i * 64, lk); rb[0][i] = lb(lrow + i * 64, lk); }
  if (nk > 1) {
#pragma unroll
    for (int i = 0; i < 2; ++i) { ra[1][i] = la(lrow + i * 64, 64 + lk); rb[1][i] = lb(lrow + i * 64, 64 + lk); }
  } else {
#pragma unroll
    for (int i = 0; i < 2; ++i) { ra[1][i] = make_uint4(0, 0, 0, 0); rb[1][i] = make_uint4(0, 0, 0, 0); }
  }
  for (int kt = 0; kt < nk; kt += 2) {
#pragma unroll
    for (int st = 0; st < 2; ++st) {
      if (kt + st < nk) {
        __syncthreads();
#pragma unroll
        for (int i = 0; i < 2; ++i) {
          *(uint4*)(sA + (lrow + i * 64) * 72 + lk) = ra[st][i];
          *(uint4*)(sB + (lrow + i * 64) * 72 + lk) = rb[st][i];
        }
        __syncthreads();
        if (kt + st + 2 < nk) {
#pragma unroll
          for (int i = 0; i < 2; ++i) { ra[st][i] = la(lrow + i * 64, (kt + st + 2) * 64 + lk); rb[st][i] = lb(lrow + i * 64, (kt + st + 2) * 64 + lk); }
        }
#pragma unroll
        for (int ks = 0; ks < 2; ++ks) {
          bf16x8 af[4], bfr[2];
#pragma unroll
          for (int mi = 0; mi < 4; ++mi) af[mi] = *(const bf16x8*)(sA + (wr * 64 + mi * 16 + fr) * 72 + ks * 32 + fq * 8);
#pragma unroll
          for (int ni = 0; ni < 2; ++ni) bfr[ni] = *(const bf16x8*)(sB + (wc * 32 + ni * 16 + fr) * 72 + ks * 32 + fq * 8);
#pragma unroll
          for (int mi = 0; mi < 4; ++mi)
#pragma unroll
            for (int ni = 0; ni < 2; ++ni) acc[mi][ni] = __builtin_amdgcn_mfma_f32_16x16x32_bf16(bfr[ni], af[mi], acc[mi][ni], 0, 0, 0);
        }
      }
    }
  }
}
__device__ __forceinline__ void zero_acc(f32x4 (&acc)[4][2]) {
#pragma unroll
  for (int i = 0; i < 4; ++i)
#pragma unroll
    for (int j = 0; j < 2; ++j) acc[i][j] = (f32x4){0.f, 0.f, 0.f, 0.f};
}
template <class LD>
__device__ __forceinline__ void gemm_pre(uint2 (&pre)[4][2], const LD& ld) {
  const int tid = otid(), lane = tid & 63, wid = tid >> 6, wr = wid >> 2, wc = wid & 3, fr = lane & 15, fq = lane >> 4;
#pragma unroll
  for (int mi = 0; mi < 4; ++mi)
#pragma unroll
    for (int ni = 0; ni < 2; ++ni) pre[mi][ni] = ld(wr * 64 + mi * 16 + fr, wc * 32 + ni * 16 + fq * 4);
}
template <class EP>
__device__ __forceinline__ void gemm_epi_pre(const f32x4 (&acc)[4][2], const uint2 (&pre)[4][2], const EP& ep) {
  const int tid = otid(), lane = tid & 63, wid = tid >> 6, wr = wid >> 2, wc = wid & 3, fr = lane & 15, fq = lane >> 4;
#pragma unroll
  for (int mi = 0; mi < 4; ++mi)
#pragma unroll
    for (int ni = 0; ni < 2; ++ni) ep(wr * 64 + mi * 16 + fr, wc * 32 + ni * 16 + fq * 4, acc[mi][ni], pre[mi][ni], ni);
}
template <class EP>
__device__ __forceinline__ void gemm_epi(const f32x4 (&acc)[4][2], const EP& ep) {
  const int tid = otid(), lane = tid & 63, wid = tid >> 6, wr = wid >> 2, wc = wid & 3, fr = lane & 15, fq = lane >> 4;
#pragma unroll
  for (int mi = 0; mi < 4; ++mi)
#pragma unroll
    for (int ni = 0; ni < 2; ++ni) ep(wr * 64 + mi * 16 + fr, wc * 32 + ni * 16 + fq * 4, acc[mi][ni], ni);
}

__device__ void transpose_job(unsigned char* lds, const float* src, bf16_t* dst, int K, int N, int Npad, int bid, int nblk, int ldd = 0) {
  if (ldd == 0) ldd = K;
  float* sm = (float*)lds;
  const int tid = otid();
  const int tk = K / 64, tn = Npad / 64, ntile = tk * tn;
  const int rr = tid >> 4, c4 = (tid & 15) * 4;
  const int wn = tid & 63, wk = (tid >> 6) * 8;
  float4 cur[2], nxt[2];
  auto ldtile = [&](int t, float4 (&v)[2]) {
    const int k0 = (t % tk) * 64, n0 = (t / tk) * 64;
#pragma unroll
    for (int i = 0; i < 2; ++i)
      v[i] = (n0 + c4 < N) ? gldf4(src + (size_t)(k0 + rr + 32 * i) * N + n0 + c4) : make_float4(0.f, 0.f, 0.f, 0.f);
  };
#pragma unroll
  for (int i = 0; i < 2; ++i) { cur[i] = make_float4(0.f, 0.f, 0.f, 0.f); nxt[i] = cur[i]; }
  if (bid < ntile) ldtile(bid, cur);
  for (int t = bid; t < ntile; t += nblk) {
    const int k0 = (t % tk) * 64, n0 = (t / tk) * 64;
    if (t + nblk < ntile) ldtile(t + nblk, nxt);
    __syncthreads();
#pragma unroll
    for (int i = 0; i < 2; ++i) *(float4*)(sm + (rr + 32 * i) * 68 + c4) = cur[i];
    __syncthreads();
    {
      float v[8];
#pragma unroll
      for (int e = 0; e < 8; ++e) v[e] = sm[(wk + e) * 68 + wn];
      uint4 o; o.x = pack2(v[0], v[1]); o.y = pack2(v[2], v[3]); o.z = pack2(v[4], v[5]); o.w = pack2(v[6], v[7]);
      u32x4v ov; ov.x = o.x; ov.y = o.y; ov.z = o.z; ov.w = o.w;
      *(GASQ u32x4v*)(dst + (size_t)(n0 + wn) * ldd + k0 + wk) = ov;
    }
#pragma unroll
    for (int i = 0; i < 2; ++i) cur[i] = nxt[i];
  }
}

__device__ __forceinline__ void sincos_f(float ang, float& s, float& c) {
  const float q = rintf(ang * 0.15915494309189535f);
  float r = fmaf(-q, 6.28125f, ang);
  r = fmaf(-q, 0.001934051513671875f, r);
  r = fmaf(-q, 1.255665914356996e-06f, r);
  s = __sinf(r); c = __cosf(r);
}

__device__ void phase0(const Params& p, unsigned char* lds, int bid, int nblk) {
  unsigned char* WS = launder_ws(lds);
  const int tid = otid();
  for (int layer = 0; layer < DEPTH; ++layer) {
    unsigned char* wl = WS + G_WL + layer * WL_SIZE;
    transpose_job(lds, p.in[3] + (size_t)layer * 1024 * INW, (bf16_t*)(wl + O_WIN), 1024, INW, INP, bid, nblk);
    for (int g = 0; g < 4; ++g)
      transpose_job(lds, p.in[4] + (size_t)(layer * 4 + g) * 128 * 128, (bf16_t*)(wl + O_WPOOL) + g * 128 * 128, 128, 128, 128, bid, nblk);
    transpose_job(lds, p.in[14] + (size_t)layer * 512 * 512, (bf16_t*)(wl + O_WGLU), 512, 512, 512, bid, nblk);
    for (int i = 0; i < 3; ++i)
      transpose_job(lds, p.in[22 + i] + (size_t)layer * 512 * 1024, (bf16_t*)(wl + O_WUP) + (size_t)i * 512, 512, 1024, 1024, bid, nblk, 1536);
    transpose_job(lds, p.in[25] + (size_t)layer * 1024 * 1024, (bf16_t*)(wl + O_WOUT), 1024, 1024, 1024, bid, nblk);
    transpose_job(lds, p.in[28] + (size_t)layer * 1024 * 4096, (bf16_t*)(wl + O_WFF1), 1024, 4096, 4096, bid, nblk);
    transpose_job(lds, p.in[29] + (size_t)layer * 4096 * 1024, (bf16_t*)(wl + O_WFF2), 4096, 1024, 1024, bid, nblk);
    transpose_job(lds, p.in[18] + (size_t)layer * 2048 * 128, (bf16_t*)(wl + O_WCK1), 2048, 128, 128, bid, nblk);
    transpose_job(lds, p.in[20] + (size_t)layer * 2048 * 128, (bf16_t*)(wl + O_WCV1), 2048, 128, 128, bid, nblk);
    transpose_job(lds, p.in[19] + (size_t)layer * 128 * 64, (bf16_t*)(wl + O_WCK2), 128, 64, 64, bid, nblk);
    transpose_job(lds, p.in[21] + (size_t)layer * 128 * 64, (bf16_t*)(wl + O_WCV2), 128, 64, 64, bid, nblk);
  }
  {
    float* rope = (float*)(WS + G_ROPE);
    for (int idx = bid * NTHR + tid; idx < 4096 * 8; idx += nblk * NTHR) {
      int pos = idx >> 3, i = idx & 7;
      const float inv = (i == 0) ? 1.0f : (i == 1) ? 0.19392274474868576f : (i == 2) ? 0.03760603093086393f : (i == 3) ? 0.007292664737217109f
                      : (i == 4) ? 0.001414213562373095f : (i == 5) ? 0.0002742481756762073f : (i == 6) ? 5.318295896944988e-05f : 1.031338537721246e-05f;
      float sn, cs; sincos_f((float)pos * inv, sn, cs);
      rope[pos * 16 + i] = cs; rope[pos * 16 + 8 + i] = sn;
    }
  }
  for (int it = bid; it < DEPTH * 2 * 8; it += nblk) {
    const int layer = it >> 4, kv = (it >> 3) & 1, j0 = (it & 7) * 16;
    const float* pe = p.in[16 + kv] + (size_t)layer * 2048;
    const float* w1 = p.in[kv ? 20 : 18] + (size_t)layer * 2048 * 128;
    float* sm = (float*)lds;
    const int jj = tid & 15, part = tid >> 4;
    float acc = 0.f;
#pragma unroll 8
    for (int i = 0; i < 64; ++i) { const int kk = part + i * 32; acc += pe[kk] * w1[(size_t)kk * 128 + j0 + jj]; }
    __syncthreads();
    sm[tid] = acc;
    __syncthreads();
    if (tid < 16) {
      float t = 0.f;
      for (int q = 0; q < 32; ++q) t += sm[q * 16 + tid];
      ((float*)(WS + G_WL + layer * WL_SIZE + (kv ? O_BCV1 : O_BCK1)))[j0 + tid] = t;
    }
    __syncthreads();
  }
  for (int it = bid; it < DEPTH * 32 * 9; it += nblk) {
    const int layer = it / (32 * 9), rem = it % (32 * 9), g = rem / 9, dg = rem % 9;
    unsigned char* wl = WS + G_WL + layer * WL_SIZE;
    float* pwr = (float*)lds; float* pwi = pwr + 64; float* kr = pwi + 64; float* ki = kr + 64; float* th1s = ki + 64; float* lrs = th1s + 64;
    float* bbr = lrs + 64; float* bbi = bbr + 1024; float* scre = bbi + 1024; float* scim = scre + 1024;
    const size_t gp = (size_t)(layer * 32 + g) * 64;
    __syncthreads();
    for (int idx = tid; idx < 1024; idx += NTHR) { scre[idx] = p.in[11][gp * 16 + idx]; scim[idx] = p.in[12][gp * 16 + idx]; }
    if (tid < 64) {
      const float lr = p.in[6][gp + tid], li = p.in[7][gp + tid];
      const float step = expf(p.in[8][layer * 32 + g]);
      const float th1 = li * step;
      float s1, c1; sincos_f(th1, s1, c1);
      const float mag = expf(lr * step);
      const float abr = mag * c1, abi = mag * s1;
      const float den = lr * lr + li * li;
      const float nr = abr - 1.0f, ni = abi;
      kr[tid] = (nr * lr + ni * li) / den;
      ki[tid] = (ni * lr - nr * li) / den;
      th1s[tid] = th1; lrs[tid] = lr * step;
    }
    __syncthreads();
    for (int idx = tid; idx < 1024; idx += NTHR) {
      int pp = idx >> 4;
      float br = p.in[9][gp * 16 + idx], bi = p.in[10][gp * 16 + idx];
      bbr[idx] = kr[pp] * br - ki[pp] * bi;
      bbi[idx] = kr[pp] * bi + ki[pp] * br;
    }
#pragma unroll 1
    for (int dd = 0; dd < 8; ++dd) {
      const int d = dg * 8 + dd;
      if (d > 64) break;
      __syncthreads();
      if (tid < 64) {
        float sd, cd; sincos_f(th1s[tid] * (float)d, sd, cd);
        const float md = expf(lrs[tid] * (float)d);
        pwr[tid] = md * cd; pwi[tid] = md * sd;
      }
      __syncthreads();
      if (d <= 63) {
        if (tid < 256) {
          const int co = tid >> 4, ci = tid & 15;
          float val = 0.f;
#pragma unroll 8
          for (int pp = 0; pp < 64; ++pp) {
            const float cr = scre[co * 64 + pp], cm = scim[co * 64 + pp];
            const float wr_ = cr * pwr[pp] - cm * pwi[pp], wi_ = cr * pwi[pp] + cm * pwr[pp];
            val += wr_ * bbr[pp * 16 + ci] - wi_ * bbi[pp * 16 + ci];
          }
          ((bf16_t*)(wl + O_KMAT))[(((size_t)g * 64 + d) * 16 + co) * 16 + ci] = f2bf(val);
        }
        const int sidx = 63 - d;
        bf16_t* em = (bf16_t*)(wl + O_EMAT);
        for (int idx = tid; idx < 1024; idx += NTHR) {
          const int pp = idx >> 4, ci = idx & 15;
          const float re = pwr[pp] * bbr[idx] - pwi[pp] * bbi[idx], im = pwr[pp] * bbi[idx] + pwi[pp] * bbr[idx];
          em[((size_t)g * 128 + pp) * 1024 + sidx * 16 + ci] = f2bf(re);
          em[((size_t)g * 128 + 64 + pp) * 1024 + sidx * 16 + ci] = f2bf(im);
        }
      }
      if (d >= 1) {
        const int t = d - 1;
        bf16_t* fm = (bf16_t*)(wl + O_FMAT);
        for (int idx = tid; idx < 1024; idx += NTHR) {
          const int co = idx >> 6, pp = idx & 63;
          const float cr = scre[idx], cm = scim[idx];
          const float wr_ = cr * pwr[pp] - cm * pwi[pp], wi_ = cr * pwi[pp] + cm * pwr[pp];
          fm[((size_t)g * 1024 + t * 16 + co) * 128 + pp] = f2bf(wr_);
          fm[((size_t)g * 1024 + t * 16 + co) * 128 + 64 + pp] = f2bf(-wi_);
        }
      }
      if (d == 64 && tid < 64) {
        float* a64 = (float*)(wl + O_A64);
        a64[(g * 64 + tid) * 2] = pwr[tid]; a64[(g * 64 + tid) * 2 + 1] = pwi[tid];
      }
    }
  }
}

__device__ void ln_rows(const float* src, float* dst, bf16_t* dstb, const float* gam, const float* bet, int nrows, int bid, int nblk) {
  const int tid = otid(), lane = tid & 63, wid = tid >> 6;
  const int stride = nblk * NWV;
  for (int row0 = bid * NWV + wid; row0 < nrows; row0 += 2 * stride) {
    float4 v[2][4];
    bool ok[2];
#pragma unroll
    for (int u = 0; u < 2; ++u) {
      const int row = row0 + u * stride;
      ok[u] = row < nrows;
      const float4* s4 = (const float4*)(src + (size_t)(ok[u] ? row : row0) * 1024);
#pragma unroll
      for (int i = 0; i < 4; ++i) v[u][i] = s4[i * 64 + lane];
    }
#pragma unroll
    for (int u = 0; u < 2; ++u) {
      const int row = row0 + u * stride;
      float sum = 0.f;
#pragma unroll
      for (int i = 0; i < 4; ++i) sum += (v[u][i].x + v[u][i].y) + (v[u][i].z + v[u][i].w);
      const float mean = wave_sum(sum, lane) * (1.0f / 1024.0f);
      float sq = 0.f;
#pragma unroll
      for (int i = 0; i < 4; ++i) {
        float a = v[u][i].x - mean, b = v[u][i].y - mean, c = v[u][i].z - mean, d = v[u][i].w - mean;
        sq += (a * a + b * b) + (c * c + d * d);
      }
      const float rstd = rsqrtf(wave_sum(sq, lane) * (1.0f / 1024.0f) + 1e-5f);
      if (ok[u]) {
#pragma unroll
        for (int i = 0; i < 4; ++i) {
          float4 gg = ((const float4*)gam)[i * 64 + lane], bb = ((const float4*)bet)[i * 64 + lane];
          float4 o;
          o.x = (v[u][i].x - mean) * rstd * gg.x + bb.x; o.y = (v[u][i].y - mean) * rstd * gg.y + bb.y;
          o.z = (v[u][i].z - mean) * rstd * gg.z + bb.z; o.w = (v[u][i].w - mean) * rstd * gg.w + bb.w;
          if (dst) ((float4*)(dst + (size_t)row * 1024))[i * 64 + lane] = o;
          if (dstb) {
            uint2 pk; pk.x = pack2(o.x, o.y); pk.y = pack2(o.z, o.w);
            ((uint2*)(dstb + (size_t)row * 1024))[i * 64 + lane] = pk;
          }
        }
      }
    }
  }
}

constexpr int PROJ_N0 = 5120;
__device__ void phase_proj(const Params& p, unsigned char* lds, int layer, int bid, int nblk) {
  unsigned char* WS = launder_ws(lds);
  pg8::Gemm g{(const bf16_t*)(WS + G_XB), (const bf16_t*)(WS + G_WL + layer * WL_SIZE + O_WIN), MC, PROJ_N0, 1024};
  pg8::StaticOrder S; S.init(MC, PROJ_N0, nblk, bid);
  pg8::EpiProj E{(bf16_t*)(WS + G_PROJ), (const float*)(WS + G_ROPE), 0, (bf16_t*)(WS + G_USSM)};
  pg8::gemm_phase<pg8::EpiProj, pg8::StaticOrder>((PG8_LAS unsigned char*)lds, g, S, E, nullptr);
}

__device__ void phase2(const Params& p, unsigned char* lds, int layer, int bid, int nblk) {
  unsigned char* WS = launder_ws(lds);
  unsigned char* wl = WS + G_WL + layer * WL_SIZE;
  const bf16_t* PROJ = (const bf16_t*)(WS + G_PROJ);
  constexpr int T_CMP = 32, T_S5 = 64, T_POOL = (MC / 128) * 4;
  const int hgrid = nblk >> 1;
  if (bid < hgrid) {
    pg8::Gemm g{(const bf16_t*)(WS + G_XB), (const bf16_t*)(wl + O_WIN) + (size_t)PROJ_N0 * 1024, MC, INP - PROJ_N0, 1024};
    pg8::StaticOrder S; S.init(MC, INP - PROJ_N0, hgrid, bid);
    pg8::EpiProj E{(bf16_t*)(WS + G_PROJ), (const float*)(WS + G_ROPE), PROJ_N0, (bf16_t*)(WS + G_USSM)};
    pg8::gemm_phase<pg8::EpiProj, pg8::StaticOrder>((PG8_LAS unsigned char*)lds, g, S, E, nullptr);
  }
  constexpr int T_HEAVY = T_CMP + T_S5, T_POOL0 = 256;
  const bool firsth = bid < hgrid;
  const int vstart = firsth ? bid : bid - hgrid, vstride = firsth ? hgrid : nblk - hgrid, vend = firsth ? T_POOL0 : T_HEAVY + T_POOL - T_POOL0;
  for (int v = vstart; v < vend; v += vstride) {
    const int t = firsth ? (T_HEAVY + v) : (v < T_HEAVY ? v : v + T_POOL0);
    f32x4 acc[4][2]; zero_acc(acc);
    if (t < T_CMP) {
      const int kv = t & 1, mt = t >> 1, m0 = mt * 128;
      const bf16_t* Bt = (const bf16_t*)(wl + (kv ? O_WCV1 : O_WCK1));
      const float* bias = (const float*)(wl + (kv ? O_BCV1 : O_BCK1));
      bf16_t* H1 = (bf16_t*)(WS + G_H1) + (size_t)kv * CHB * 512 * 128;
      const int col0 = C_KV + kv * 128;
      auto la = [=](int r, int kk) -> uint4 {
        const int row = m0 + r;
        int n = row & 255; if (n > 254) n = 254;
        const int k = (row >> 8) & 1, bl = row >> 9;
        return gld16(PROJ + ((size_t)bl * SEQ + 16 * n + (kk >> 6)) * INP + col0 + k * 64 + (kk & 63));
      };
      auto lb = [=](int n, int kk) -> uint4 { return gld16(Bt + (size_t)n * 2048 + kk); };
      gemm_acc(lds, 32, la, lb, acc);
      const int ecol = ((otid() >> 6) & 3) * 32 + ((otid() & 63) >> 4) * 4;
      const float4 bia0 = gldf4(bias + ecol), bia1 = gldf4(bias + ecol + 16);
      gemm_epi(acc, [=](int r, int c, f32x4 v, int ni) {
        const float4 b4 = ni ? bia1 : bia0;
        v[0] = gelu_tanh(v[0] + b4.x); v[1] = gelu_tanh(v[1] + b4.y); v[2] = gelu_tanh(v[2] + b4.z); v[3] = gelu_tanh(v[3] + b4.w);
        gst8(H1 + (size_t)(m0 + r) * 128 + c, pack4(v));
      });
    } else if (t < T_CMP + T_S5) {
      const int tt = t - T_CMP, g = tt >> 1, m0 = (tt & 1) * 128;
      const bf16_t* Bt = (const bf16_t*)(wl + O_EMAT) + (size_t)g * 128 * 1024;
      float* S = (float*)(WS + G_S);
      auto la = [=](int r, int kk) -> uint4 {
        return gld16((const bf16_t*)(WS + G_USSM) + ((size_t)g * MC + (size_t)(m0 + r) * 64) * 16 + kk);
      };
      auto lb = [=](int n, int kk) -> uint4 { return gld16(Bt + (size_t)n * 1024 + kk); };
      gemm_acc(lds, 16, la, lb, acc);
      gemm_epi(acc, [=](int r, int c, f32x4 v, int) {
        gstf4(S + ((size_t)g * NROW + m0 + r) * 128 + c, make_float4(v[0], v[1], v[2], v[3]));
      });
    } else {
      const int tt = t - T_CMP - T_S5, g = tt & 3, m0 = (tt >> 2) * 128;
      const bf16_t* Bt = (const bf16_t*)(wl + O_WPOOL) + g * 128 * 128;
      const float* pscale = p.in[5] + (size_t)layer * 512 + g * 128;
      bf16_t* Y = (bf16_t*)(WS + G_Y);
      auto lb = [=](int n, int kk) -> uint4 { return gld16(Bt + (size_t)n * 128 + kk); };
      auto pool_la = [=](auto wtag, int r, int kk) -> uint4 {
        constexpr int W = decltype(wtag)::value;
        const int row = m0 + r, tpos = row & (SEQ - 1);
        const int cnt = (tpos + 1 < W) ? (tpos + 1) : W;
        const bf16_t* base = PROJ + (size_t)row * INP + g * 128 + kk;
        uint4 u[W];
#pragma unroll
        for (int j = 0; j < W; ++j) u[j] = gld16(base - (size_t)((j < cnt) ? j : 0) * INP);
        float sum[8];
#pragma unroll
        for (int e = 0; e < 8; ++e) sum[e] = 0.f;
#pragma unroll
        for (int j = 0; j < W; ++j) {
          const float wj = (j < cnt) ? 1.0f : 0.0f;
          sum[0] += wj * __uint_as_float(u[j].x << 16); sum[1] += wj * __uint_as_float(u[j].x & 0xffff0000u);
          sum[2] += wj * __uint_as_float(u[j].y << 16); sum[3] += wj * __uint_as_float(u[j].y & 0xffff0000u);
          sum[4] += wj * __uint_as_float(u[j].z << 16); sum[5] += wj * __uint_as_float(u[j].z & 0xffff0000u);
          sum[6] += wj * __uint_as_float(u[j].w << 16); sum[7] += wj * __uint_as_float(u[j].w & 0xffff0000u);
        }
        const float ic = 1.0f / (float)cnt;
        uint4 o;
        o.x = pack2(sum[0] * ic - __uint_as_float(u[0].x << 16), sum[1] * ic - __uint_as_float(u[0].x & 0xffff0000u));
        o.y = pack2(sum[2] * ic - __uint_as_float(u[0].y << 16), sum[3] * ic - __uint_as_float(u[0].y & 0xffff0000u));
        o.z = pack2(sum[4] * ic - __uint_as_float(u[0].z << 16), sum[5] * ic - __uint_as_float(u[0].z & 0xffff0000u));
        o.w = pack2(sum[6] * ic - __uint_as_float(u[0].w << 16), sum[7] * ic - __uint_as_float(u[0].w & 0xffff0000u));
        return o;
      };
      if (g == 0) gemm_acc(lds, 2, [=](int r, int kk) -> uint4 { return pool_la(std::integral_constant<int, 2>{}, r, kk); }, lb, acc);
      else if (g == 1) gemm_acc(lds, 2, [=](int r, int kk) -> uint4 { return pool_la(std::integral_constant<int, 4>{}, r, kk); }, lb, acc);
      else if (g == 2) gemm_acc(lds, 2, [=](int r, int kk) -> uint4 { return pool_la(std::integral_constant<int, 8>{}, r, kk); }, lb, acc);
      else gemm_acc(lds, 2, [=](int r, int kk) -> uint4 { return pool_la(std::integral_constant<int, 16>{}, r, kk); }, lb, acc);
      const int ecol = ((otid() >> 6) & 3) * 32 + ((otid() & 63) >> 4) * 4;
      const float4 psc0 = gldf4(pscale + ecol), psc1 = gldf4(pscale + ecol + 16);
      gemm_epi(acc, [=](int r, int c, f32x4 v, int ni) {
        const float4 s4 = ni ? psc1 : psc0;
        v[0] *= s4.x; v[1] *= s4.y; v[2] *= s4.z; v[3] *= s4.w;
        gst8(Y + (size_t)(m0 + r) * 1536 + g * 128 + c, pack4(v));
      });
    }
  }
}

__device__ void phase3(const Params& p, unsigned char* lds, int layer, int bid, int nblk) {
  unsigned char* WS = launder_ws(lds);
  unsigned char* wl = WS + G_WL + layer * WL_SIZE;
  constexpr int T_CMP = 32, T_SCAN = 32 * CHB * 64 / NTHR;
  for (int t = bid; t < T_CMP + T_SCAN; t += nblk) {
    if (t < T_CMP) {
      const int kv = t & 1, m0 = (t >> 1) * 128;
      const bf16_t* A = (const bf16_t*)(WS + G_H1) + (size_t)kv * CHB * 512 * 128;
      const bf16_t* Bt = (const bf16_t*)(wl + (kv ? O_WCV2 : O_WCK2));
      bf16_t* KC = (bf16_t*)(WS + G_KCMP);
      bf16_t* VT = (bf16_t*)(WS + G_VCMPT);
      f32x4 acc[4][2]; zero_acc(acc);
      auto la = [=](int r, int kk) -> uint4 { return gld16(A + (size_t)(m0 + r) * 128 + kk); };
      auto lb = [=](int n, int kk) -> uint4 { return gld16(Bt + (size_t)(n & 63) * 128 + kk); };
      gemm_acc(lds, 2, la, lb, acc);
      gemm_epi(acc, [=](int r, int c, f32x4 v, int) {
        if (c < 64) {
          const int row = m0 + r;
          if (kv == 0) {
            gst8(KC + (size_t)row * 64 + c, pack4(v));
          } else {
            const int bk = row >> 8, n = row & 255;
#pragma unroll
            for (int e = 0; e < 4; ++e) VT[((size_t)bk * 64 + c + e) * 256 + n] = f2bf(v[e]);
          }
        }
      });
    } else {
      const int idx = (t - T_CMP) * NTHR + otid();
      const int pp = idx & 63, bl = (idx >> 6) % CHB, g = idx / (64 * CHB);
      const float* a64 = (const float*)(wl + O_A64);
      const float ar = a64[(g * 64 + pp) * 2], ai = a64[(g * 64 + pp) * 2 + 1];
      const float* S = (const float*)(WS + G_S) + ((size_t)g * NROW + bl * 64) * 128;
      bf16_t* HIN = (bf16_t*)(WS + G_HIN) + ((size_t)g * NROW + bl * 64) * 128;
      float hr = 0.f, hi = 0.f;
#pragma unroll 1
      for (int c0 = 0; c0 < 64; c0 += 16) {
        float sr[16], si[16];
#pragma unroll
        for (int c = 0; c < 16; ++c) { sr[c] = S[(c0 + c) * 128 + pp]; si[c] = S[(c0 + c) * 128 + 64 + pp]; }
#pragma unroll
        for (int c = 0; c < 16; ++c) {
          HIN[(c0 + c) * 128 + pp] = f2bf(hr); HIN[(c0 + c) * 128 + 64 + pp] = f2bf(hi);
          const float nr = ar * hr - ai * hi + sr[c], ni = ar * hi + ai * hr + si[c];
          hr = nr; hi = ni;
        }
      }
    }
  }
}

constexpr int CMP_LDS_OFF = 40960;
__device__ void cmp_attn_wave(const Params& p, unsigned char* lds, int it) {
  unsigned char* WS = launder_ws(lds);
  const int tid = otid(), lane = tid & 63, wid = __builtin_amdgcn_readfirstlane(tid >> 6), fr = lane & 15, fq = lane >> 4;
  const int pairidx = it >> 1;
  const int tg = (wid >> 2) ? 255 - pairidx : pairidx;
  const int bk = (it & 1) * 4 + (wid & 3), bl = bk >> 1, k = bk & 1;
  const bf16_t* PROJ = (const bf16_t*)(WS + G_PROJ);
  const bf16_t* KC = (const bf16_t*)(WS + G_KCMP) + (size_t)bk * 256 * 64;
  const bf16_t* VT = (const bf16_t*)(WS + G_VCMPT) + (size_t)bk * 64 * 256;
  float* ONSA = (float*)(WS + G_ONSA);
  u64* SEL = (u64*)(WS + G_SEL);
  float* sc = (float*)(lds + CMP_LDS_OFF) + wid * (16 * 65);
  const int t0 = tg * 16;
  const size_t tok = (size_t)bl * SEQ + t0 + fr;
  const int nvr = (tg == 0) ? 0 : ((fr == 15) ? tg : tg - 1);
  const int src = (lane + 48) & 63;
  float imp[16];
#pragma unroll
  for (int ni = 0; ni < 16; ++ni) imp[ni] = 0.f;
#pragma unroll 1
  for (int g = 0; g < 4; ++g) {
    int lnl = lane; asm volatile("" : "+v"(lnl));
    const int frl = lnl & 15, fql = lnl >> 4, srcl = (lnl + 48) & 63;
    const size_t tokl = (size_t)bl * SEQ + t0 + frl;
    const int h = k * 4 + g;
    int nrel = ((tg == 0) ? 0 : ((frl == 15) ? tg : tg - 1)) - fql * 4;
    asm volatile("" : "+v"(nrel));
    bf16x8 qf[2];
#pragma unroll
    for (int ks = 0; ks < 2; ++ks) qf[ks] = gld16b(PROJ + tokl * INP + C_Q + h * 64 + ks * 32 + fql * 8);
    f32x4 s[16];
#pragma unroll
    for (int ni = 0; ni < 16; ++ni) {
      s[ni] = (f32x4){0.f, 0.f, 0.f, 0.f};
      if (ni * 16 < tg) {
#pragma unroll
        for (int ks = 0; ks < 2; ++ks) {
          const bf16x8 kf = gld16b(KC + (size_t)(ni * 16 + frl) * 64 + ks * 32 + fql * 8);
          s[ni] = __builtin_amdgcn_mfma_f32_16x16x32_bf16(kf, qf[ks], s[ni], 0, 0, 0);
        }
      }
      if (ni & 1) asm volatile("" ::: "memory");
    }
    float rmax = -1e30f;
#pragma unroll
    for (int ni = 0; ni < 16; ++ni)
#pragma unroll
      for (int e = 0; e < 4; ++e) {
        if (ni * 16 + e < nrel) rmax = fmaxf(rmax, s[ni][e]);
      }
    rmax = fmaxf(rmax, shx(rmax, 16, lnl)); rmax = fmaxf(rmax, shx(rmax, 32, lnl));
    float rsum = 0.f;
#pragma unroll
    for (int ni = 0; ni < 16; ++ni)
#pragma unroll
      for (int e = 0; e < 4; ++e) {
        const float pv = (ni * 16 + e < nrel) ? __builtin_amdgcn_exp2f(s[ni][e] - rmax) : 0.f;
        s[ni][e] = pv; rsum += pv;
      }
    rsum += shx(rsum, 16, lnl); rsum += shx(rsum, 32, lnl);
    const float inv = (rsum > 0.f) ? 1.0f / rsum : 0.f;
#pragma unroll
    for (int ni = 0; ni < 16; ++ni) {
#pragma unroll
      for (int e = 0; e < 4; ++e) s[ni][e] *= inv;
      const float a = __int_as_float(__builtin_amdgcn_ds_bpermute(srcl << 2, __float_as_int(s[ni][3])));
      const float b = (ni > 0) ? __int_as_float(__builtin_amdgcn_ds_bpermute(srcl << 2, __float_as_int(s[ni > 0 ? ni - 1 : 0][3]))) : 0.f;
      const float prev = (fql > 0) ? a : b;
      imp[ni] += 2.0f * (s[ni][0] + s[ni][1] + s[ni][2]) + s[ni][3] + prev;
      if ((ni & 3) == 3) asm volatile("" ::: "memory");
    }
    f32x4 o[4];
#pragma unroll
    for (int nd = 0; nd < 4; ++nd) o[nd] = (f32x4){0.f, 0.f, 0.f, 0.f};
#pragma unroll
    for (int kh = 0; kh < 2; ++kh) {
      if (kh * 128 < tg) {
#pragma unroll
        for (int kq = 0; kq < 4; ++kq) {
          const int k8 = kh * 4 + kq;
          const uint2 pa = pack4(s[2 * k8]), pb = pack4(s[2 * k8 + 1]);
          const bf16x8 pf = __builtin_bit_cast(bf16x8, (u32x4v){pa.x, pa.y, pb.x, pb.y});
#pragma unroll
          for (int nd = 0; nd < 4; ++nd) {
            const uint2 va = gld8(VT + (size_t)(nd * 16 + frl) * 256 + k8 * 32 + fql * 4);
            const uint2 vb = gld8(VT + (size_t)(nd * 16 + frl) * 256 + k8 * 32 + 16 + fql * 4);
            o[nd] = __builtin_amdgcn_mfma_f32_16x16x32_bf16(__builtin_bit_cast(bf16x8, (u32x4v){va.x, va.y, vb.x, vb.y}), pf, o[nd], 0, 0, 0);
          }
          if (kq & 1) asm volatile("" ::: "memory");
        }
      }
    }
    const float gt = bf2f(PROJ[tokl * INP + C_GN + h * 3 + 0]);
#pragma unroll
    for (int nd = 0; nd < 4; ++nd)
      gstf4(ONSA + tokl * 512 + h * 64 + nd * 16 + fql * 4, make_float4(gt * o[nd][0], gt * o[nd][1], gt * o[nd][2], gt * o[nd][3]));
  }
#pragma unroll
  for (int ni = 0; ni < 16; ++ni) sc[fr * 65 + ni * 4 + fq] = imp[ni];
  asm volatile("s_waitcnt lgkmcnt(0)" ::: "memory");
#pragma unroll 1
  for (int r = 0; r < 16; ++r) {
    const int t = t0 + r, cur = t >> 6, sb = lane;
    const float impv = sc[r * 65 + sb];
    const bool forced = (sb == 0) || (sb == cur) || (sb == cur - 1);
    const float score = forced ? 1e6f : ((sb <= cur) ? impv : -1e6f);
    const unsigned bits = __float_as_uint(score);
    const unsigned u = (bits & 0x80000000u) ? ~bits : (bits | 0x80000000u);
    unsigned T = 0u;
#pragma unroll
    for (int bit = 31; bit >= 0; --bit) {
      const unsigned cand = T | (1u << bit);
      if (__popcll(__ballot(u >= cand)) >= 16) T = cand;
    }
    u64 m = __ballot(u > T);
    u64 eq = __ballot(u == T);
    int need = 16 - __popcll(m);
    while (need > 0 && eq) { const u64 low = eq & (~eq + 1ull); m |= low; eq ^= low; --need; }
    if (lane == 0) SEL[((size_t)bl * SEQ + t) * 2 + k] = m;
  }
  asm volatile("s_waitcnt lgkmcnt(0)" ::: "memory");
}

__device__ void phase4(const Params& p, unsigned char* lds, int layer, int bid, int nblk, int mode) {
  unsigned char* WS = launder_ws(lds);
  unsigned char* wl = WS + G_WL + layer * WL_SIZE;
  const bf16_t* PROJ = (const bf16_t*)(WS + G_PROJ);
  constexpr int T_S5 = 32 * 2 * 8, T_CMP = CHB * 2 * 256 / NWV;
  for (int t = bid; t < T_S5 + T_CMP; t += nblk) {
    if (mode == 1 && t >= T_S5) break;
    if (mode == 2 && t < T_S5) continue;
    if (t < T_S5) {
      const int nt = (t < T_S5 / 2) ? (7 - (t & 7)) : (t & 7), mt = (t >> 3) & 1, g = t >> 4;
      const int m0 = mt * 128, n0 = nt * 128, nk1 = 2 * nt + 2;
      const bf16_t* HIN = (const bf16_t*)(WS + G_HIN) + (size_t)g * NROW * 128;
      const bf16_t* USSM = (const bf16_t*)(WS + G_USSM);
      const bf16_t* KM = (const bf16_t*)(wl + O_KMAT) + (size_t)g * 64 * 256;
      const bf16_t* FM = (const bf16_t*)(wl + O_FMAT) + (size_t)g * 1024 * 128;
      const float* dsk = p.in[13] + (size_t)(layer * 32 + g) * 16;
      bf16_t* ZS = (bf16_t*)(WS + G_ZS);
      f32x4 acc[4][2]; zero_acc(acc);
      auto la = [=](int r, int kk) -> uint4 {
        const bool carry = kk >= nk1 * 64;
        const int k2 = carry ? (kk - nk1 * 64) : kk;
        const bf16_t* pu = USSM + ((size_t)g * MC + (size_t)(m0 + r) * 64) * 16 + k2;
        const bf16_t* ph_ = HIN + (size_t)(m0 + r) * 128 + (k2 & 127);
        return gld16(carry ? ph_ : pu);
      };
      auto lb = [=](int n, int kk) -> uint4 {
        const bool carry = kk >= nk1 * 64;
        const int k2 = carry ? (kk - nk1 * 64) : kk;
        const int nn = n0 + n, tt = nn >> 4, co = nn & 15;
        const int dd = tt - (k2 >> 4);
        const bf16_t* pk = KM + ((size_t)(dd < 0 ? 0 : dd) * 16 + co) * 16 + (k2 & 15);
        const bf16_t* pf = FM + (size_t)nn * 128 + (k2 & 127);
        uint4 v = gld16(carry ? pf : pk);
        if (!carry && dd < 0) v = make_uint4(0, 0, 0, 0);
        return v;
      };
      gemm_acc(lds, nk1 + 2, la, lb, acc);
      uint2 upre[4][2];
      gemm_pre(upre, [=](int r, int c) -> uint2 {
        const int nn = n0 + c, tt = nn >> 4, co = nn & 15;
        return gld8(USSM + ((size_t)g * MC + (size_t)(m0 + r) * 64 + tt) * 16 + co);
      });
      const float4 d4 = gldf4(dsk + ((otid() & 63) >> 4) * 4);
      gemm_epi_pre(acc, upre, [=](int r, int c, f32x4 v, uint2 pre, int) {
        const int nn = n0 + c, tt = nn >> 4, co = nn & 15;
        const size_t tok = (size_t)(m0 + r) * 64 + tt;
        const f32x4 u = unpack4(pre);
        v[0] = gelu_tanh(v[0] + d4.x * u[0]); v[1] = gelu_tanh(v[1] + d4.y * u[1]);
        v[2] = gelu_tanh(v[2] + d4.z * u[2]); v[3] = gelu_tanh(v[3] + d4.w * u[3]);
        gst8(ZS + tok * 512 + g * 16 + co, pack4(v));
      });
    } else {
      cmp_attn_wave(p, lds, t - T_S5);
    }
  }
}

constexpr int AMI = 2;
__device__ void attn_item(const Params& p, unsigned char* lds, int item) {
  unsigned char* WS = launder_ws(lds);
  const int tid = otid(), lane = tid & 63, wid = __builtin_amdgcn_readfirstlane(tid >> 6), g = wid & 3, th = wid >> 2, fr = lane & 15, fq = lane >> 4;
  const int qb = (item < 256) ? (63 - (item >> 3)) : ((item - 256) >> 3), k = item & 1, bl = (item >> 1) & 3;
  const bf16_t* PROJ = (const bf16_t*)(WS + G_PROJ);
  float* ONSA = (float*)(WS + G_ONSA);
  bf16_t* YN = (bf16_t*)(WS + G_Y) + 1024;
  const u64* SEL = (const u64*)(WS + G_SEL);
  bf16_t* sK = (bf16_t*)lds;
  bf16_t* sVt = sK + 64 * 72;
  const int h = k * 4 + g, t0 = qb * 64 + th * (AMI * 16);
  const int jq = qb;
  const size_t tokb = (size_t)bl * SEQ;
  bf16x8 qf[AMI][2];
#pragma unroll
  for (int mi = 0; mi < AMI; ++mi)
#pragma unroll
    for (int ks = 0; ks < 2; ++ks) qf[mi][ks] = gld16b(PROJ + (tokb + t0 + mi * 16 + fr) * INP + C_Q + h * 64 + ks * 32 + fq * 8);
  u64 mrow[AMI];
#pragma unroll
  for (int mi = 0; mi < AMI; ++mi) mrow[mi] = SEL[(tokb + t0 + mi * 16 + fr) * 2 + k];
  u64 um;
  {
    const u64 mm = SEL[(tokb + qb * 64 + lane) * 2 + k];
    unsigned lo = (unsigned)mm, hi = (unsigned)(mm >> 32);
#pragma unroll
    for (int o = 32; o >= 1; o >>= 1) { lo |= shxu(lo, o, lane); hi |= shxu(hi, o, lane); }
    lo = __builtin_amdgcn_readfirstlane(lo); hi = __builtin_amdgcn_readfirstlane(hi);
    um = ((u64)hi << 32) | lo;
  }
  const u64 causal = (jq == 63) ? ~0ull : ((1ull << (jq + 1)) - 1ull);
  um &= causal;
#pragma unroll 1
  for (int pass = 0; pass < 2; ++pass) {
    const int kcol = C_KV + (pass == 0 ? 512 : 256) + k * 64, vcol = kcol + 128;
    u64 blk;
    if (pass == 0) {
      const int lo = (qb >= 8) ? (qb - 8) : 0;
      blk = causal & ~((1ull << lo) - 1ull);
    } else blk = um;
    f32x4 o[AMI][4];
#pragma unroll
    for (int i = 0; i < AMI; ++i)
#pragma unroll
      for (int j = 0; j < 4; ++j) o[i][j] = (f32x4){0.f, 0.f, 0.f, 0.f};
    float mst[AMI], lst[AMI];
#pragma unroll
    for (int i = 0; i < AMI; ++i) { mst[i] = 0.f; lst[i] = 0.f; }
    bool first = true;
    const int lo_blk = (pass == 0 && qb >= 8) ? (qb - 8) : -1;
    const int krow = tid >> 3, kc8 = (tid & 7) * 8;
    auto pop = [&]() -> int { const int j_ = 63 - __builtin_clzll(blk); blk &= ~(1ull << j_); return j_; };
    auto stage = [&](int b_, const uint4& kreg, const uint4& vreg) {
      bf16_t* dK = sK + b_ * (2 * 64 * 72);
      bf16_t* dV = dK + 64 * 72;
      *(uint4*)(dK + krow * 72 + kc8) = kreg;
      const unsigned w[4] = {vreg.x, vreg.y, vreg.z, vreg.w};
#pragma unroll
      for (int e = 0; e < 4; ++e) {
        dV[(wid * 8 + 2 * e) * 72 + lane] = (bf16_t)(w[e] & 0xffffu);
        dV[(wid * 8 + 2 * e + 1) * 72 + lane] = (bf16_t)(w[e] >> 16);
      }
    };
    int jc = pop(), jn = -1, bsel = 0;
    uint4 kreg = gld16(PROJ + (tokb + jc * 64 + krow) * INP + kcol + kc8);
    uint4 vreg = gld16(PROJ + (tokb + jc * 64 + lane) * INP + vcol + wid * 8);
    __syncthreads();
    stage(0, kreg, vreg);
    if (blk) {
      jn = pop();
      kreg = gld16(PROJ + (tokb + jn * 64 + krow) * INP + kcol + kc8);
      vreg = gld16(PROJ + (tokb + jn * 64 + lane) * INP + vcol + wid * 8);
    }
    __syncthreads();
    for (;;) {
      const int j = jc;
      const bf16_t* cK = sK + bsel * (2 * 64 * 72);
      const bf16_t* cVt = cK + 64 * 72;
      int jnn = -1;
      if (jn >= 0) {
        stage(bsel ^ 1, kreg, vreg);
        if (blk) {
          jnn = pop();
          kreg = gld16(PROJ + (tokb + jnn * 64 + krow) * INP + kcol + kc8);
          vreg = gld16(PROJ + (tokb + jnn * 64 + lane) * INP + vcol + wid * 8);
        }
      }
      const bool maskblk = (j == jq) || (j == lo_blk);
      f32x4 sall[AMI][4];
      uint2 pp[AMI][4];
#pragma unroll
      for (int mi = 0; mi < AMI; ++mi) {
        const bool rowsel = (pass == 0) || ((mrow[mi] >> j) & 1ull);
        const float cinit = rowsel ? -mst[mi] : -1e30f;
#pragma unroll
        for (int ni = 0; ni < 4; ++ni) sall[mi][ni] = (f32x4){cinit, cinit, cinit, cinit};
      }
      bf16x8 kfr[2][4];
#pragma unroll
      for (int ks = 0; ks < 2; ++ks)
#pragma unroll
        for (int ni = 0; ni < 4; ++ni) kfr[ks][ni] = *(const bf16x8*)(cK + (ni * 16 + fr) * 72 + ks * 32 + fq * 8);
#pragma unroll
      for (int mi = 0; mi < AMI; ++mi)
#pragma unroll
        for (int ks = 0; ks < 2; ++ks)
#pragma unroll
          for (int ni = 0; ni < 4; ++ni) sall[mi][ni] = __builtin_amdgcn_mfma_f32_16x16x32_bf16(kfr[ks][ni], qf[mi][ks], sall[mi][ni], 0, 0, 0);
      bf16x8 vfr[2][4];
#pragma unroll
      for (int ks = 0; ks < 2; ++ks)
#pragma unroll
        for (int nd = 0; nd < 4; ++nd) {
          const uint2 va = *(const uint2*)(cVt + (nd * 16 + fr) * 72 + ks * 32 + fq * 4);
          const uint2 vb = *(const uint2*)(cVt + (nd * 16 + fr) * 72 + ks * 32 + 16 + fq * 4);
          vfr[ks][nd] = __builtin_bit_cast(bf16x8, (u32x4v){va.x, va.y, vb.x, vb.y});
        }
#pragma unroll
      for (int mi = 0; mi < AMI; ++mi) {
        f32x4 (&s)[4] = sall[mi];
        if (maskblk) {
          const int hi = t0 + mi * 16 + fr - j * 64, lo = hi - 512;
#pragma unroll
          for (int ni = 0; ni < 4; ++ni)
#pragma unroll
            for (int e = 0; e < 4; ++e) {
              const int key = ni * 16 + fq * 4 + e;
              s[ni][e] = (key <= hi && key > lo) ? s[ni][e] : -1e30f;
            }
        }
        float lm = s[0][0];
#pragma unroll
        for (int ni = 0; ni < 4; ++ni)
#pragma unroll
          for (int e = 0; e < 4; ++e) lm = fmaxf(lm, s[ni][e]);
        if (__any(first || lm > 64.0f)) {
          float r = fmaxf(lm, shx(lm, 16, lane)); r = fmaxf(r, shx(r, 32, lane));
          float delta = first ? r : fmaxf(r, 0.f);
          if (delta < -1e29f) delta = 0.f;
          const float alpha = __builtin_amdgcn_exp2f(-delta);
          mst[mi] += delta; lst[mi] *= alpha;
#pragma unroll
          for (int nd = 0; nd < 4; ++nd)
#pragma unroll
            for (int e = 0; e < 4; ++e) o[mi][nd][e] *= alpha;
#pragma unroll
          for (int ni = 0; ni < 4; ++ni)
#pragma unroll
            for (int e = 0; e < 4; ++e) s[ni][e] -= delta;
        }
        float rsum = 0.f;
#pragma unroll
        for (int ni = 0; ni < 4; ++ni) {
#pragma unroll
          for (int e = 0; e < 4; ++e) { const float pv = __builtin_amdgcn_exp2f(s[ni][e]); s[ni][e] = pv; rsum += pv; }
          pp[mi][ni] = pack4(s[ni]);
        }
        lst[mi] += rsum;
#pragma unroll
        for (int ks = 0; ks < 2; ++ks) {
          const bf16x8 pf = __builtin_bit_cast(bf16x8, (u32x4v){pp[mi][2 * ks].x, pp[mi][2 * ks].y, pp[mi][2 * ks + 1].x, pp[mi][2 * ks + 1].y});
#pragma unroll
          for (int nd = 0; nd < 4; ++nd) o[mi][nd] = __builtin_amdgcn_mfma_f32_16x16x32_bf16(vfr[ks][nd], pf, o[mi][nd], 0, 0, 0);
        }
      }
      first = false;
      if (jn < 0) break;
      __syncthreads();
      jc = jn; jn = jnn; bsel ^= 1;
    }
#pragma unroll
    for (int mi = 0; mi < AMI; ++mi) {
      const size_t tok = tokb + t0 + mi * 16 + fr;
      float lsum = lst[mi]; lsum += shx(lsum, 16, lane); lsum += shx(lsum, 32, lane);
      const float gt = bf2f(PROJ[tok * INP + C_GN + h * 3 + (pass == 0 ? 2 : 1)]) / lsum;
      float4 prevs[4];
#pragma unroll
      for (int nd = 0; nd < 4; ++nd) prevs[nd] = gldf4(ONSA + tok * 512 + h * 64 + nd * 16 + fq * 4);
#pragma unroll
      for (int nd = 0; nd < 4; ++nd) {
        const float4 prev = prevs[nd];
        f32x4 r;
        r[0] = prev.x + gt * o[mi][nd][0]; r[1] = prev.y + gt * o[mi][nd][1];
        r[2] = prev.z + gt * o[mi][nd][2]; r[3] = prev.w + gt * o[mi][nd][3];
        if (pass == 0) gstf4(ONSA + tok * 512 + h * 64 + nd * 16 + fq * 4, make_float4(r[0], r[1], r[2], r[3]));
        else gst8(YN + tok * 1536 + h * 64 + nd * 16 + fq * 4, pack4(r));
      }
    }
  }
}

__device__ void phase5(const Params& p, unsigned char* lds, int layer, int bid, int nblk) {
  unsigned char* WS = launder_ws(lds);
  unsigned char* wl = WS + G_WL + layer * WL_SIZE;
  constexpr int T_ATT = CHB * 2 * 64, T_GLU = (MC / 128) * 4;
  for (int t = bid; t < T_ATT + T_GLU; t += nblk) {
    if (t < T_ATT) {
      attn_item(p, lds, t);
    } else {
      const int tt = t - T_ATT, nt = tt & 3, m0 = (tt >> 2) * 128, n0 = nt * 128;
      const bf16_t* ZS = (const bf16_t*)(WS + G_ZS);
      const bf16_t* Bt = (const bf16_t*)(wl + O_WGLU);
      const float* bg = p.in[15] + (size_t)layer * 512;
      bf16_t* Y = (bf16_t*)(WS + G_Y);
      f32x4 acc[4][2]; zero_acc(acc);
      auto la = [=](int r, int kk) -> uint4 { return gld16(ZS + (size_t)(m0 + r) * 512 + kk); };
      auto lb = [=](int n, int kk) -> uint4 { return gld16(Bt + (size_t)(n0 + n) * 512 + kk); };
      gemm_acc(lds, 8, la, lb, acc);
      uint2 zpre[4][2];
      gemm_pre(zpre, [=](int r, int c) -> uint2 { return gld8(ZS + (size_t)(m0 + r) * 512 + n0 + c); });
      const int ecol = ((otid() >> 6) & 3) * 32 + ((otid() & 63) >> 4) * 4;
      const float4 bgl0 = gldf4(bg + n0 + ecol), bgl1 = gldf4(bg + n0 + ecol + 16);
      gemm_epi_pre(acc, zpre, [=](int r, int c, f32x4 v, uint2 pre, int ni) {
        const float4 b4 = ni ? bgl1 : bgl0;
        const f32x4 z = unpack4(pre);
        v[0] = z[0] * sigmoidf_(v[0] + b4.x); v[1] = z[1] * sigmoidf_(v[1] + b4.y);
        v[2] = z[2] * sigmoidf_(v[2] + b4.z); v[3] = z[3] * sigmoidf_(v[3] + b4.w);
        gst8(Y + (size_t)(m0 + r) * 1536 + 512 + n0 + c, pack4(v));
      });
    }
  }
}

__device__ void phase_merge(const Params& p, unsigned char* lds, int layer, int bid, int nblk) {
  unsigned char* WS = launder_ws(lds);
  unsigned char* wl = WS + G_WL + layer * WL_SIZE;
  pg8::Gemm g{(const bf16_t*)(WS + G_Y), (const bf16_t*)(wl + O_WUP), MC, 1024, 1536};
  pg8::StaticOrder S; S.init(MC, 1024, nblk, bid);
  pg8::EpiMerge E{(const bf16_t*)(WS + G_PROJ), (bf16_t*)(WS + G_ONSA)};
  pg8::gemm_phase<pg8::EpiMerge, pg8::StaticOrder>((PG8_LAS unsigned char*)lds, g, S, E, nullptr);
}
template <int K>
__device__ void phase_resid(const Params& p, unsigned char* lds, const bf16_t* A, const bf16_t* Bt, float* X, int bid, int nblk) {
  unsigned char* WS = launder_ws(lds);
  pg8::Gemm g{A, Bt, MC, 1024, K};
  pg8::StaticOrder S; S.init(MC, 1024, nblk, bid);
  pg8::EpiResid E{X, (const bf16_t*)(WS + G_XB)};
  pg8::gemm_phase<pg8::EpiResid, pg8::StaticOrder>((PG8_LAS unsigned char*)lds, g, S, E, nullptr);
}
__device__ void phase_ff1(const Params& p, unsigned char* lds, int layer, int bid, int nblk) {
  unsigned char* WS = launder_ws(lds);
  pg8::Gemm g{(const bf16_t*)(WS + G_XB), (const bf16_t*)(WS + G_WL + layer * WL_SIZE + O_WFF1), MC, 4096, 1024};
  pg8::StaticOrder S; S.init(MC, 4096, nblk, bid);
  pg8::EpiRelu2 E{(bf16_t*)(WS + G_PROJ), 4096};
  pg8::gemm_phase<pg8::EpiRelu2, pg8::StaticOrder>((PG8_LAS unsigned char*)lds, g, S, E, nullptr);
}

#define XB_TMO      128
#define XB_XCNT(j)  (256  + 64 * (j))
#define XB_XSUB(j)  (1280 + 64 * (j))
#define XB_XGEN(j)  (2304 + 64 * (j))
#define XB_TOP      3328
#define XB_TOPGEN   3392
#define XCD_BAR_WORDS 3456
#define XB_SPIN_CAP (1u << 18)
#define LAS __attribute__((address_space(3)))

__device__ __forceinline__ unsigned xb_ld(unsigned* p)              { return __hip_atomic_load(p, __ATOMIC_RELAXED, __HIP_MEMORY_SCOPE_AGENT); }
__device__ __forceinline__ unsigned xb_add(unsigned* p, unsigned v) { return __hip_atomic_fetch_add(p, v, __ATOMIC_RELAXED, __HIP_MEMORY_SCOPE_AGENT); }
__device__ __forceinline__ unsigned xb_xcc_id() { return (unsigned)__builtin_amdgcn_s_getreg((3 << 11) | 20) & 0xFu; }
#define XB_SPIN(cond, bar) do { unsigned _sp = 0; while (cond) { __builtin_amdgcn_s_sleep(1); \
    if ((++_sp & 255u) == 0u) { if (xb_ld(&(bar)[XB_TMO])) break; if (_sp > XB_SPIN_CAP) { atomicAdd(&(bar)[XB_TMO], 1u); break; } } } } while (0)

struct XcdBarrier {
    unsigned* bar; unsigned x;
    volatile LAS unsigned* st;
};

__device__ __forceinline__ XcdBarrier xcd_barrier_post(unsigned* bar, volatile LAS unsigned* st) {
    XcdBarrier b; b.bar = bar; b.x = xb_xcc_id(); b.st = st;
    if (threadIdx.x == 0) (void)xb_add(&bar[XB_XCNT(b.x)], 1u);
    return b;
}
__device__ __forceinline__ void xcd_barrier_complete(unsigned* bar, unsigned x, unsigned& nloc, unsigned& nx) {
    const unsigned G = gridDim.x * gridDim.y * gridDim.z;
    unsigned sum, cnt, mine, sp = 0u;
    for (;;) {
        sum = 0u; cnt = 0u; mine = 0u;
#pragma unroll
        for (unsigned j = 0; j < 16; ++j) { const unsigned c = xb_ld(&bar[XB_XCNT(j)]); sum += c; cnt += (c > 0u) ? 1u : 0u; mine = (j == x) ? c : mine; }
        if (sum == G) break;
        __builtin_amdgcn_s_sleep(1);
        if ((++sp & 255u) == 0u) { if (xb_ld(&bar[XB_TMO])) break; if (sp > XB_SPIN_CAP) { atomicAdd(&bar[XB_TMO], 1u); break; } }
    }
    nloc = mine > 0u ? mine : 1u; nx = cnt > 0u ? cnt : 1u;
}

__device__ __forceinline__ void xcd_barrier(const XcdBarrier& b) {
    asm volatile("s_waitcnt vmcnt(0)" ::: "memory");
    __syncthreads();
    if (threadIdx.x == 0) {
        unsigned* bar = b.bar;
        __builtin_amdgcn_s_waitcnt(0);
        unsigned nloc = b.st[0], nx = b.st[1];
        if (nloc == 0u) { xcd_barrier_complete(bar, b.x, nloc, nx); b.st[0] = nloc; b.st[1] = nx; }
        const unsigned old = xb_add(&bar[XB_XSUB(b.x)], 1u);
        const unsigned gen = old / nloc;
        if (old + 1u == (gen + 1u) * nloc) {
            __builtin_amdgcn_fence(__ATOMIC_RELEASE, "agent");
            asm volatile("s_waitcnt vmcnt(0)" ::: "memory");
            const unsigned og = xb_add(&bar[XB_TOP], 1u);
            const unsigned tg = og / nx;
            if (og + 1u == (tg + 1u) * nx) xb_add(&bar[XB_TOPGEN], 1u);
            else XB_SPIN(xb_ld(&bar[XB_TOPGEN]) == tg, bar);
            __builtin_amdgcn_fence(__ATOMIC_ACQUIRE, "agent");
            xb_add(&bar[XB_XGEN(b.x)], 1u);
            asm volatile("s_waitcnt vmcnt(0)" ::: "memory");
        } else {
            XB_SPIN(xb_ld(&bar[XB_XGEN(b.x)]) == gen, bar);
            __builtin_amdgcn_fence(__ATOMIC_ACQUIRE, "agent");
            asm volatile("s_waitcnt vmcnt(0)" ::: "memory");
        }
    }
    __syncthreads();
}


__device__ void run_phase(const Params& p, unsigned char* lds, int ph, int layer, int chunk, int bid, int nblk) {
  unsigned char* WS = launder_ws(lds);
  float* X = p.out + (size_t)chunk * MC * 1024;
  unsigned char* wl = WS + G_WL + layer * WL_SIZE;
  bf16_t* XB = (bf16_t*)(WS + G_XB);
  switch (ph) {
    case 0: phase0(p, lds, bid, nblk);
            ln_rows(p.in[0], (float*)nullptr, XB, p.in[1], p.in[2], MC, bid, nblk); break;
    case 2: phase_proj(p, lds, layer, bid, nblk); break;
    case 3: phase2(p, lds, layer, bid, nblk); break;
    case 4: phase3(p, lds, layer, bid, nblk); break;
    case 5: case 13: case 14: phase4(p, lds, layer, bid, nblk, ph == 5 ? 0 : ph - 12); break;
    case 6: phase5(p, lds, layer, bid, nblk); break;
    case 7: phase_merge(p, lds, layer, bid, nblk); break;
    case 8: phase_resid<1024>(p, lds, (const bf16_t*)(WS + G_ONSA), (const bf16_t*)(wl + O_WOUT), X, bid, nblk); break;
    case 9: ln_rows(X, (float*)nullptr, XB, p.in[26] + layer * 1024, p.in[27] + layer * 1024, MC, bid, nblk); break;
    case 10: phase_ff1(p, lds, layer, bid, nblk); break;
    case 11: phase_resid<4096>(p, lds, (const bf16_t*)(WS + G_PROJ), (const bf16_t*)(wl + O_WFF2), X, bid, nblk); break;
    case 12: {
      const bool fold = (layer + 1 == DEPTH) && (chunk + 1 < NCH);
      const int nj = fold ? 2 : 1;
#pragma unroll 1
      for (int i = 0; i < nj; ++i) {
        const bool second = (i == 1);
        ln_rows(second ? p.in[0] + (size_t)(chunk + 1) * MC * 1024 : X, (!second && layer + 1 == DEPTH) ? X : (float*)nullptr,
                (second || layer + 1 < DEPTH) ? XB : (bf16_t*)nullptr, second ? p.in[1] : p.in[30] + layer * 1024, second ? p.in[2] : p.in[31] + layer * 1024, MC, bid, nblk);
      }
      break; }
    default: break;
  }
}

__global__ void __launch_bounds__(NTHR, 2) k_mega(Params p) {
  __shared__ __attribute__((aligned(16))) unsigned char lds[LDS_BYTES + 256];
  cg::grid_group grid = cg::this_grid();
  {
    volatile LAS unsigned* bst = (volatile LAS unsigned*)(lds + LDS_BYTES);
    if (threadIdx.x == 0) { bst[0] = 0u; bst[1] = 0u; const unsigned long long wsv = (unsigned long long)p.ws; bst[4] = (unsigned)wsv; bst[5] = (unsigned)(wsv >> 32); }
    __syncthreads();
    (void)xcd_barrier_post((unsigned*)(launder_ws(lds) + G_BAR), bst);
  }
  const int bid = blockIdx.x, nblk = gridDim.x;
#ifdef DBL_LO
  constexpr int NEXTRA = DBL_HI - DBL_LO + 1;
  constexpr int DLO = DBL_LO, DHI = DBL_HI;
#else
  constexpr int NEXTRA = 0, DLO = 100, DHI = 100;
#endif
  constexpr int PER_LAYER = 11 + NEXTRA, PER_CHUNK = DEPTH * PER_LAYER, NSTEP = 1 + NCH * PER_CHUNK;
#pragma unroll 1
  for (int step = 0; step < NSTEP; ++step) {
    int ph = 0, layer = 0, chunk = 0;
    if (step > 0) {
      const int s = step - 1, r = s % PER_CHUNK;
      chunk = s / PER_CHUNK; layer = r / PER_LAYER;
      const int i = r % PER_LAYER, nfirst = DHI - 2 + 1;
      if (NEXTRA == 0 || i < nfirst) ph = 2 + i;
      else if (i < nfirst + NEXTRA) ph = DLO + (i - nfirst);
      else ph = 2 + i - NEXTRA;
    }
    run_phase(p, lds, ph, layer, chunk, bid, nblk);
    if (step + 1 < NSTEP) { if (step == 0) grid.sync(); else { XcdBarrier xb; xb.bar = (unsigned*)(launder_ws(lds) + G_BAR); xb.x = xb_xcc_id(); xb.st = (volatile LAS unsigned*)(lds + LDS_BYTES); xcd_barrier(xb); } }
  }
}

extern "C" void kernel_launch(void* const* d_in, const int* in_sizes, int n_in, void* d_out, int out_size, void* d_ws, size_t ws_size,
                              hipStream_t stream) {
  Params p{};
  for (int i = 0; i < 32; ++i) p.in[i] = (const float*)d_in[i];
  p.out = (float*)d_out;
  p.ws = (unsigned char*)d_ws;
  static int grid_blocks = 0;
  if (!grid_blocks) {
    int dev = 0, cus = 0, per_cu = 0;
    (void)hipGetDevice(&dev);
    (void)hipDeviceGetAttribute(&cus, hipDeviceAttributeMultiprocessorCount, dev);
    (void)hipOccupancyMaxActiveBlocksPerMultiprocessor(&per_cu, k_mega, NTHR, 0);
    if (per_cu > 1) per_cu = 1;
    if (per_cu < 1) per_cu = 1;
    grid_blocks = cus * per_cu;
  }
  (void)hipMemsetAsync((unsigned char*)d_ws + G_BAR, 0, XCD_BAR_WORDS * 4, stream);
  void* args[] = {&p};
  (void)hipLaunchCooperativeKernel((void*)k_mega, dim3(grid_blocks), dim3(NTHR), args, 0, stream);
}
```

```cpp
#include <hip/hip_runtime.h>
#include <hip/hip_cooperative_groups.h>
#include <type_traits>
namespace cg = cooperative_groups;

typedef unsigned short bf16_t;
typedef short bf16x8 __attribute__((ext_vector_type(8)));
typedef float f32x4 __attribute__((ext_vector_type(4)));
typedef unsigned long long u64;
typedef unsigned u32x4v __attribute__((ext_vector_type(4)));
typedef unsigned u32x2v __attribute__((ext_vector_type(2)));

constexpr int DM = 1024, NB = 8, SEQ = 4096, DEPTH = 2;
constexpr int CHB = 4;
constexpr int NCH = NB / CHB;
constexpr int MC = CHB * SEQ;
constexpr int INW = 5400, INP = 5632;
constexpr int C_SSM = 512, C_Q = 1024, C_KV = 1536, C_GN = 2304, C_GM = 2328;
constexpr int NROW = CHB * 64;
constexpr float ALPHA = 1.4142135623730951f;
constexpr int LDS_BYTES = 131072;
constexpr int NTHR = 512;
constexpr int NWV = NTHR / 64;

constexpr size_t al256(size_t x) { return (x + 255) & ~(size_t)255; }
constexpr size_t O_WIN = 0;
constexpr size_t O_WPOOL = O_WIN + (size_t)INP * 1024 * 2;
constexpr size_t O_WGLU = O_WPOOL + 4 * 128 * 128 * 2;
constexpr size_t O_WUP = O_WGLU + 512 * 512 * 2;
constexpr size_t O_WOUT = O_WUP + 3 * 1024 * 512 * 2;
constexpr size_t O_WFF1 = O_WOUT + 1024 * 1024 * 2;
constexpr size_t O_WFF2 = O_WFF1 + 4096 * 1024 * 2;
constexpr size_t O_WCK1 = O_WFF2 + 4096 * 1024 * 2;
constexpr size_t O_WCV1 = O_WCK1 + 128 * 2048 * 2;
constexpr size_t O_WCK2 = O_WCV1 + 128 * 2048 * 2;
constexpr size_t O_WCV2 = O_WCK2 + 64 * 128 * 2;
constexpr size_t O_BCK1 = O_WCV2 + 64 * 128 * 2;
constexpr size_t O_BCV1 = O_BCK1 + 512;
constexpr size_t O_KMAT = O_BCV1 + 512;
constexpr size_t O_EMAT = O_KMAT + 32 * 64 * 256 * 2;
constexpr size_t O_FMAT = O_EMAT + (size_t)32 * 128 * 1024 * 2;
constexpr size_t O_A64 = O_FMAT + (size_t)32 * 1024 * 128 * 2;
constexpr size_t WL_SIZE = al256(O_A64 + 32 * 64 * 2 * 4);
constexpr size_t G_WL = 0;
constexpr size_t G_ROPE = G_WL + 2 * WL_SIZE;
constexpr size_t G_XB = al256(G_ROPE + 4096 * 16 * 4);
constexpr size_t G_PROJ = al256(G_XB + (size_t)MC * 1024 * 4);
constexpr size_t G_Y = al256(G_PROJ + (size_t)MC * INP * 2);
constexpr size_t G_ZS = al256(G_Y + (size_t)MC * 1536 * 2);
constexpr size_t G_ONSA = al256(G_ZS + (size_t)MC * 512 * 2);
constexpr size_t G_S = al256(G_ONSA + (size_t)MC * 512 * 4);
constexpr size_t G_HIN = al256(G_S + (size_t)32 * NROW * 128 * 4);
constexpr size_t G_KCMP = al256(G_HIN + (size_t)32 * NROW * 128 * 2);
constexpr size_t G_VCMPT = al256(G_KCMP + (size_t)CHB * 2 * 256 * 64 * 2);
constexpr size_t G_H1 = al256(G_VCMPT + (size_t)CHB * 2 * 256 * 64 * 2);
constexpr size_t G_SEL = al256(G_H1 + (size_t)2 * CHB * 512 * 128 * 2);
constexpr size_t G_BAR = al256(G_SEL + (size_t)MC * 2 * 8);
constexpr size_t G_USSM = al256(G_BAR + 3456 * 4);
constexpr size_t G_END = al256(G_USSM + (size_t)32 * MC * 16 * 2);
static_assert(G_END <= (size_t)536870912, "workspace budget");
static_assert((size_t)MC * 4096 * 2 <= (size_t)MC * INP * 2, "H aliases PROJ");

struct Params {
  const float* in[32];
  float* out;
  unsigned char* ws;
};

__device__ __forceinline__ unsigned char* launder_ws(unsigned char* lds) {
  const volatile __attribute__((address_space(3))) unsigned* q = (const volatile __attribute__((address_space(3))) unsigned*)(lds + LDS_BYTES + 16);
  const unsigned lo = (unsigned)__builtin_amdgcn_readfirstlane((int)q[0]), hi = (unsigned)__builtin_amdgcn_readfirstlane((int)q[1]);
  return (unsigned char*)(((unsigned long long)hi << 32) | (unsigned long long)lo);
}
__device__ __forceinline__ int otid() { int t = threadIdx.x; asm volatile("" : "+v"(t)); return t; }
__device__ __forceinline__ float bf2f(bf16_t h) { return __uint_as_float(((unsigned)h) << 16); }
__device__ __forceinline__ bf16_t f2bf(float f) {
  unsigned u = __float_as_uint(f);
  u += 0x7fffu + ((u >> 16) & 1u);
  return (bf16_t)(u >> 16);
}
__device__ __forceinline__ unsigned pack2(float a, float b) { unsigned r; asm volatile("v_cvt_pk_bf16_f32 %0, %1, %2" : "=v"(r) : "v"(a), "v"(b)); return r; }
__device__ __forceinline__ uint2 pack4(f32x4 v) { uint2 r; r.x = pack2(v[0], v[1]); r.y = pack2(v[2], v[3]); return r; }
__device__ __forceinline__ f32x4 unpack4(uint2 u) {
  f32x4 r; r[0] = __uint_as_float(u.x << 16); r[1] = __uint_as_float(u.x & 0xffff0000u);
  r[2] = __uint_as_float(u.y << 16); r[3] = __uint_as_float(u.y & 0xffff0000u); return r;
}
__device__ __forceinline__ f32x4 unpack4v(u32x2v u) { uint2 t; t.x = u.x; t.y = u.y; return unpack4(t); }
__device__ __forceinline__ u32x2v pack4v(f32x4 v) { const uint2 t = pack4(v); u32x2v r; r.x = t.x; r.y = t.y; return r; }
#define GASQ __attribute__((address_space(1)))
__device__ __forceinline__ uint4 gld16(const void* q) { const u32x4v v = *(const GASQ u32x4v*)q; return make_uint4(v.x, v.y, v.z, v.w); }
__device__ __forceinline__ uint2 gld8(const void* q) { const u32x2v v = *(const GASQ u32x2v*)q; uint2 r; r.x = v.x; r.y = v.y; return r; }
__device__ __forceinline__ bf16x8 gld16b(const void* q) { return *(const GASQ bf16x8*)q; }
__device__ __forceinline__ float4 gldf4(const void* q) { const f32x4 v = *(const GASQ f32x4*)q; return make_float4(v[0], v[1], v[2], v[3]); }
__device__ __forceinline__ void gst8(void* q, uint2 v) { u32x2v t; t.x = v.x; t.y = v.y; *(GASQ u32x2v*)q = t; }
__device__ __forceinline__ void gstf4(void* q, float4 v) { *(GASQ f32x4*)q = (f32x4){v.x, v.y, v.z, v.w}; }
__device__ __forceinline__ float sigmoidf_(float x) { return __builtin_amdgcn_rcpf(1.0f + __builtin_amdgcn_exp2f(-1.4426950408889634f * x)); }
__device__ __forceinline__ float gelu_tanh(float x) {
  float u = 0.7978845608028654f * (x + 0.044715f * x * x * x);
  return x * __builtin_amdgcn_rcpf(1.0f + __builtin_amdgcn_exp2f(-2.8853900817779268f * u));
}
__device__ __forceinline__ float shx(float v, int mask, int lane) { return __int_as_float(__builtin_amdgcn_ds_bpermute((lane ^ mask) << 2, __float_as_int(v))); }
__device__ __forceinline__ unsigned shxu(unsigned v, int mask, int lane) { return (unsigned)__builtin_amdgcn_ds_bpermute((lane ^ mask) << 2, (int)v); }
__device__ __forceinline__ float wave_sum(float v, int lane) {
#pragma unroll
  for (int o = 32; o >= 1; o >>= 1) v += shx(v, o, lane);
  return v;
}

namespace pg8 {
#define PG8_LAS __attribute__((address_space(3)))
typedef unsigned short bf16_t;
typedef short bf16x8 __attribute__((ext_vector_type(8)));
typedef float f32x4 __attribute__((ext_vector_type(4)));
typedef unsigned u32x4 __attribute__((ext_vector_type(4)));
constexpr int BM = 256, BK = 64, HALF = 128, HTB = HALF * BK * 2  , STAGE_BYTES = 8 * HTB, NXCD = 8, WGM = 8;

__host__ __device__ __forceinline__ int lds_byte(int r, int c) { const int st = (r >> 4) * 2 + (c >> 5), rr = r & 15, cc = c & 31, ob = rr * 64 + cc * 2; return st * 1024 + (ob ^ (((ob >> 9) & 1) << 5)); }
__host__ __device__ __forceinline__ void stage_rc(int b, int& R, int& C) { const int st = b / 1024, sb = b % 1024, swz = sb ^ (((sb >> 9) & 1) << 5); R = (st >> 1) * 16 + swz / 64; C = (st & 1) * 32 + (swz % 64) / 2; }
__host__ __device__ __forceinline__ int perm32(int rho) { const int n = rho >> 4, i = rho & 15; return 8 * (i >> 2) + 4 * n + (i & 3); }

struct Gemm { const bf16_t* A; const bf16_t* Bt; int M, N, K; };

struct Unit { int pm, pn; };
struct StaticOrder {
    int nM, nN, nwg, G, c;
    __host__ __device__ void init(int M, int N, int G_, int c_) { nM = M / BM; nN = N / BM; nwg = nM * nN; G = G_; c = c_; }
    __host__ __device__ bool next(int i, Unit& u) const {
        const long L = (long)i * G + c; if (L >= nwg) return false;
        int wgid = (int)L; { const int q = nwg / NXCD, r = nwg % NXCD, xcd = wgid % NXCD, off = wgid / NXCD; wgid = (xcd < r ? xcd * (q + 1) : r * (q + 1) + (xcd - r) * q) + off; }
        const int nig = WGM * nN, gid = wgid / nig, fm = gid * WGM, gsz = (nM - fm) < WGM ? (nM - fm) : WGM;
        u.pm = fm + ((wgid % nig) % gsz); u.pn = (wgid % nig) / gsz; return true;
    }
    __device__ __forceinline__ void a_ready(const Unit&) const {}
    __device__ __forceinline__ size_t a_off(const Unit&) const { return 0; }
    __device__ __forceinline__ void done(const Unit&) const {}
};

struct MergeOrder {
    StaticOrder base;
    __host__ __device__ void init(int G_, int c_) { base.init(MC, 1024, G_, c_); }
    __host__ __device__ bool next(int i, Unit& u) const { Unit b; if (!base.next(i / 3, b)) return false; u.pm = b.pm; u.pn = (i % 3) * 4 + b.pn; return true; }
    __device__ __forceinline__ void a_ready(const Unit&) const {}
    __device__ __forceinline__ void done(const Unit&) const {}
    __device__ __forceinline__ size_t a_off(const Unit& u) const { return (size_t)(u.pn >> 2) * ((size_t)MC * 512 * 2); }
};
struct EpiProj {
  static constexpr bool PERM = false, AFTER_DRAIN = false, MID = false;
  bf16_t* PROJ; const float* rope; int coff; bf16_t* USSM;
  __device__ __forceinline__ void operator()(const f32x4 (&acc)[2][2][4][2], const Unit& u, int wr, int wc, int fr, int fq) const {
#pragma unroll
    for (int bj = 0; bj < 2; ++bj) {
      const int cb = coff + u.pn * BM + bj * HALF + wc * 32;
      const int jg = (cb - C_Q) >> 6;
      const bool inqkv = (cb >= C_Q) && (cb < C_GN);
      const bool roped = inqkv && ((cb & 32) == 0) && (jg < 8 || (((jg - 8) & 2) == 0));
      const bool isq = (cb >= C_Q) && (cb < C_KV);
      const bool isgate = cb >= C_GN;
      const bool isssm = (cb >= C_SSM) && (cb < C_Q);
#pragma unroll
      for (int ai = 0; ai < 2; ++ai) {
        float4 csr[4], snr[4];
#pragma unroll
        for (int m = 0; m < 4; ++m) {
          if (roped) {
            const int pos = (u.pm * BM + ai * HALF + wr * 64 + m * 16 + fr) & (SEQ - 1);
            csr[m] = gldf4(rope + pos * 16 + (fq & 1) * 4); snr[m] = gldf4(rope + pos * 16 + 8 + (fq & 1) * 4);
          } else { csr[m] = make_float4(0.f, 0.f, 0.f, 0.f); snr[m] = make_float4(0.f, 0.f, 0.f, 0.f); }
        }
#pragma unroll
        for (int m = 0; m < 4; ++m) {
          const int row = u.pm * BM + ai * HALF + wr * 64 + m * 16 + fr;
#pragma unroll
          for (int n = 0; n < 2; ++n) {
            f32x4 v = acc[ai][bj][m][n];
            if (isgate) {
#pragma unroll
              for (int e = 0; e < 4; ++e) v[e] = sigmoidf_(v[e]);
            } else if (roped && n == 0) {
              const float csv[4] = {csr[m].x, csr[m].y, csr[m].z, csr[m].w}, snv[4] = {snr[m].x, snr[m].y, snr[m].z, snr[m].w};
#pragma unroll
              for (int e = 0; e < 4; ++e) {
                const float pv = shx(v[e], 32, fq * 16 + fr);
                v[e] = (fq < 2) ? (v[e] * csv[e] - pv * snv[e]) : (pv * snv[e] + v[e] * csv[e]);
              }
            }
            if (isq) {
#pragma unroll
              for (int e = 0; e < 4; ++e) v[e] *= 0.18033688011112042f;
            }
            if (isssm) gst8(USSM + ((size_t)(((cb - C_SSM) >> 4) + n) * MC + row) * 16 + 4 * fq, pack4(v));
            else gst8(PROJ + (size_t)row * INP + cb + n * 16 + 4 * fq, pack4(v));
          }
        }
        asm volatile("" ::: "memory");
      }
    }
  }
};
struct EpiRelu2 {
  static constexpr bool PERM = true, AFTER_DRAIN = false, MID = false;
  bf16_t* O; int ldc;
  __device__ __forceinline__ void operator()(const f32x4 (&acc)[2][2][4][2], const Unit& u, int wr, int wc, int fr, int fq) const {
    int row0 = u.pm * BM + wr * 64 + fr, col0 = u.pn * BM + wc * 32 + 8 * fq;
    asm volatile("" : "+v"(row0), "+v"(col0));
#pragma unroll
    for (int ai = 0; ai < 2; ++ai)
#pragma unroll
      for (int m = 0; m < 4; ++m) {
        bf16_t* rowp = O + (size_t)(row0 + ai * HALF + m * 16) * ldc + col0;
#pragma unroll
        for (int bj = 0; bj < 2; ++bj) {
          f32x4 v0 = acc[ai][bj][m][0], v1 = acc[ai][bj][m][1];
#pragma unroll
          for (int e = 0; e < 4; ++e) { const float a = fmaxf(v0[e], 0.f), b = fmaxf(v1[e], 0.f); v0[e] = a * a; v1[e] = b * b; }
          u32x4 w; w.x = pack2(v0[0], v0[1]); w.y = pack2(v0[2], v0[3]); w.z = pack2(v1[0], v1[1]); w.w = pack2(v1[2], v1[3]);
          *(u32x4*)(rowp + bj * HALF) = w;
        }
      }
  }
};
#define GAS __attribute__((address_space(1)))
struct EpiResid {
  static constexpr bool PERM = false, AFTER_DRAIN = false, MID = false;
  float* X; const bf16_t* XBr;
  __device__ __forceinline__ void operator()(const f32x4 (&acc)[2][2][4][2], const Unit& u, int wr, int wc, int fr, int fq) const {
    int row0 = u.pm * BM + wr * 64 + fr, col0 = u.pn * BM + wc * 32 + 4 * fq;
    asm volatile("" : "+v"(row0), "+v"(col0));
    const GAS bf16_t* xb = (const GAS bf16_t*)XBr; GAS float* xo = (GAS float*)X;
#pragma unroll
    for (int ai = 0; ai < 2; ++ai) {
      u32x2v xv[4][2][2];
#pragma unroll
      for (int m = 0; m < 4; ++m)
#pragma unroll
        for (int bj = 0; bj < 2; ++bj)
#pragma unroll
          for (int n = 0; n < 2; ++n) xv[m][bj][n] = *(const GAS u32x2v*)(xb + (size_t)(row0 + ai * HALF + m * 16) * 1024 + col0 + bj * HALF + n * 16);
#pragma unroll
      for (int m = 0; m < 4; ++m)
#pragma unroll
        for (int bj = 0; bj < 2; ++bj)
#pragma unroll
          for (int n = 0; n < 2; ++n)
            *(GAS f32x4*)(xo + (size_t)(row0 + ai * HALF + m * 16) * 1024 + col0 + bj * HALF + n * 16) = unpack4v(xv[m][bj][n]) * ALPHA + acc[ai][bj][m][n];
      asm volatile("" ::: "memory");
    }
  }
};
struct EpiMerge {
  static constexpr bool PERM = false, AFTER_DRAIN = false, MID = true;
  const bf16_t* PROJ; bf16_t* MG;
  __device__ __forceinline__ static f32x4 clampg(f32x4 g) { f32x4 r; for (int e = 0; e < 4; ++e) r[e] = fmaxf(g[e], 1e-30f); return r; }
  __device__ __forceinline__ void mid(f32x4 (&acc)[2][2][4][2], const Unit& u, int t, int wr, int wc, int fr, int fq) const {
    const int seg = (t == 8) ? 0 : 1;
    int row0 = u.pm * BM + wr * 64 + fr, col0 = u.pn * BM + wc * 32 + 4 * fq;
    asm volatile("" : "+v"(row0), "+v"(col0));
    const GAS bf16_t* pg = (const GAS bf16_t*)PROJ;
#pragma unroll
    for (int ai = 0; ai < 2; ++ai)
#pragma unroll
      for (int mh = 0; mh < 2; ++mh) {
        u32x2v ga[2][2][2], gb[2][2][2];
#pragma unroll
        for (int mm = 0; mm < 2; ++mm)
#pragma unroll
          for (int bj = 0; bj < 2; ++bj)
#pragma unroll
            for (int n = 0; n < 2; ++n) {
              const GAS bf16_t* gp = pg + (size_t)(row0 + ai * HALF + (mh * 2 + mm) * 16) * INP + C_GM + seg * 1024 + col0 + bj * HALF + n * 16;
              ga[mm][bj][n] = *(const GAS u32x2v*)gp; gb[mm][bj][n] = *(const GAS u32x2v*)(gp + 1024);
            }
#pragma unroll
        for (int mm = 0; mm < 2; ++mm)
#pragma unroll
          for (int bj = 0; bj < 2; ++bj)
#pragma unroll
            for (int n = 0; n < 2; ++n) {
              const f32x4 a = clampg(unpack4v(ga[mm][bj][n])), b = clampg(unpack4v(gb[mm][bj][n]));
              f32x4 r;
#pragma unroll
              for (int e = 0; e < 4; ++e) r[e] = a[e] * __builtin_amdgcn_rcpf(b[e]);
              acc[ai][bj][mh * 2 + mm][n] *= r;
            }
        asm volatile("" ::: "memory");
      }
  }
  __device__ __forceinline__ void operator()(const f32x4 (&acc)[2][2][4][2], const Unit& u, int wr, int wc, int fr, int fq) const {
    int row0 = u.pm * BM + wr * 64 + fr, col0 = u.pn * BM + wc * 32 + 4 * fq;
    asm volatile("" : "+v"(row0), "+v"(col0));
    const GAS bf16_t* pg = (const GAS bf16_t*)PROJ; GAS bf16_t* mg = (GAS bf16_t*)MG;
#pragma unroll
    for (int ai = 0; ai < 2; ++ai) {
      u32x2v gv[4][2][2];
#pragma unroll
      for (int m = 0; m < 4; ++m)
#pragma unroll
        for (int bj = 0; bj < 2; ++bj)
#pragma unroll
          for (int n = 0; n < 2; ++n) gv[m][bj][n] = *(const GAS u32x2v*)(pg + (size_t)(row0 + ai * HALF + m * 16) * INP + C_GM + 2 * 1024 + col0 + bj * HALF + n * 16);
#pragma unroll
      for (int m = 0; m < 4; ++m)
#pragma unroll
        for (int bj = 0; bj < 2; ++bj)
#pragma unroll
          for (int n = 0; n < 2; ++n)
            *(GAS u32x2v*)(mg + (size_t)(row0 + ai * HALF + m * 16) * 1024 + col0 + bj * HALF + n * 16) = pack4v(clampg(unpack4v(gv[m][bj][n])) * acc[ai][bj][m][n]);
      asm volatile("" ::: "memory");
    }
  }
};
template <class Epi, class Sched, bool STAMP = false>
__device__ __forceinline__ void gemm_phase(PG8_LAS unsigned char* lds, const Gemm g, const Sched& S, const Epi& E, unsigned long long* stamps) {
    const int tid = otid(), wid = __builtin_amdgcn_readfirstlane(tid >> 6), lane = tid & 63, wr = wid >> 2, wc = wid & 3, fr = lane & 15, fq = lane >> 4;
    const int K = g.K, nt = K / BK;
    int ts_lo = 0, ts_hi = 0, nts = 0; const unsigned long long rt_entry = STAMP ? (unsigned long long)wall_clock64() : 0ull;
#define PG8_STAMP() do { if (STAMP && wid == 0 && nts < 64) { const unsigned long long _c = (unsigned long long)clock64(); \
        ts_lo = (lane == nts) ? (int)(unsigned)_c : ts_lo; ts_hi = (lane == nts) ? (int)(unsigned)(_c >> 32) : ts_hi; ++nts; } } while (0)
    PG8_STAMP();
    unsigned voffA[2], voffB[2];
#pragma unroll
    for (int i = 0; i < 2; ++i) { int R, C; stage_rc(tid * 16 + i * 8192, R, C); const int Rb = Epi::PERM ? ((R & ~31) + perm32(R & 31)) : R;
        voffA[i] = (unsigned)(R * K + C) * 2u; voffB[i] = (unsigned)(Rb * K + C) * 2u; }
    const size_t kstep = (size_t)(BK * 2);
    const size_t hstep = (size_t)HALF * K * 2;
    const size_t tstep = 2 * hstep;
    const unsigned ldsw = (unsigned)wid * 1024u;
    const int aoff = lds_byte(wr * 64 + fr, fq * 8), boff = lds_byte(wc * 32 + fr, fq * 8);
#define PG8_SA(b, h) (((b) * 2 + (h)) * HTB)
#define PG8_SB(b, h) ((4 + (b) * 2 + (h)) * HTB)
#define PG8_STAGE(bufoff, gbase, voff) do { _Pragma("unroll") for (int _i = 0; _i < 2; ++_i) \
        __builtin_amdgcn_global_load_lds((const unsigned*)((const char*)(gbase) + (voff)[_i]), (PG8_LAS unsigned*)(lds + (bufoff) + ldsw + _i * 8192), 16, 0, 0); } while (0)
#define PG8_LDA(dst, b, h) do { _Pragma("unroll") for (int m = 0; m < 4; ++m) _Pragma("unroll") for (int k = 0; k < 2; ++k) dst[m][k] = *(const PG8_LAS bf16x8*)(lds + PG8_SA(b, h) + aoff + m * 2048 + k * 1024); } while (0)
#define PG8_LDB(dst, b, h) do { _Pragma("unroll") for (int n = 0; n < 2; ++n) _Pragma("unroll") for (int k = 0; k < 2; ++k) dst[n][k] = *(const PG8_LAS bf16x8*)(lds + PG8_SB(b, h) + boff + n * 2048 + k * 1024); } while (0)
#define PG8_MMA(ai, bj, At, Bt) do { __builtin_amdgcn_s_setprio(1); _Pragma("unroll") for (int m = 0; m < 4; ++m) _Pragma("unroll") for (int n = 0; n < 2; ++n) _Pragma("unroll") for (int k = 0; k < 2; ++k) \
        acc[ai][bj][m][n] = __builtin_amdgcn_mfma_f32_16x16x32_bf16(Bt[n][k], At[m][k], acc[ai][bj][m][n], 0, 0, 0); __builtin_amdgcn_s_setprio(0); } while (0)
#define PG8_WAIT_V(n) asm volatile("s_waitcnt vmcnt(" #n ")" ::: "memory")
#define PG8_WAIT_L(n) asm volatile("s_waitcnt lgkmcnt(" #n ")" ::: "memory")
#define PG8_BAR __builtin_amdgcn_s_barrier()
#define PG8_SCHED __builtin_amdgcn_sched_barrier(0)
    Unit cur, nxt; int ui = 0;
    if (!S.next(0, cur)) return;
    f32x4 acc[2][2][4][2];
#pragma unroll
    for (int a = 0; a < 2; ++a)
#pragma unroll
        for (int b = 0; b < 2; ++b)
#pragma unroll
            for (int m = 0; m < 4; ++m)
#pragma unroll
                for (int n = 0; n < 2; ++n) acc[a][b][m][n] = (f32x4){0.f, 0.f, 0.f, 0.f};
    bf16x8 At[4][2], B0[2][2], B1[2][2];
    const char* cA = (const char*)g.A + (size_t)cur.pm * tstep + S.a_off(cur); const char* cB = (const char*)g.Bt + (size_t)cur.pn * tstep;
    S.a_ready(cur);
    PG8_STAGE(PG8_SB(0, 0), cB, voffB); PG8_STAGE(PG8_SA(0, 0), cA, voffA); PG8_STAGE(PG8_SB(0, 1), cB + hstep, voffB); PG8_STAGE(PG8_SA(0, 1), cA + hstep, voffA);
    if (wr == 1) PG8_BAR;
    PG8_WAIT_V(4); PG8_BAR;
    PG8_STAGE(PG8_SB(1, 0), cB + kstep, voffB); PG8_STAGE(PG8_SA(1, 0), cA + kstep, voffA); PG8_STAGE(PG8_SB(1, 1), cB + hstep + kstep, voffB);
    PG8_WAIT_V(6); PG8_BAR;
    PG8_STAMP();
    for (;;) {
        const bool has_next = S.next(ui + 1, nxt);
        const char* nA = has_next ? (const char*)g.A + (size_t)nxt.pm * tstep + S.a_off(nxt) : cA; const char* nB = has_next ? (const char*)g.Bt + (size_t)nxt.pn * tstep : cB;
        for (int t = 0; t < nt; t += 2) {
            if constexpr (Epi::MID) { if (t == 8 || t == 16) E.mid(acc, cur, t, wr, wc, fr, fq); }
            const bool last = (t == nt - 2);
            const char* a1 = cA + (size_t)(t + 1) * kstep;
            const char* a2 = last ? nA : cA + (size_t)(t + 2) * kstep; const char* b2 = last ? nB : cB + (size_t)(t + 2) * kstep;
            const char* a3 = a2 + kstep; const char* b3 = b2 + kstep;
            if (last && has_next) S.a_ready(nxt);
            PG8_LDB(B0, 0, 0); PG8_SCHED; PG8_LDA(At, 0, 0); PG8_STAGE(PG8_SA(1, 1), a1 + hstep, voffA);
            PG8_WAIT_L(8); PG8_BAR; PG8_WAIT_L(0); PG8_MMA(0, 0, At, B0); PG8_BAR; PG8_SCHED;
            PG8_LDB(B1, 0, 1); PG8_STAGE(PG8_SB(0, 0), b2, voffB);
            PG8_BAR; PG8_WAIT_L(0); PG8_MMA(0, 1, At, B1); PG8_BAR;
            PG8_LDA(At, 0, 1); PG8_STAGE(PG8_SA(0, 0), a2, voffA);
            PG8_BAR; PG8_WAIT_L(0); PG8_MMA(1, 0, At, B0); PG8_BAR; PG8_SCHED;
            PG8_STAGE(PG8_SB(0, 1), b2 + hstep, voffB);
            PG8_WAIT_V(6); PG8_BAR; PG8_MMA(1, 1, At, B1); PG8_BAR;
            PG8_LDB(B0, 1, 0); PG8_SCHED; PG8_LDA(At, 1, 0); PG8_STAGE(PG8_SA(0, 1), a2 + hstep, voffA);
            PG8_WAIT_L(8); PG8_BAR; PG8_WAIT_L(0); PG8_MMA(0, 0, At, B0); PG8_BAR; PG8_SCHED;
            PG8_LDB(B1, 1, 1); PG8_STAGE(PG8_SB(1, 0), b3, voffB);
            PG8_BAR; PG8_WAIT_L(0); PG8_MMA(0, 1, At, B1); PG8_BAR;
            PG8_LDA(At, 1, 1); PG8_STAGE(PG8_SA(1, 0), a3, voffA);
            PG8_BAR; PG8_WAIT_L(0); PG8_MMA(1, 0, At, B0); PG8_BAR; PG8_SCHED;
            PG8_STAGE(PG8_SB(1, 1), b3 + hstep, voffB);
            PG8_WAIT_V(6); PG8_BAR; PG8_MMA(1, 1, At, B1); PG8_BAR;
        }
        PG8_STAMP();
        if constexpr (!Epi::AFTER_DRAIN) { E(acc, cur, wr, wc, fr, fq); S.done(cur); }
        PG8_STAMP();
        if (!has_next) break;
#pragma unroll
        for (int a = 0; a < 2; ++a)
#pragma unroll
            for (int b = 0; b < 2; ++b)
#pragma unroll
                for (int m = 0; m < 4; ++m)
#pragma unroll
                    for (int n = 0; n < 2; ++n) acc[a][b][m][n] = (f32x4){0.f, 0.f, 0.f, 0.f};
        cur = nxt; cA = nA; cB = nB; ++ui;
    }
    PG8_WAIT_V(0);
    if (wr == 0) PG8_BAR;
    PG8_BAR;
    if constexpr (Epi::AFTER_DRAIN) { E.fused(acc, cur, wr, wc, fr, fq, lds, wid, lane); S.done(cur); }
    PG8_STAMP();
    if (STAMP && wid == 0) { stamps[lane] = lane < nts ? (((unsigned long long)(unsigned)ts_hi << 32) | (unsigned)ts_lo) : 0ull;
        if (lane == 62) stamps[62] = rt_entry; if (lane == 63) stamps[63] = (unsigned long long)wall_clock64(); }
#undef PG8_STAMP
#undef PG8_SA
#undef PG8_SB
#undef PG8_STAGE
#undef PG8_LDA
#undef PG8_LDB
#undef PG8_MMA
#undef PG8_WAIT_V
#undef PG8_WAIT_L
#undef PG8_BAR
#undef PG8_SCHED
}
}

template <class LA, class LB>
__device__ __forceinline__ void gemm_acc(unsigned char* lds, int nk, const LA& la, const LB& lb, f32x4 (&acc)[4][2]) {
  const int tid = otid(), lane = tid & 63, wid = tid >> 6, wr = wid >> 2, wc = wid & 3, fr = lane & 15, fq = lane >> 4;
  bf16_t* sA = (bf16_t*)lds;
  bf16_t* sB = sA + 128 * 72;
  const int lrow = tid >> 3, lk = (tid & 7) * 8;
  uint4 ra[2][2], rb[2][2];
#pragma unroll
  for (int i = 0; i < 2; ++i) { ra[0][i] = la(lrow + i * 64, lk); rb[0][i] = lb(lrow + i * 64, lk); }
  if (nk > 1) {
#pragma unroll
    for (int i = 0; i < 2; ++i) { ra[1][i] = la(lrow + i * 64, 64 + lk); rb[1][i] = lb(lrow + i * 64, 64 + lk); }
  } else {
#pragma unroll
    for (int i = 0; i < 2; ++i) { ra[1][i] = make_uint4(0, 0, 0, 0); rb[1][i] = make_uint4(0, 0, 0, 0); }
  }
  for (int kt = 0; kt < nk; kt += 2) {
#pragma unroll
    for (int st = 0; st < 2; ++st) {
      if (kt + st < nk) {
        __syncthreads();
#pragma unroll
        for (int i = 0; i < 2; ++i) {
          *(uint4*)(sA + (lrow + i * 64) * 72 + lk) = ra[st][i];
          *(uint4*)(sB + (lrow + i * 64) * 72 + lk) = rb[st][i];
        }
        __syncthreads();
        if (kt + st + 2 < nk) {
#pragma unroll
          for (int i = 0; i < 2; ++i) { ra[st][i] = la(lrow + i * 64, (kt + st + 2) * 64 + lk); rb[st][i] = lb(lrow + i * 64, (kt + st + 2) * 64 + lk); }
        }
#pragma unroll
        for (int ks = 0; ks < 2; ++ks) {
          bf16x8 af[4], bfr[2];
#pragma unroll
          for (int mi = 0; mi < 4; ++mi) af[mi] = *(const bf16x8*)(sA + (wr * 64 + mi * 16 + fr) * 72 + ks * 32 + fq * 8);
#pragma unroll
          for (int ni = 0; ni < 2; ++ni) bfr[ni] = *(const bf16x8*)(sB + (wc * 32 + ni * 16 + fr) * 72 + ks * 32 + fq * 8);
#pragma unroll
          for (int mi = 0; mi < 4; ++mi)
#pragma unroll
            for (int ni = 0; ni < 2; ++ni) acc[mi][ni] = __builtin_amdgcn_mfma_f32_16x16x32_bf16(bfr[ni], af[mi], acc[mi][ni], 0, 0, 0);
        }
      }
    }
  }
}
__device__ __forceinline__ void zero_acc(f32x4 (&acc)[4][2]) {
#pragma unroll
  for (int i = 0; i < 4; ++i)
#pragma unroll
    for (int j = 0; j < 2; ++j) acc[i][j] = (f32x4){0.f, 0.f, 0.f, 0.f};
}
template <class LD>
__device__ __forceinline__ void gemm_pre(uint2 (&pre)[4][2], const LD& ld) {
  const int tid = otid(), lane = tid & 63, wid = tid >> 6, wr = wid >> 2, wc = wid & 3, fr = lane & 15, fq = lane >> 4;
#pragma unroll
  for (int mi = 0; mi < 4; ++mi)
#pragma unroll
    for (int ni = 0; ni < 2; ++ni) pre[mi][ni] = ld(wr * 64 + mi * 16 + fr, wc * 32 + ni * 16 + fq * 4);
}
template <class EP>
__device__ __forceinline__ void gemm_epi_pre(const f32x4 (&acc)[4][2], const uint2 (&pre)[4][2], const EP& ep) {
  const int tid = otid(), lane = tid & 63, wid = tid >> 6, wr = wid >> 2, wc = wid & 3, fr = lane & 15, fq = lane >> 4;
#pragma unroll
  for (int mi = 0; mi < 4; ++mi)
#pragma unroll
    for (int ni = 0; ni < 2; ++ni) ep(wr * 64 + mi * 16 + fr, wc * 32 + ni * 16 + fq * 4, acc[mi][ni], pre[mi][ni], ni);
}
template <class EP>
__device__ __forceinline__ void gemm_epi(const f32x4 (&acc)[4][2], const EP& ep) {
  const int tid = otid(), lane = tid & 63, wid = tid >> 6, wr = wid >> 2, wc = wid & 3, fr = lane & 15, fq = lane >> 4;
#pragma unroll
  for (int mi = 0; mi < 4; ++mi)
#pragma unroll
    for (int ni = 0; ni < 2; ++ni) ep(wr * 64 + mi * 16 + fr, wc * 32 + ni * 16 + fq * 4, acc[mi][ni], ni);
}

__device__ void transpose_job(unsigned char* lds, const float* src, bf16_t* dst, int K, int N, int Npad, int bid, int nblk, int ldd = 0) {
  if (ldd == 0) ldd = K;
  float* sm = (float*)lds;
  const int tid = otid();
  const int tk = K / 64, tn = Npad / 64, ntile = tk * tn;
  const int rr = tid >> 4, c4 = (tid & 15) * 4;
  const int wn = tid & 63, wk = (tid >> 6) * 8;
  float4 cur[2], nxt[2];
  auto ldtile = [&](int t, float4 (&v)[2]) {
    const int k0 = (t % tk) * 64, n0 = (t / tk) * 64;
#pragma unroll
    for (int i = 0; i < 2; ++i)
      v[i] = (n0 + c4 < N) ? gldf4(src + (size_t)(k0 + rr + 32 * i) * N + n0 + c4) : make_float4(0.f, 0.f, 0.f, 0.f);
  };
#pragma unroll
  for (int i = 0; i < 2; ++i) { cur[i] = make_float4(0.f, 0.f, 0.f, 0.f); nxt[i] = cur[i]; }
  if (bid < ntile) ldtile(bid, cur);
  for (int t = bid; t < ntile; t += nblk) {
    const int k0 = (t % tk) * 64, n0 = (t / tk) * 64;
    if (t + nblk < ntile) ldtile(t + nblk, nxt);
    __syncthreads();
#pragma unroll
    for (int i = 0; i < 2; ++i) *(float4*)(sm + (rr + 32 * i) * 68 + c4) = cur[i];
    __syncthreads();
    {
      float v[8];
#pragma unroll
      for (int e = 0; e < 8; ++e) v[e] = sm[(wk + e) * 68 + wn];
      uint4 o; o.x = pack2(v[0], v[1]); o.y = pack2(v[2], v[3]); o.z = pack2(v[4], v[5]); o.w = pack2(v[6], v[7]);
      u32x4v ov; ov.x = o.x; ov.y = o.y; ov.z = o.z; ov.w = o.w;
      *(GASQ u32x4v*)(dst + (size_t)(n0 + wn) * ldd + k0 + wk) = ov;
    }
#pragma unroll
    for (int i = 0; i < 2; ++i) cur[i] = nxt[i];
  }
}

__device__ __forceinline__ void sincos_f(float ang, float& s, float& c) {
  const float q = rintf(ang * 0.15915494309189535f);
  float r = fmaf(-q, 6.28125f, ang);
  r = fmaf(-q, 0.001934051513671875f, r);
  r = fmaf(-q, 1.255665914356996e-06f, r);
  s = __sinf(r); c = __cosf(r);
}

__device__ void phase0(const Params& p, unsigned char* lds, int bid, int nblk) {
  unsigned char* WS = launder_ws(lds);
  const int tid = otid();
  for (int layer = 0; layer < DEPTH; ++layer) {
    unsigned char* wl = WS + G_WL + layer * WL_SIZE;
    transpose_job(lds, p.in[3] + (size_t)layer * 1024 * INW, (bf16_t*)(wl + O_WIN), 1024, INW, INP, bid, nblk);
    for (int g = 0; g < 4; ++g)
      transpose_job(lds, p.in[4] + (size_t)(layer * 4 + g) * 128 * 128, (bf16_t*)(wl + O_WPOOL) + g * 128 * 128, 128, 128, 128, bid, nblk);
    transpose_job(lds, p.in[14] + (size_t)layer * 512 * 512, (bf16_t*)(wl + O_WGLU), 512, 512, 512, bid, nblk);
    for (int i = 0; i < 3; ++i)
      transpose_job(lds, p.in[22 + i] + (size_t)layer * 512 * 1024, (bf16_t*)(wl + O_WUP) + (size_t)i * 512, 512, 1024, 1024, bid, nblk, 1536);
    transpose_job(lds, p.in[25] + (size_t)layer * 1024 * 1024, (bf16_t*)(wl + O_WOUT), 1024, 1024, 1024, bid, nblk);
    transpose_job(lds, p.in[28] + (size_t)layer * 1024 * 4096, (bf16_t*)(wl + O_WFF1), 1024, 4096, 4096, bid, nblk);
    transpose_job(lds, p.in[29] + (size_t)layer * 4096 * 1024, (bf16_t*)(wl + O_WFF2), 4096, 1024, 1024, bid, nblk);
    transpose_job(lds, p.in[18] + (size_t)layer * 2048 * 128, (bf16_t*)(wl + O_WCK1), 2048, 128, 128, bid, nblk);
    transpose_job(lds, p.in[20] + (size_t)layer * 2048 * 128, (bf16_t*)(wl + O_WCV1), 2048, 128, 128, bid, nblk);
    transpose_job(lds, p.in[19] + (size_t)layer * 128 * 64, (bf16_t*)(wl + O_WCK2), 128, 64, 64, bid, nblk);
    transpose_job(lds, p.in[21] + (size_t)layer * 128 * 64, (bf16_t*)(wl + O_WCV2), 128, 64, 64, bid, nblk);
  }
  {
    float* rope = (float*)(WS + G_ROPE);
    for (int idx = bid * NTHR + tid; idx < 4096 * 8; idx += nblk * NTHR) {
      int pos = idx >> 3, i = idx & 7;
      const float inv = (i == 0) ? 1.0f : (i == 1) ? 0.19392274474868576f : (i == 2) ? 0.03760603093086393f : (i == 3) ? 0.007292664737217109f
                      : (i == 4) ? 0.001414213562373095f : (i == 5) ? 0.0002742481756762073f : (i == 6) ? 5.318295896944988e-05f : 1.031338537721246e-05f;
      float sn, cs; sincos_f((float)pos * inv, sn, cs);
      rope[pos * 16 + i] = cs; rope[pos * 16 + 8 + i] = sn;
    }
  }
  for (int it = bid; it < DEPTH * 2 * 8; it += nblk) {
    const int layer = it >> 4, kv = (it >> 3) & 1, j0 = (it & 7) * 16;
    const float* pe = p.in[16 + kv] + (size_t)layer * 2048;
    const float* w1 = p.in[kv ? 20 : 18] + (size_t)layer * 2048 * 128;
    float* sm = (float*)lds;
    const int jj = tid & 15, part = tid >> 4;
    float acc = 0.f;
#pragma unroll 8
    for (int i = 0; i < 64; ++i) { const int kk = part + i * 32; acc += pe[kk] * w1[(size_t)kk * 128 + j0 + jj]; }
    __syncthreads();
    sm[tid] = acc;
    __syncthreads();
    if (tid < 16) {
      float t = 0.f;
      for (int q = 0; q < 32; ++q) t += sm[q * 16 + tid];
      ((float*)(WS + G_WL + layer * WL_SIZE + (kv ? O_BCV1 : O_BCK1)))[j0 + tid] = t;
    }
    __syncthreads();
  }
  for (int it = bid; it < DEPTH * 32 * 9; it += nblk) {
    const int layer = it / (32 * 9), rem = it % (32 * 9), g = rem / 9, dg = rem % 9;
    unsigned char* wl = WS + G_WL + layer * WL_SIZE;
    float* pwr = (float*)lds; float* pwi = pwr + 64; float* kr = pwi + 64; float* ki = kr + 64; float* th1s = ki + 64; float* lrs = th1s + 64;
    float* bbr = lrs + 64; float* bbi = bbr + 1024; float* scre = bbi + 1024; float* scim = scre + 1024;
    const size_t gp = (size_t)(layer * 32 + g) * 64;
    __syncthreads();
    for (int idx = tid; idx < 1024; idx += NTHR) { scre[idx] = p.in[11][gp * 16 + idx]; scim[idx] = p.in[12][gp * 16 + idx]; }
    if (tid < 64) {
      const float lr = p.in[6][gp + tid], li = p.in[7][gp + tid];
      const float step = expf(p.in[8][layer * 32 + g]);
      const float th1 = li * step;
      float s1, c1; sincos_f(th1, s1, c1);
      const float mag = expf(lr * step);
      const float abr = mag * c1, abi = mag * s1;
      const float den = lr * lr + li * li;
      const float nr = abr - 1.0f, ni = abi;
      kr[tid] = (nr * lr + ni * li) / den;
      ki[tid] = (ni * lr - nr * li) / den;
      th1s[tid] = th1; lrs[tid] = lr * step;
    }
    __syncthreads();
    for (int idx = tid; idx < 1024; idx += NTHR) {
      int pp = idx >> 4;
      float br = p.in[9][gp * 16 + idx], bi = p.in[10][gp * 16 + idx];
      bbr[idx] = kr[pp] * br - ki[pp] * bi;
      bbi[idx] = kr[pp] * bi + ki[pp] * br;
    }
#pragma unroll 1
    for (int dd = 0; dd < 8; ++dd) {
      const int d = dg * 8 + dd;
      if (d > 64) break;
      __syncthreads();
      if (tid < 64) {
        float sd, cd; sincos_f(th1s[tid] * (float)d, sd, cd);
        const float md = expf(lrs[tid] * (float)d);
        pwr[tid] = md * cd; pwi[tid] = md * sd;
      }
      __syncthreads();
      if (d <= 63) {
        if (tid < 256) {
          const int co = tid >> 4, ci = tid & 15;
          float val = 0.f;
#pragma unroll 8
          for (int pp = 0; pp < 64; ++pp) {
            const float cr = scre[co * 64 + pp], cm = scim[co * 64 + pp];
            const float wr_ = cr * pwr[pp] - cm * pwi[pp], wi_ = cr * pwi[pp] + cm * pwr[pp];
            val += wr_ * bbr[pp * 16 + ci] - wi_ * bbi[pp * 16 + ci];
          }
          ((bf16_t*)(wl + O_KMAT))[(((size_t)g * 64 + d) * 16 + co) * 16 + ci] = f2bf(val);
        }
        const int sidx = 63 - d;
        bf16_t* em = (bf16_t*)(wl + O_EMAT);
        for (int idx = tid; idx < 1024; idx += NTHR) {
          const int pp = idx >> 4, ci = idx & 15;
          const float re = pwr[pp] * bbr[idx] - pwi[pp] * bbi[idx], im = pwr[pp] * bbi[idx] + pwi[pp] * bbr[idx];
          em[((size_t)g * 128 + pp) * 1024 + sidx * 16 + ci] = f2bf(re);
          em[((size_t)g * 128 + 64 + pp) * 1024 + sidx * 16 + ci] = f2bf(im);
        }
      }
      if (d >= 1) {
        const int t = d - 1;
        bf16_t* fm = (bf16_t*)(wl + O_FMAT);
        for (int idx = tid; idx < 1024; idx += NTHR) {
          const int co = idx >> 6, pp = idx & 63;
          const float cr = scre[idx], cm = scim[idx];
          const float wr_ = cr * pwr[pp] - cm * pwi[pp], wi_ = cr * pwi[pp] + cm * pwr[pp];
          fm[((size_t)g * 1024 + t * 16 + co) * 128 + pp] = f2bf(wr_);
          fm[((size_t)g * 1024 + t * 16 + co) * 128 + 64 + pp] = f2bf(-wi_);
        }
      }
      if (d == 64 && tid < 64) {
        float* a64 = (float*)(wl + O_A64);
        a64[(g * 64 + tid) * 2] = pwr[tid]; a64[(g * 64 + tid) * 2 + 1] = pwi[tid];
      }
    }
  }
}

__device__ void ln_rows(const float* src, float* dst, bf16_t* dstb, const float* gam, const float* bet, int nrows, int bid, int nblk) {
  const int tid = otid(), lane = tid & 63, wid = tid >> 6;
  const int stride = nblk * NWV;
  for (int row0 = bid * NWV + wid; row0 < nrows; row0 += 2 * stride) {
    float4 v[2][4];
    bool ok[2];
#pragma unroll
    for (int u = 0; u < 2; ++u) {
      const int row = row0 + u * stride;
      ok[u] = row < nrows;
      const float4* s4 = (const float4*)(src + (size_t)(ok[u] ? row : row0) * 1024);
#pragma unroll
      for (int i = 0; i < 4; ++i) v[u][i] = s4[i * 64 + lane];
    }
#pragma unroll
    for (int u = 0; u < 2; ++u) {
      const int row = row0 + u * stride;
      float sum = 0.f;
#pragma unroll
      for (int i = 0; i < 4; ++i) sum += (v[u][i].x + v[u][i].y) + (v[u][i].z + v[u][i].w);
      const float mean = wave_sum(sum, lane) * (1.0f / 1024.0f);
      float sq = 0.f;
#pragma unroll
      for (int i = 0; i < 4; ++i) {
        float a = v[u][i].x - mean, b = v[u][i].y - mean, c = v[u][i].z - mean, d = v[u][i].w - mean;
        sq += (a * a + b * b) + (c * c + d * d);
      }
      const float rstd = rsqrtf(wave_sum(sq, lane) * (1.0f / 1024.0f) + 1e-5f);
      if (ok[u]) {
#pragma unroll
        for (int i = 0; i < 4; ++i) {
          float4 gg = ((const float4*)gam)[i * 64 + lane], bb = ((const float4*)bet)[i * 64 + lane];
          float4 o;
          o.x = (v[u][i].x - mean) * rstd * gg.x + bb.x; o.y = (v[u][i].y - mean) * rstd * gg.y + bb.y;
          o.z = (v[u][i].z - mean) * rstd * gg.z + bb.z; o.w = (v[u][i].w - mean) * rstd * gg.w + bb.w;
          if (dst) ((float4*)(dst + (size_t)row * 1024))[i * 64 + lane] = o;
          if (dstb) {
            uint2 pk; pk.x = pack2(o.x, o.y); pk.y = pack2(o.z, o.w);
            ((uint2*)(dstb + (size_t)row * 1024))[i * 64 + lane] = pk;
          }
        }
      }
    }
  }
}

constexpr int PROJ_N0 = 5120;
__device__ void phase_proj(const Params& p, unsigned char* lds, int layer, int bid, int nblk) {
  unsigned char* WS = launder_ws(lds);
  pg8::Gemm g{(const bf16_t*)(WS + G_XB), (const bf16_t*)(WS + G_WL + layer * WL_SIZE + O_WIN), MC, PROJ_N0, 1024};
  pg8::StaticOrder S; S.init(MC, PROJ_N0, nblk, bid);
  pg8::EpiProj E{(bf16_t*)(WS + G_PROJ), (const float*)(WS + G_ROPE), 0, (bf16_t*)(WS + G_USSM)};
  pg8::gemm_phase<pg8::EpiProj, pg8::StaticOrder>((PG8_LAS unsigned char*)lds, g, S, E, nullptr);
}

__device__ void phase2(const Params& p, unsigned char* lds, int layer, int bid, int nblk) {
  unsigned char* WS = launder_ws(lds);
  unsigned char* wl = WS + G_WL + layer * WL_SIZE;
  const bf16_t* PROJ = (const bf16_t*)(WS + G_PROJ);
  constexpr int T_CMP = 32, T_S5 = 64, T_POOL = (MC / 128) * 4;
  const int hgrid = nblk >> 1;
  if (bid < hgrid) {
    pg8::Gemm g{(const bf16_t*)(WS + G_XB), (const bf16_t*)(wl + O_WIN) + (size_t)PROJ_N0 * 1024, MC, INP - PROJ_N0, 1024};
    pg8::StaticOrder S; S.init(MC, INP - PROJ_N0, hgrid, bid);
    pg8::EpiProj E{(bf16_t*)(WS + G_PROJ), (const float*)(WS + G_ROPE), PROJ_N0, (bf16_t*)(WS + G_USSM)};
    pg8::gemm_phase<pg8::EpiProj, pg8::StaticOrder>((PG8_LAS unsigned char*)lds, g, S, E, nullptr);
  }
  constexpr int T_HEAVY = T_CMP + T_S5, T_POOL0 = 256;
  const bool firsth = bid < hgrid;
  const int vstart = firsth ? bid : bid - hgrid, vstride = firsth ? hgrid : nblk - hgrid, vend = firsth ? T_POOL0 : T_HEAVY + T_POOL - T_POOL0;
  for (int v = vstart; v < vend; v += vstride) {
    const int t = firsth ? (T_HEAVY + v) : (v < T_HEAVY ? v : v + T_POOL0);
    f32x4 acc[4][2]; zero_acc(acc);
    if (t < T_CMP) {
      const int kv = t & 1, mt = t >> 1, m0 = mt * 128;
      const bf16_t* Bt = (const bf16_t*)(wl + (kv ? O_WCV1 : O_WCK1));
      const float* bias = (const float*)(wl + (kv ? O_BCV1 : O_BCK1));
      bf16_t* H1 = (bf16_t*)(WS + G_H1) + (size_t)kv * CHB * 512 * 128;
      const int col0 = C_KV + kv * 128;
      auto la = [=](int r, int kk) -> uint4 {
        const int row = m0 + r;
        int n = row & 255; if (n > 254) n = 254;
        const int k = (row >> 8) & 1, bl = row >> 9;
        return gld16(PROJ + ((size_t)bl * SEQ + 16 * n + (kk >> 6)) * INP + col0 + k * 64 + (kk & 63));
      };
      auto lb = [=](int n, int kk) -> uint4 { return gld16(Bt + (size_t)n * 2048 + kk); };
      gemm_acc(lds, 32, la, lb, acc);
      const int ecol = ((otid() >> 6) & 3) * 32 + ((otid() & 63) >> 4) * 4;
      const float4 bia0 = gldf4(bias + ecol), bia1 = gldf4(bias + ecol + 16);
      gemm_epi(acc, [=](int r, int c, f32x4 v, int ni) {
        const float4 b4 = ni ? bia1 : bia0;
        v[0] = gelu_tanh(v[0] + b4.x); v[1] = gelu_tanh(v[1] + b4.y); v[2] = gelu_tanh(v[2] + b4.z); v[3] = gelu_tanh(v[3] + b4.w);
        gst8(H1 + (size_t)(m0 + r) * 128 + c, pack4(v));
      });
    } else if (t < T_CMP + T_S5) {
      const int tt = t - T_CMP, g = tt >> 1, m0 = (tt & 1) * 128;
      const bf16_t* Bt = (const bf16_t*)(wl + O_EMAT) + (size_t)g * 128 * 1024;
      float* S = (float*)(WS + G_S);
      auto la = [=](int r, int kk) -> uint4 {
        return gld16((const bf16_t*)(WS + G_USSM) + ((size_t)g * MC + (size_t)(m0 + r) * 64) * 16 + kk);
      };
      auto lb = [=](int n, int kk) -> uint4 { return gld16(Bt + (size_t)n * 1024 + kk); };
      gemm_acc(lds, 16, la, lb, acc);
      gemm_epi(acc, [=](int r, int c, f32x4 v, int) {
        gstf4(S + ((size_t)g * NROW + m0 + r) * 128 + c, make_float4(v[0], v[1], v[2], v[3]));
      });
    } else {
      const int tt = t - T_CMP - T_S5, g = tt & 3, m0 = (tt >> 2) * 128;
      const bf16_t* Bt = (const bf16_t*)(wl + O_WPOOL) + g * 128 * 128;
      const float* pscale = p.in[5] + (size_t)layer * 512 + g * 128;
      bf16_t* Y = (bf16_t*)(WS + G_Y);
      auto lb = [=](int n, int kk) -> uint4 { return gld16(Bt + (size_t)n * 128 + kk); };
      auto pool_la = [=](auto wtag, int r, int kk) -> uint4 {
        constexpr int W = decltype(wtag)::value;
        const int row = m0 + r, tpos = row & (SEQ - 1);
        const int cnt = (tpos + 1 < W) ? (tpos + 1) : W;
        const bf16_t* base = PROJ + (size_t)row * INP + g * 128 + kk;
        uint4 u[W];
#pragma unroll
        for (int j = 0; j < W; ++j) u[j] = gld16(base - (size_t)((j < cnt) ? j : 0) * INP);
        float sum[8];
#pragma unroll
        for (int e = 0; e < 8; ++e) sum[e] = 0.f;
#pragma unroll
        for (int j = 0; j < W; ++j) {
          const float wj = (j < cnt) ? 1.0f : 0.0f;
          sum[0] += wj * __uint_as_float(u[j].x << 16); sum[1] += wj * __uint_as_float(u[j].x & 0xffff0000u);
          sum[2] += wj * __uint_as_float(u[j].y << 16); sum[3] += wj * __uint_as_float(u[j].y & 0xffff0000u);
          sum[4] += wj * __uint_as_float(u[j].z << 16); sum[5] += wj * __uint_as_float(u[j].z & 0xffff0000u);
          sum[6] += wj * __uint_as_float(u[j].w << 16); sum[7] += wj * __uint_as_float(u[j].w & 0xffff0000u);
        }
        const float ic = 1.0f / (float)cnt;
        uint4 o;
        o.x = pack2(sum[0] * ic - __uint_as_float(u[0].x << 16), sum[1] * ic - __uint_as_float(u[0].x & 0xffff0000u));
        o.y = pack2(sum[2] * ic - __uint_as_float(u[0].y << 16), sum[3] * ic - __uint_as_float(u[0].y & 0xffff0000u));
        o.z = pack2(sum[4] * ic - __uint_as_float(u[0].z << 16), sum[5] * ic - __uint_as_float(u[0].z & 0xffff0000u));
        o.w = pack2(sum[6] * ic - __uint_as_float(u[0].w << 16), sum[7] * ic - __uint_as_float(u[0].w & 0xffff0000u));
        return o;
      };
      if (g == 0) gemm_acc(lds, 2, [=](int r, int kk) -> uint4 { return pool_la(std::integral_constant<int, 2>{}, r, kk); }, lb, acc);
      else if (g == 1) gemm_acc(lds, 2, [=](int r, int kk) -> uint4 { return pool_la(std::integral_constant<int, 4>{}, r, kk); }, lb, acc);
      else if (g == 2) gemm_acc(lds, 2, [=](int r, int kk) -> uint4 { return pool_la(std::integral_constant<int, 8>{}, r, kk); }, lb, acc);
      else gemm_acc(lds, 2, [=](int r, int kk) -> uint4 { return pool_la(std::integral_constant<int, 16>{}, r, kk); }, lb, acc);
      const int ecol = ((otid() >> 6) & 3) * 32 + ((otid() & 63) >> 4) * 4;
      const float4 psc0 = gldf4(pscale + ecol), psc1 = gldf4(pscale + ecol + 16);
      gemm_epi(acc, [=](int r, int c, f32x4 v, int ni) {
        const float4 s4 = ni ? psc1 : psc0;
        v[0] *= s4.x; v[1] *= s4.y; v[2] *= s4.z; v[3] *= s4.w;
        gst8(Y + (size_t)(m0 + r) * 1536 + g * 128 + c, pack4(v));
      });
    }
  }
}

__device__ void phase3(const Params& p, unsigned char* lds, int layer, int bid, int nblk) {
  unsigned char* WS = launder_ws(lds);
  unsigned char* wl = WS + G_WL + layer * WL_SIZE;
  constexpr int T_CMP = 32, T_SCAN = 32 * CHB * 64 / NTHR;
  for (int t = bid; t < T_CMP + T_SCAN; t += nblk) {
    if (t < T_CMP) {
      const int kv = t & 1, m0 = (t >> 1) * 128;
      const bf16_t* A = (const bf16_t*)(WS + G_H1) + (size_t)kv * CHB * 512 * 128;
      const bf16_t* Bt = (const bf16_t*)(wl + (kv ? O_WCV2 : O_WCK2));
      bf16_t* KC = (bf16_t*)(WS + G_KCMP);
      bf16_t* VT = (bf16_t*)(WS + G_VCMPT);
      f32x4 acc[4][2]; zero_acc(acc);
      auto la = [=](int r, int kk) -> uint4 { return gld16(A + (size_t)(m0 + r) * 128 + kk); };
      auto lb = [=](int n, int kk) -> uint4 { return gld16(Bt + (size_t)(n & 63) * 128 + kk); };
      gemm_acc(lds, 2, la, lb, acc);
      gemm_epi(acc, [=](int r, int c, f32x4 v, int) {
        if (c < 64) {
          const int row = m0 + r;
          if (kv == 0) {
            gst8(KC + (size_t)row * 64 + c, pack4(v));
          } else {
            const int bk = row >> 8, n = row & 255;
#pragma unroll
            for (int e = 0; e < 4; ++e) VT[((size_t)bk * 64 + c + e) * 256 + n] = f2bf(v[e]);
          }
        }
      });
    } else {
      const int idx = (t - T_CMP) * NTHR + otid();
      const int pp = idx & 63, bl = (idx >> 6) % CHB, g = idx / (64 * CHB);
      const float* a64 = (const float*)(wl + O_A64);
      const float ar = a64[(g * 64 + pp) * 2], ai = a64[(g * 64 + pp) * 2 + 1];
      const float* S = (const float*)(WS + G_S) + ((size_t)g * NROW + bl * 64) * 128;
      bf16_t* HIN = (bf16_t*)(WS + G_HIN) + ((size_t)g * NROW + bl * 64) * 128;
      float hr = 0.f, hi = 0.f;
#pragma unroll 1
      for (int c0 = 0; c0 < 64; c0 += 16) {
        float sr[16], si[16];
#pragma unroll
        for (int c = 0; c < 16; ++c) { sr[c] = S[(c0 + c) * 128 + pp]; si[c] = S[(c0 + c) * 128 + 64 + pp]; }
#pragma unroll
        for (int c = 0; c < 16; ++c) {
          HIN[(c0 + c) * 128 + pp] = f2bf(hr); HIN[(c0 + c) * 128 + 64 + pp] = f2bf(hi);
          const float nr = ar * hr - ai * hi + sr[c], ni = ar * hi + ai * hr + si[c];
          hr = nr; hi = ni;
        }
      }
    }
  }
}

constexpr int CMP_LDS_OFF = 40960;
__device__ void cmp_attn_wave(const Params& p, unsigned char* lds, int it) {
  unsigned char* WS = launder_ws(lds);
  const int tid = otid(), lane = tid & 63, wid = __builtin_amdgcn_readfirstlane(tid >> 6), fr = lane & 15, fq = lane >> 4;
  const int pairidx = it >> 1;
  const int tg = (wid >> 2) ? 255 - pairidx : pairidx;
  const int bk = (it & 1) * 4 + (wid & 3), bl = bk >> 1, k = bk & 1;
  const bf16_t* PROJ = (const bf16_t*)(WS + G_PROJ);
  const bf16_t* KC = (const bf16_t*)(WS + G_KCMP) + (size_t)bk * 256 * 64;
  const bf16_t* VT = (const bf16_t*)(WS + G_VCMPT) + (size_t)bk * 64 * 256;
  float* ONSA = (float*)(WS + G_ONSA);
  u64* SEL = (u64*)(WS + G_SEL);
  float* sc = (float*)(lds + CMP_LDS_OFF) + wid * (16 * 65);
  const int t0 = tg * 16;
  const size_t tok = (size_t)bl * SEQ + t0 + fr;
  const int nvr = (tg == 0) ? 0 : ((fr == 15) ? tg : tg - 1);
  const int src = (lane + 48) & 63;
  float imp[16];
#pragma unroll
  for (int ni = 0; ni < 16; ++ni) imp[ni] = 0.f;
#pragma unroll 1
  for (int g = 0; g < 4; ++g) {
    int lnl = lane; asm volatile("" : "+v"(lnl));
    const int frl = lnl & 15, fql = lnl >> 4, srcl = (lnl + 48) & 63;
    const size_t tokl = (size_t)bl * SEQ + t0 + frl;
    const int h = k * 4 + g;
    int nrel = ((tg == 0) ? 0 : ((frl == 15) ? tg : tg - 1)) - fql * 4;
    asm volatile("" : "+v"(nrel));
    bf16x8 qf[2];
#pragma unroll
    for (int ks = 0; ks < 2; ++ks) qf[ks] = gld16b(PROJ + tokl * INP + C_Q + h * 64 + ks * 32 + fql * 8);
    f32x4 s[16];
#pragma unroll
    for (int ni = 0; ni < 16; ++ni) {
      s[ni] = (f32x4){0.f, 0.f, 0.f, 0.f};
      if (ni * 16 < tg) {
#pragma unroll
        for (int ks = 0; ks < 2; ++ks) {
          const bf16x8 kf = gld16b(KC + (size_t)(ni * 16 + frl) * 64 + ks * 32 + fql * 8);
          s[ni] = __builtin_amdgcn_mfma_f32_16x16x32_bf16(kf, qf[ks], s[ni], 0, 0, 0);
        }
      }
      if (ni & 1) asm volatile("" ::: "memory");
    }
    float rmax = -1e30f;
#pragma unroll
    for (int ni = 0; ni < 16; ++ni)
#pragma unroll
      for (int e = 0; e < 4; ++e) {
        if (ni * 16 + e < nrel) rmax = fmaxf(rmax, s[ni][e]);
      }
    rmax = fmaxf(rmax, shx(rmax, 16, lnl)); rmax = fmaxf(rmax, shx(rmax, 32, lnl));
    float rsum = 0.f;
#pragma unroll
    for (int ni = 0; ni < 16; ++ni)
#pragma unroll
      for (int e = 0; e < 4; ++e) {
        const float pv = (ni * 16 + e < nrel) ? __builtin_amdgcn_exp2f(s[ni][e] - rmax) : 0.f;
        s[ni][e] = pv; rsum += pv;
      }
    rsum += shx(rsum, 16, lnl); rsum += shx(rsum, 32, lnl);
    const float inv = (rsum > 0.f) ? 1.0f / rsum : 0.f;
#pragma unroll
    for (int ni = 0; ni < 16; ++ni) {
#pragma unroll
      for (int e = 0; e < 4; ++e) s[ni][e] *= inv;
      const float a = __int_as_float(__builtin_amdgcn_ds_bpermute(srcl << 2, __float_as_int(s[ni][3])));
      const float b = (ni > 0) ? __int_as_float(__builtin_amdgcn_ds_bpermute(srcl << 2, __float_as_int(s[ni > 0 ? ni - 1 : 0][3]))) : 0.f;
      const float prev = (fql > 0) ? a : b;
      imp[ni] += 2.0f * (s[ni][0] + s[ni][1] + s[ni][2]) + s[ni][3] + prev;
      if ((ni & 3) == 3) asm volatile("" ::: "memory");
    }
    f32x4 o[4];
#pragma unroll
    for (int nd = 0; nd < 4; ++nd) o[nd] = (f32x4){0.f, 0.f, 0.f, 0.f};
#pragma unroll
    for (int kh = 0; kh < 2; ++kh) {
      if (kh * 128 < tg) {
#pragma unroll
        for (int kq = 0; kq < 4; ++kq) {
          const int k8 = kh * 4 + kq;
          const uint2 pa = pack4(s[2 * k8]), pb = pack4(s[2 * k8 + 1]);
          const bf16x8 pf = __builtin_bit_cast(bf16x8, (u32x4v){pa.x, pa.y, pb.x, pb.y});
#pragma unroll
          for (int nd = 0; nd < 4; ++nd) {
            const uint2 va = gld8(VT + (size_t)(nd * 16 + frl) * 256 + k8 * 32 + fql * 4);
            const uint2 vb = gld8(VT + (size_t)(nd * 16 + frl) * 256 + k8 * 32 + 16 + fql * 4);
            o[nd] = __builtin_amdgcn_mfma_f32_16x16x32_bf16(__builtin_bit_cast(bf16x8, (u32x4v){va.x, va.y, vb.x, vb.y}), pf, o[nd], 0, 0, 0);
          }
          if (kq & 1) asm volatile("" ::: "memory");
        }
      }
    }
    const float gt = bf2f(PROJ[tokl * INP + C_GN + h * 3 + 0]);
#pragma unroll
    for (int nd = 0; nd < 4; ++nd)
      gstf4(ONSA + tokl * 512 + h * 64 + nd * 16 + fql * 4, make_float4(gt * o[nd][0], gt * o[nd][1], gt * o[nd][2], gt * o[nd][3]));
  }
#pragma unroll
  for (int ni = 0; ni < 16; ++ni) sc[fr * 65 + ni * 4 + fq] = imp[ni];
  asm volatile("s_waitcnt lgkmcnt(0)" ::: "memory");
#pragma unroll 1
  for (int r = 0; r < 16; ++r) {
    const int t = t0 + r, cur = t >> 6, sb = lane;
    const float impv = sc[r * 65 + sb];
    const bool forced = (sb == 0) || (sb == cur) || (sb == cur - 1);
    const float score = forced ? 1e6f : ((sb <= cur) ? impv : -1e6f);
    const unsigned bits = __float_as_uint(score);
    const unsigned u = (bits & 0x80000000u) ? ~bits : (bits | 0x80000000u);
    unsigned T = 0u;
#pragma unroll
    for (int bit = 31; bit >= 0; --bit) {
      const unsigned cand = T | (1u << bit);
      if (__popcll(__ballot(u >= cand)) >= 16) T = cand;
    }
    u64 m = __ballot(u > T);
    u64 eq = __ballot(u == T);
    int need = 16 - __popcll(m);
    while (need > 0 && eq) { const u64 low = eq & (~eq + 1ull); m |= low; eq ^= low; --need; }
    if (lane == 0) SEL[((size_t)bl * SEQ + t) * 2 + k] = m;
  }
  asm volatile("s_waitcnt lgkmcnt(0)" ::: "memory");
}

__device__ void phase4(const Params& p, unsigned char* lds, int layer, int bid, int nblk, int mode) {
  unsigned char* WS = launder_ws(lds);
  unsigned char* wl = WS + G_WL + layer * WL_SIZE;
  const bf16_t* PROJ = (const bf16_t*)(WS + G_PROJ);
  constexpr int T_S5 = 32 * 2 * 8, T_CMP = CHB * 2 * 256 / NWV;
  for (int t = bid; t < T_S5 + T_CMP; t += nblk) {
    if (mode == 1 && t >= T_S5) break;
    if (mode == 2 && t < T_S5) continue;
    if (t < T_S5) {
      const int nt = (t < T_S5 / 2) ? (7 - (t & 7)) : (t & 7), mt = (t >> 3) & 1, g = t >> 4;
      const int m0 = mt * 128, n0 = nt * 128, nk1 = 2 * nt + 2;
      const bf16_t* HIN = (const bf16_t*)(WS + G_HIN) + (size_t)g * NROW * 128;
      const bf16_t* USSM = (const bf16_t*)(WS + G_USSM);
      const bf16_t* KM = (const bf16_t*)(wl + O_KMAT) + (size_t)g * 64 * 256;
      const bf16_t* FM = (const bf16_t*)(wl + O_FMAT) + (size_t)g * 1024 * 128;
      const float* dsk = p.in[13] + (size_t)(layer * 32 + g) * 16;
      bf16_t* ZS = (bf16_t*)(WS + G_ZS);
      f32x4 acc[4][2]; zero_acc(acc);
      auto la = [=](int r, int kk) -> uint4 {
        const bool carry = kk >= nk1 * 64;
        const int k2 = carry ? (kk - nk1 * 64) : kk;
        const bf16_t* pu = USSM + ((size_t)g * MC + (size_t)(m0 + r) * 64) * 16 + k2;
        const bf16_t* ph_ = HIN + (size_t)(m0 + r) * 128 + (k2 & 127);
        return gld16(carry ? ph_ : pu);
      };
      auto lb = [=](int n, int kk) -> uint4 {
        const bool carry = kk >= nk1 * 64;
        const int k2 = carry ? (kk - nk1 * 64) : kk;
        const int nn = n0 + n, tt = nn >> 4, co = nn & 15;
        const int dd = tt - (k2 >> 4);
        const bf16_t* pk = KM + ((size_t)(dd < 0 ? 0 : dd) * 16 + co) * 16 + (k2 & 15);
        const bf16_t* pf = FM + (size_t)nn * 128 + (k2 & 127);
        uint4 v = gld16(carry ? pf : pk);
        if (!carry && dd < 0) v = make_uint4(0, 0, 0, 0);
        return v;
      };
      gemm_acc(lds, nk1 + 2, la, lb, acc);
      uint2 upre[4][2];
      gemm_pre(upre, [=](int r, int c) -> uint2 {
        const int nn = n0 + c, tt = nn >> 4, co = nn & 15;
        return gld8(USSM + ((size_t)g * MC + (size_t)(m0 + r) * 64 + tt) * 16 + co);
      });
      const float4 d4 = gldf4(dsk + ((otid() & 63) >> 4) * 4);
      gemm_epi_pre(acc, upre, [=](int r, int c, f32x4 v, uint2 pre, int) {
        const int nn = n0 + c, tt = nn >> 4, co = nn & 15;
        const size_t tok = (size_t)(m0 + r) * 64 + tt;
        const f32x4 u = unpack4(pre);
        v[0] = gelu_tanh(v[0] + d4.x * u[0]); v[1] = gelu_tanh(v[1] + d4.y * u[1]);
        v[2] = gelu_tanh(v[2] + d4.z * u[2]); v[3] = gelu_tanh(v[3] + d4.w * u[3]);
        gst8(ZS + tok * 512 + g * 16 + co, pack4(v));
      });
    } else {
      cmp_attn_wave(p, lds, t - T_S5);
    }
  }
}

constexpr int AMI = 2;
__device__ void attn_item(const Params& p, unsigned char* lds, int item) {
  unsigned char* WS = launder_ws(lds);
  const int tid = otid(), lane = tid & 63, wid = __builtin_amdgcn_readfirstlane(tid >> 6), g = wid & 3, th = wid >> 2, fr = lane & 15, fq = lane >> 4;
  const int qb = (item < 256) ? (63 - (item >> 3)) : ((item - 256) >> 3), k = item & 1, bl = (item >> 1) & 3;
  const bf16_t* PROJ = (const bf16_t*)(WS + G_PROJ);
  float* ONSA = (float*)(WS + G_ONSA);
  bf16_t* YN = (bf16_t*)(WS + G_Y) + 1024;
  const u64* SEL = (const u64*)(WS + G_SEL);
  bf16_t* sK = (bf16_t*)lds;
  bf16_t* sVt = sK + 64 * 72;
  const int h = k * 4 + g, t0 = qb * 64 + th * (AMI * 16);
  const int jq = qb;
  const size_t tokb = (size_t)bl * SEQ;
  bf16x8 qf[AMI][2];
#pragma unroll
  for (int mi = 0; mi < AMI; ++mi)
#pragma unroll
    for (int ks = 0; ks < 2; ++ks) qf[mi][ks] = gld16b(PROJ + (tokb + t0 + mi * 16 + fr) * INP + C_Q + h * 64 + ks * 32 + fq * 8);
  u64 mrow[AMI];
#pragma unroll
  for (int mi = 0; mi < AMI; ++mi) mrow[mi] = SEL[(tokb + t0 + mi * 16 + fr) * 2 + k];
  u64 um;
  {
    const u64 mm = SEL[(tokb + qb * 64 + lane) * 2 + k];
    unsigned lo = (unsigned)mm, hi = (unsigned)(mm >> 32);
#pragma unroll
    for (int o = 32; o >= 1; o >>= 1) { lo |= shxu(lo, o, lane); hi |= shxu(hi, o, lane); }
    lo = __builtin_amdgcn_readfirstlane(lo); hi = __builtin_amdgcn_readfirstlane(hi);
    um = ((u64)hi << 32) | lo;
  }
  const u64 causal = (jq == 63) ? ~0ull : ((1ull << (jq + 1)) - 1ull);
  um &= causal;
  if (wid >= 4) __builtin_amdgcn_s_setprio(1);
#pragma unroll 1
  for (int pass = 0; pass < 2; ++pass) {
    const int kcol = C_KV + (pass == 0 ? 512 : 256) + k * 64, vcol = kcol + 128;
    u64 blk;
    if (pass == 0) {
      const int lo = (qb >= 8) ? (qb - 8) : 0;
      blk = causal & ~((1ull << lo) - 1ull);
    } else blk = um;
    f32x4 o[AMI][4];
#pragma unroll
    for (int i = 0; i < AMI; ++i)
#pragma unroll
      for (int j = 0; j < 4; ++j) o[i][j] = (f32x4){0.f, 0.f, 0.f, 0.f};
    float mst[AMI], lst[AMI];
#pragma unroll
    for (int i = 0; i < AMI; ++i) { mst[i] = 0.f; lst[i] = 0.f; }
    bool first = true;
    const int lo_blk = (pass == 0 && qb >= 8) ? (qb - 8) : -1;
    const int krow = tid >> 3, kc8 = (tid & 7) * 8;
    auto pop = [&]() -> int { const int j_ = 63 - __builtin_clzll(blk); blk &= ~(1ull << j_); return j_; };
    auto stage = [&](int b_, const uint4& kreg, const uint4& vreg) {
      bf16_t* dK = sK + b_ * (2 * 64 * 72);
      bf16_t* dV = dK + 64 * 72;
      *(uint4*)(dK + krow * 72 + kc8) = kreg;
      const unsigned w[4] = {vreg.x, vreg.y, vreg.z, vreg.w};
#pragma unroll
      for (int e = 0; e < 4; ++e) {
        dV[(wid * 8 + 2 * e) * 72 + lane] = (bf16_t)(w[e] & 0xffffu);
        dV[(wid * 8 + 2 * e + 1) * 72 + lane] = (bf16_t)(w[e] >> 16);
      }
    };
    int jc = pop(), jn = -1, bsel = 0;
    uint4 kreg = gld16(PROJ + (tokb + jc * 64 + krow) * INP + kcol + kc8);
    uint4 vreg = gld16(PROJ + (tokb + jc * 64 + lane) * INP + vcol + wid * 8);
    __syncthreads();
    stage(0, kreg, vreg);
    if (blk) {
      jn = pop();
      kreg = gld16(PROJ + (tokb + jn * 64 + krow) * INP + kcol + kc8);
      vreg = gld16(PROJ + (tokb + jn * 64 + lane) * INP + vcol + wid * 8);
    }
    __syncthreads();
    for (;;) {
      const int j = jc;
      const bf16_t* cK = sK + bsel * (2 * 64 * 72);
      const bf16_t* cVt = cK + 64 * 72;
      int jnn = -1;
      if (jn >= 0) {
        stage(bsel ^ 1, kreg, vreg);
        if (blk) {
          jnn = pop();
          kreg = gld16(PROJ + (tokb + jnn * 64 + krow) * INP + kcol + kc8);
          vreg = gld16(PROJ + (tokb + jnn * 64 + lane) * INP + vcol + wid * 8);
        }
      }
      const bool maskblk = (j == jq) || (j == lo_blk);
      f32x4 sall[AMI][4];
      uint2 pp[AMI][4];
#pragma unroll
      for (int mi = 0; mi < AMI; ++mi) {
        const bool rowsel = (pass == 0) || ((mrow[mi] >> j) & 1ull);
        const float cinit = rowsel ? -mst[mi] : -1e30f;
#pragma unroll
        for (int ni = 0; ni < 4; ++ni) sall[mi][ni] = (f32x4){cinit, cinit, cinit, cinit};
      }
#pragma unroll
      for (int ks = 0; ks < 2; ++ks)
#pragma unroll
        for (int ni = 0; ni < 4; ++ni) {
          const bf16x8 kf = *(const bf16x8*)(cK + (ni * 16 + fr) * 72 + ks * 32 + fq * 8);
#pragma unroll
          for (int mi = 0; mi < AMI; ++mi) sall[mi][ni] = __builtin_amdgcn_mfma_f32_16x16x32_bf16(kf, qf[mi][ks], sall[mi][ni], 0, 0, 0);
        }
#pragma unroll
      for (int mi = 0; mi < AMI; ++mi) {
        f32x4 (&s)[4] = sall[mi];
        if (maskblk) {
          const int hi = t0 + mi * 16 + fr - j * 64, lo = hi - 512;
#pragma unroll
          for (int ni = 0; ni < 4; ++ni)
#pragma unroll
            for (int e = 0; e < 4; ++e) {
              const int key = ni * 16 + fq * 4 + e;
              s[ni][e] = (key <= hi && key > lo) ? s[ni][e] : -1e30f;
            }
        }
        float lm = s[0][0];
#pragma unroll
        for (int ni = 0; ni < 4; ++ni)
#pragma unroll
          for (int e = 0; e < 4; ++e) lm = fmaxf(lm, s[ni][e]);
        if (__any(first || lm > 64.0f)) {
          float r = fmaxf(lm, shx(lm, 16, lane)); r = fmaxf(r, shx(r, 32, lane));
          float delta = first ? r : fmaxf(r, 0.f);
          if (delta < -1e29f) delta = 0.f;
          const float alpha = __builtin_amdgcn_exp2f(-delta);
          mst[mi] += delta; lst[mi] *= alpha;
#pragma unroll
          for (int nd = 0; nd < 4; ++nd)
#pragma unroll
            for (int e = 0; e < 4; ++e) o[mi][nd][e] *= alpha;
#pragma unroll
          for (int ni = 0; ni < 4; ++ni)
#pragma unroll
            for (int e = 0; e < 4; ++e) s[ni][e] -= delta;
        }
        float rsum = 0.f;
#pragma unroll
        for (int ni = 0; ni < 4; ++ni) {
#pragma unroll
          for (int e = 0; e < 4; ++e) { const float pv = __builtin_amdgcn_exp2f(s[ni][e]); s[ni][e] = pv; rsum += pv; }
          pp[mi][ni] = pack4(s[ni]);
        }
        lst[mi] += rsum;
      }
      first = false;
#pragma unroll
      for (int ks = 0; ks < 2; ++ks) {
        bf16x8 vf[4], pf[AMI];
#pragma unroll
        for (int nd = 0; nd < 4; ++nd) {
          const uint2 va = *(const uint2*)(cVt + (nd * 16 + fr) * 72 + ks * 32 + fq * 4);
          const uint2 vb = *(const uint2*)(cVt + (nd * 16 + fr) * 72 + ks * 32 + 16 + fq * 4);
          vf[nd] = __builtin_bit_cast(bf16x8, (u32x4v){va.x, va.y, vb.x, vb.y});
        }
#pragma unroll
        for (int mi = 0; mi < AMI; ++mi) pf[mi] = __builtin_bit_cast(bf16x8, (u32x4v){pp[mi][2 * ks].x, pp[mi][2 * ks].y, pp[mi][2 * ks + 1].x, pp[mi][2 * ks + 1].y});
#pragma unroll
        for (int mi = 0; mi < AMI; ++mi)
#pragma unroll
          for (int nd = 0; nd < 4; ++nd) o[mi][nd] = __builtin_amdgcn_mfma_f32_16x16x32_bf16(vf[nd], pf[mi], o[mi][nd], 0, 0, 0);
      }
      if (jn < 0) break;
      __syncthreads();
      jc = jn; jn = jnn; bsel ^= 1;
    }
#pragma unroll
    for (int mi = 0; mi < AMI; ++mi) {
      const size_t tok = tokb + t0 + mi * 16 + fr;
      float lsum = lst[mi]; lsum += shx(lsum, 16, lane); lsum += shx(lsum, 32, lane);
      const float gt = bf2f(PROJ[tok * INP + C_GN + h * 3 + (pass == 0 ? 2 : 1)]) / lsum;
      float4 prevs[4];
#pragma unroll
      for (int nd = 0; nd < 4; ++nd) prevs[nd] = gldf4(ONSA + tok * 512 + h * 64 + nd * 16 + fq * 4);
#pragma unroll
      for (int nd = 0; nd < 4; ++nd) {
        const float4 prev = prevs[nd];
        f32x4 r;
        r[0] = prev.x + gt * o[mi][nd][0]; r[1] = prev.y + gt * o[mi][nd][1];
        r[2] = prev.z + gt * o[mi][nd][2]; r[3] = prev.w + gt * o[mi][nd][3];
        if (pass == 0) gstf4(ONSA + tok * 512 + h * 64 + nd * 16 + fq * 4, make_float4(r[0], r[1], r[2], r[3]));
        else gst8(YN + tok * 1536 + h * 64 + nd * 16 + fq * 4, pack4(r));
      }
    }
  }
  __builtin_amdgcn_s_setprio(0);
}

__device__ void phase5(const Params& p, unsigned char* lds, int layer, int bid, int nblk) {
  unsigned char* WS = launder_ws(lds);
  unsigned char* wl = WS + G_WL + layer * WL_SIZE;
  constexpr int T_ATT = CHB * 2 * 64, T_GLU = (MC / 128) * 4;
  for (int t = bid; t < T_ATT + T_GLU; t += nblk) {
    if (t < T_ATT) {
      attn_item(p, lds, t);
    } else {
      const int tt = t - T_ATT, nt = tt & 3, m0 = (tt >> 2) * 128, n0 = nt * 128;
      const bf16_t* ZS = (const bf16_t*)(WS + G_ZS);
      const bf16_t* Bt = (const bf16_t*)(wl + O_WGLU);
      const float* bg = p.in[15] + (size_t)layer * 512;
      bf16_t* Y = (bf16_t*)(WS + G_Y);
      f32x4 acc[4][2]; zero_acc(acc);
      auto la = [=](int r, int kk) -> uint4 { return gld16(ZS + (size_t)(m0 + r) * 512 + kk); };
      auto lb = [=](int n, int kk) -> uint4 { return gld16(Bt + (size_t)(n0 + n) * 512 + kk); };
      gemm_acc(lds, 8, la, lb, acc);
      uint2 zpre[4][2];
      gemm_pre(zpre, [=](int r, int c) -> uint2 { return gld8(ZS + (size_t)(m0 + r) * 512 + n0 + c); });
      const int ecol = ((otid() >> 6) & 3) * 32 + ((otid() & 63) >> 4) * 4;
      const float4 bgl0 = gldf4(bg + n0 + ecol), bgl1 = gldf4(bg + n0 + ecol + 16);
      gemm_epi_pre(acc, zpre, [=](int r, int c, f32x4 v, uint2 pre, int ni) {
        const float4 b4 = ni ? bgl1 : bgl0;
        const f32x4 z = unpack4(pre);
        v[0] = z[0] * sigmoidf_(v[0] + b4.x); v[1] = z[1] * sigmoidf_(v[1] + b4.y);
        v[2] = z[2] * sigmoidf_(v[2] + b4.z); v[3] = z[3] * sigmoidf_(v[3] + b4.w);
        gst8(Y + (size_t)(m0 + r) * 1536 + 512 + n0 + c, pack4(v));
      });
    }
  }
}

__device__ void phase_merge(const Params& p, unsigned char* lds, int layer, int bid, int nblk) {
  unsigned char* WS = launder_ws(lds);
  unsigned char* wl = WS + G_WL + layer * WL_SIZE;
  pg8::Gemm g{(const bf16_t*)(WS + G_Y), (const bf16_t*)(wl + O_WUP), MC, 1024, 1536};
  pg8::StaticOrder S; S.init(MC, 1024, nblk, bid);
  pg8::EpiMerge E{(const bf16_t*)(WS + G_PROJ), (bf16_t*)(WS + G_ONSA)};
  pg8::gemm_phase<pg8::EpiMerge, pg8::StaticOrder>((PG8_LAS unsigned char*)lds, g, S, E, nullptr);
}
template <int K>
__device__ void phase_resid(const Params& p, unsigned char* lds, const bf16_t* A, const bf16_t* Bt, float* X, int bid, int nblk) {
  unsigned char* WS = launder_ws(lds);
  pg8::Gemm g{A, Bt, MC, 1024, K};
  pg8::StaticOrder S; S.init(MC, 1024, nblk, bid);
  pg8::EpiResid E{X, (const bf16_t*)(WS + G_XB)};
  pg8::gemm_phase<pg8::EpiResid, pg8::StaticOrder>((PG8_LAS unsigned char*)lds, g, S, E, nullptr);
}
__device__ void phase_ff1(const Params& p, unsigned char* lds, int layer, int bid, int nblk) {
  unsigned char* WS = launder_ws(lds);
  pg8::Gemm g{(const bf16_t*)(WS + G_XB), (const bf16_t*)(WS + G_WL + layer * WL_SIZE + O_WFF1), MC, 4096, 1024};
  pg8::StaticOrder S; S.init(MC, 4096, nblk, bid);
  pg8::EpiRelu2 E{(bf16_t*)(WS + G_PROJ), 4096};
  pg8::gemm_phase<pg8::EpiRelu2, pg8::StaticOrder>((PG8_LAS unsigned char*)lds, g, S, E, nullptr);
}

#define XB_TMO      128
#define XB_XCNT(j)  (256  + 64 * (j))
#define XB_XSUB(j)  (1280 + 64 * (j))
#define XB_XGEN(j)  (2304 + 64 * (j))
#define XB_TOP      3328
#define XB_TOPGEN   3392
#define XCD_BAR_WORDS 3456
#define XB_SPIN_CAP (1u << 18)
#define LAS __attribute__((address_space(3)))

__device__ __forceinline__ unsigned xb_ld(unsigned* p)              { return __hip_atomic_load(p, __ATOMIC_RELAXED, __HIP_MEMORY_SCOPE_AGENT); }
__device__ __forceinline__ unsigned xb_add(unsigned* p, unsigned v) { return __hip_atomic_fetch_add(p, v, __ATOMIC_RELAXED, __HIP_MEMORY_SCOPE_AGENT); }
__device__ __forceinline__ unsigned xb_xcc_id() { return (unsigned)__builtin_amdgcn_s_getreg((3 << 11) | 20) & 0xFu; }
#define XB_SPIN(cond, bar) do { unsigned _sp = 0; while (cond) { __builtin_amdgcn_s_sleep(1); \
    if ((++_sp & 255u) == 0u) { if (xb_ld(&(bar)[XB_TMO])) break; if (_sp > XB_SPIN_CAP) { atomicAdd(&(bar)[XB_TMO], 1u); break; } } } } while (0)

struct XcdBarrier {
    unsigned* bar; unsigned x;
    volatile LAS unsigned* st;
};

__device__ __forceinline__ XcdBarrier xcd_barrier_post(unsigned* bar, volatile LAS unsigned* st) {
    XcdBarrier b; b.bar = bar; b.x = xb_xcc_id(); b.st = st;
    if (threadIdx.x == 0) (void)xb_add(&bar[XB_XCNT(b.x)], 1u);
    return b;
}
__device__ __forceinline__ void xcd_barrier_complete(unsigned* bar, unsigned x, unsigned& nloc, unsigned& nx) {
    const unsigned G = gridDim.x * gridDim.y * gridDim.z;
    unsigned sum, cnt, mine, sp = 0u;
    for (;;) {
        sum = 0u; cnt = 0u; mine = 0u;
#pragma unroll
        for (unsigned j = 0; j < 16; ++j) { const unsigned c = xb_ld(&bar[XB_XCNT(j)]); sum += c; cnt += (c > 0u) ? 1u : 0u; mine = (j == x) ? c : mine; }
        if (sum == G) break;
        __builtin_amdgcn_s_sleep(1);
        if ((++sp & 255u) == 0u) { if (xb_ld(&bar[XB_TMO])) break; if (sp > XB_SPIN_CAP) { atomicAdd(&bar[XB_TMO], 1u); break; } }
    }
    nloc = mine > 0u ? mine : 1u; nx = cnt > 0u ? cnt : 1u;
}

__device__ __forceinline__ void xcd_barrier(const XcdBarrier& b) {
    asm volatile("s_waitcnt vmcnt(0)" ::: "memory");
    __syncthreads();
    if (threadIdx.x == 0) {
        unsigned* bar = b.bar;
        __builtin_amdgcn_s_waitcnt(0);
        unsigned nloc = b.st[0], nx = b.st[1];
        if (nloc == 0u) { xcd_barrier_complete(bar, b.x, nloc, nx); b.st[0] = nloc; b.st[1] = nx; }
        const unsigned old = xb_add(&bar[XB_XSUB(b.x)], 1u);
        const unsigned gen = old / nloc;
        if (old + 1u == (gen + 1u) * nloc) {
            __builtin_amdgcn_fence(__ATOMIC_RELEASE, "agent");
            asm volatile("s_waitcnt vmcnt(0)" ::: "memory");
            const unsigned og = xb_add(&bar[XB_TOP], 1u);
            const unsigned tg = og / nx;
            if (og + 1u == (tg + 1u) * nx) xb_add(&bar[XB_TOPGEN], 1u);
            else XB_SPIN(xb_ld(&bar[XB_TOPGEN]) == tg, bar);
            __builtin_amdgcn_fence(__ATOMIC_ACQUIRE, "agent");
            xb_add(&bar[XB_XGEN(b.x)], 1u);
            asm volatile("s_waitcnt vmcnt(0)" ::: "memory");
        } else {
            XB_SPIN(xb_ld(&bar[XB_XGEN(b.x)]) == gen, bar);
            __builtin_amdgcn_fence(__ATOMIC_ACQUIRE, "agent");
            asm volatile("s_waitcnt vmcnt(0)" ::: "memory");
        }
    }
    __syncthreads();
}


__device__ void run_phase(const Params& p, unsigned char* lds, int ph, int layer, int chunk, int bid, int nblk) {
  unsigned char* WS = launder_ws(lds);
  float* X = p.out + (size_t)chunk * MC * 1024;
  unsigned char* wl = WS + G_WL + layer * WL_SIZE;
  bf16_t* XB = (bf16_t*)(WS + G_XB);
  switch (ph) {
    case 0: phase0(p, lds, bid, nblk);
            ln_rows(p.in[0], (float*)nullptr, XB, p.in[1], p.in[2], MC, bid, nblk); break;
    case 2: phase_proj(p, lds, layer, bid, nblk); break;
    case 3: phase2(p, lds, layer, bid, nblk); break;
    case 4: phase3(p, lds, layer, bid, nblk); break;
    case 5: case 13: case 14: phase4(p, lds, layer, bid, nblk, ph == 5 ? 0 : ph - 12); break;
    case 6: phase5(p, lds, layer, bid, nblk); break;
    case 7: phase_merge(p, lds, layer, bid, nblk); break;
    case 8: phase_resid<1024>(p, lds, (const bf16_t*)(WS + G_ONSA), (const bf16_t*)(wl + O_WOUT), X, bid, nblk); break;
    case 9: ln_rows(X, (float*)nullptr, XB, p.in[26] + layer * 1024, p.in[27] + layer * 1024, MC, bid, nblk); break;
    case 10: phase_ff1(p, lds, layer, bid, nblk); break;
    case 11: phase_resid<4096>(p, lds, (const bf16_t*)(WS + G_PROJ), (const bf16_t*)(wl + O_WFF2), X, bid, nblk); break;
    case 12: {
      const bool fold = (layer + 1 == DEPTH) && (chunk + 1 < NCH);
      const int nj = fold ? 2 : 1;
#pragma unroll 1
      for (int i = 0; i < nj; ++i) {
        const bool second = (i == 1);
        ln_rows(second ? p.in[0] + (size_t)(chunk + 1) * MC * 1024 : X, (!second && layer + 1 == DEPTH) ? X : (float*)nullptr,
                (second || layer + 1 < DEPTH) ? XB : (bf16_t*)nullptr, second ? p.in[1] : p.in[30] + layer * 1024, second ? p.in[2] : p.in[31] + layer * 1024, MC, bid, nblk);
      }
      break; }
    default: break;
  }
}

__global__ void __launch_bounds__(NTHR, 2) k_mega(Params p) {
  __shared__ __attribute__((aligned(16))) unsigned char lds[LDS_BYTES + 256];
  cg::grid_group grid = cg::this_grid();
  {
    volatile LAS unsigned* bst = (volatile LAS unsigned*)(lds + LDS_BYTES);
    if (threadIdx.x == 0) { bst[0] = 0u; bst[1] = 0u; const unsigned long long wsv = (unsigned long long)p.ws; bst[4] = (unsigned)wsv; bst[5] = (unsigned)(wsv >> 32); }
    __syncthreads();
    (void)xcd_barrier_post((unsigned*)(launder_ws(lds) + G_BAR), bst);
  }
  const int bid = blockIdx.x, nblk = gridDim.x;
#ifdef DBL_LO
  constexpr int NEXTRA = DBL_HI - DBL_LO + 1;
  constexpr int DLO = DBL_LO, DHI = DBL_HI;
#else
  constexpr int NEXTRA = 0, DLO = 100, DHI = 100;
#endif
  constexpr int PER_LAYER = 11 + NEXTRA, PER_CHUNK = DEPTH * PER_LAYER, NSTEP = 1 + NCH * PER_CHUNK;
#pragma unroll 1
  for (int step = 0; step < NSTEP; ++step) {
    int ph = 0, layer = 0, chunk = 0;
    if (step > 0) {
      const int s = step - 1, r = s % PER_CHUNK;
      chunk = s / PER_CHUNK; layer = r / PER_LAYER;
      const int i = r % PER_LAYER, nfirst = DHI - 2 + 1;
      if (NEXTRA == 0 || i < nfirst) ph = 2 + i;
      else if (i < nfirst + NEXTRA) ph = DLO + (i - nfirst);
      else ph = 2 + i - NEXTRA;
    }
    run_phase(p, lds, ph, layer, chunk, bid, nblk);
    if (step + 1 < NSTEP) { if (step == 0) grid.sync(); else { XcdBarrier xb; xb.bar = (unsigned*)(launder_ws(lds) + G_BAR); xb.x = xb_xcc_id(); xb.st = (volatile LAS unsigned*)(lds + LDS_BYTES); xcd_barrier(xb); } }
  }
}

extern "C" void kernel_launch(void* const* d_in, const int* in_sizes, int n_in, void* d_out, int out_size, void* d_ws, size_t ws_size,
                              hipStream_t stream) {
  Params p{};
  for (int i = 0; i < 32; ++i) p.in[i] = (const float*)d_in[i];
  p.out = (float*)d_out;
  p.ws = (unsigned char*)d_ws;
  static int grid_blocks = 0;
  if (!grid_blocks) {
    int dev = 0, cus = 0, per_cu = 0;
    (void)hipGetDevice(&dev);
    (void)hipDeviceGetAttribute(&cus, hipDeviceAttributeMultiprocessorCount, dev);
    (void)hipOccupancyMaxActiveBlocksPerMultiprocessor(&per_cu, k_mega, NTHR, 0);
    if (per_cu > 1) per_cu = 1;
    if (per_cu < 1) per_cu = 1;
    grid_blocks = cus * per_cu;
  }
  (void)hipMemsetAsync((unsigned char*)d_ws + G_BAR, 0, XCD_BAR_WORDS * 4, stream);
  void* args[] = {&p};
  (void)hipLaunchCooperativeKernel((void*)k_mega, dim3(grid_blocks), dim3(NTHR), args, 0, stream);
}
```

```cpp
#include <hip/hip_runtime.h>
#include <hip/hip_cooperative_groups.h>
#include <type_traits>
namespace cg = cooperative_groups;

typedef unsigned short bf16_t;
typedef short bf16x8 __attribute__((ext_vector_type(8)));
typedef float f32x4 __attribute__((ext_vector_type(4)));
typedef unsigned long long u64;
typedef unsigned u32x4v __attribute__((ext_vector_type(4)));
typedef unsigned u32x2v __attribute__((ext_vector_type(2)));

constexpr int DM = 1024, NB = 8, SEQ = 4096, DEPTH = 2;
constexpr int CHB = 4;
constexpr int NCH = NB / CHB;
constexpr int MC = CHB * SEQ;
constexpr int INW = 5400, INP = 5632;
constexpr int C_SSM = 512, C_Q = 1024, C_KV = 1536, C_GN = 2304, C_GM = 2328;
constexpr int NROW = CHB * 64;
constexpr float ALPHA = 1.4142135623730951f;
constexpr int LDS_BYTES = 131072;
constexpr int NTHR = 512;
constexpr int NWV = NTHR / 64;

constexpr size_t al256(size_t x) { return (x + 255) & ~(size_t)255; }
constexpr size_t O_WIN = 0;
constexpr size_t O_WPOOL = O_WIN + (size_t)INP * 1024 * 2;
constexpr size_t O_WGLU = O_WPOOL + 4 * 128 * 128 * 2;
constexpr size_t O_WUP = O_WGLU + 512 * 512 * 2;
constexpr size_t O_WOUT = O_WUP + 3 * 1024 * 512 * 2;
constexpr size_t O_WFF1 = O_WOUT + 1024 * 1024 * 2;
constexpr size_t O_WFF2 = O_WFF1 + 4096 * 1024 * 2;
constexpr size_t O_WCK1 = O_WFF2 + 4096 * 1024 * 2;
constexpr size_t O_WCV1 = O_WCK1 + 128 * 2048 * 2;
constexpr size_t O_WCK2 = O_WCV1 + 128 * 2048 * 2;
constexpr size_t O_WCV2 = O_WCK2 + 64 * 128 * 2;
constexpr size_t O_BCK1 = O_WCV2 + 64 * 128 * 2;
constexpr size_t O_BCV1 = O_BCK1 + 512;
constexpr size_t O_KMAT = O_BCV1 + 512;
constexpr size_t O_EMAT = O_KMAT + 32 * 64 * 256 * 2;
constexpr size_t O_FMAT = O_EMAT + (size_t)32 * 128 * 1024 * 2;
constexpr size_t O_A64 = O_FMAT + (size_t)32 * 1024 * 128 * 2;
constexpr size_t WL_SIZE = al256(O_A64 + 32 * 64 * 2 * 4);
constexpr size_t G_WL = 0;
constexpr size_t G_ROPE = G_WL + 2 * WL_SIZE;
constexpr size_t G_XB = al256(G_ROPE + 4096 * 16 * 4);
constexpr size_t G_PROJ = al256(G_XB + (size_t)MC * 1024 * 4);
constexpr size_t G_Y = al256(G_PROJ + (size_t)MC * INP * 2);
constexpr size_t G_ZS = al256(G_Y + (size_t)MC * 1536 * 2);
constexpr size_t G_ONSA = al256(G_ZS + (size_t)MC * 512 * 2);
constexpr size_t G_S = al256(G_ONSA + (size_t)MC * 512 * 4);
constexpr size_t G_HIN = al256(G_S + (size_t)32 * NROW * 128 * 4);
constexpr size_t G_KCMP = al256(G_HIN + (size_t)32 * NROW * 128 * 2);
constexpr size_t G_VCMPT = al256(G_KCMP + (size_t)CHB * 2 * 256 * 64 * 2);
constexpr size_t G_H1 = al256(G_VCMPT + (size_t)CHB * 2 * 256 * 64 * 2);
constexpr size_t G_SEL = al256(G_H1 + (size_t)2 * CHB * 512 * 128 * 2);
constexpr size_t G_BAR = al256(G_SEL + (size_t)MC * 2 * 8);
constexpr size_t G_USSM = al256(G_BAR + 3456 * 4);
constexpr size_t G_END = al256(G_USSM + (size_t)32 * MC * 16 * 2);
static_assert(G_END <= (size_t)536870912, "workspace budget");
static_assert((size_t)MC * 4096 * 2 <= (size_t)MC * INP * 2, "H aliases PROJ");

struct Params {
  const float* in[32];
  float* out;
  unsigned char* ws;
};

__device__ __forceinline__ unsigned char* launder_ws(unsigned char* lds) {
  const volatile __attribute__((address_space(3))) unsigned* q = (const volatile __attribute__((address_space(3))) unsigned*)(lds + LDS_BYTES + 16);
  const unsigned lo = (unsigned)__builtin_amdgcn_readfirstlane((int)q[0]), hi = (unsigned)__builtin_amdgcn_readfirstlane((int)q[1]);
  return (unsigned char*)(((unsigned long long)hi << 32) | (unsigned long long)lo);
}
__device__ __forceinline__ int otid() { int t = threadIdx.x; asm volatile("" : "+v"(t)); return t; }
__device__ __forceinline__ float bf2f(bf16_t h) { return __uint_as_float(((unsigned)h) << 16); }
__device__ __forceinline__ bf16_t f2bf(float f) {
  unsigned u = __float_as_uint(f);
  u += 0x7fffu + ((u >> 16) & 1u);
  return (bf16_t)(u >> 16);
}
__device__ __forceinline__ unsigned pack2(float a, float b) { unsigned r; asm volatile("v_cvt_pk_bf16_f32 %0, %1, %2" : "=v"(r) : "v"(a), "v"(b)); return r; }
__device__ __forceinline__ uint2 pack4(f32x4 v) { uint2 r; r.x = pack2(v[0], v[1]); r.y = pack2(v[2], v[3]); return r; }
__device__ __forceinline__ f32x4 unpack4(uint2 u) {
  f32x4 r; r[0] = __uint_as_float(u.x << 16); r[1] = __uint_as_float(u.x & 0xffff0000u);
  r[2] = __uint_as_float(u.y << 16); r[3] = __uint_as_float(u.y & 0xffff0000u); return r;
}
__device__ __forceinline__ f32x4 unpack4v(u32x2v u) { uint2 t; t.x = u.x; t.y = u.y; return unpack4(t); }
__device__ __forceinline__ u32x2v pack4v(f32x4 v) { const uint2 t = pack4(v); u32x2v r; r.x = t.x; r.y = t.y; return r; }
#define GASQ __attribute__((address_space(1)))
__device__ __forceinline__ uint4 gld16(const void* q) { const u32x4v v = *(const GASQ u32x4v*)q; return make_uint4(v.x, v.y, v.z, v.w); }
__device__ __forceinline__ uint2 gld8(const void* q) { const u32x2v v = *(const GASQ u32x2v*)q; uint2 r; r.x = v.x; r.y = v.y; return r; }
__device__ __forceinline__ bf16x8 gld16b(const void* q) { return *(const GASQ bf16x8*)q; }
__device__ __forceinline__ float4 gldf4(const void* q) { const f32x4 v = *(const GASQ f32x4*)q; return make_float4(v[0], v[1], v[2], v[3]); }
__device__ __forceinline__ void gst8(void* q, uint2 v) { u32x2v t; t.x = v.x; t.y = v.y; *(GASQ u32x2v*)q = t; }
__device__ __forceinline__ void gstf4(void* q, float4 v) { *(GASQ f32x4*)q = (f32x4){v.x, v.y, v.z, v.w}; }
__device__ __forceinline__ float sigmoidf_(float x) { return __builtin_amdgcn_rcpf(1.0f + __builtin_amdgcn_exp2f(-1.4426950408889634f * x)); }
__device__ __forceinline__ float gelu_tanh(float x) {
  float u = 0.7978845608028654f * (x + 0.044715f * x * x * x);
  return x * __builtin_amdgcn_rcpf(1.0f + __builtin_amdgcn_exp2f(-2.8853900817779268f * u));
}
__device__ __forceinline__ float shx(float v, int mask, int lane) { return __int_as_float(__builtin_amdgcn_ds_bpermute((lane ^ mask) << 2, __float_as_int(v))); }
__device__ __forceinline__ unsigned shxu(unsigned v, int mask, int lane) { return (unsigned)__builtin_amdgcn_ds_bpermute((lane ^ mask) << 2, (int)v); }
__device__ __forceinline__ float wave_sum(float v, int lane) {
#pragma unroll
  for (int o = 32; o >= 1; o >>= 1) v += shx(v, o, lane);
  return v;
}

namespace pg8 {
#define PG8_LAS __attribute__((address_space(3)))
typedef unsigned short bf16_t;
typedef short bf16x8 __attribute__((ext_vector_type(8)));
typedef float f32x4 __attribute__((ext_vector_type(4)));
typedef unsigned u32x4 __attribute__((ext_vector_type(4)));
constexpr int BM = 256, BK = 64, HALF = 128, HTB = HALF * BK * 2  , STAGE_BYTES = 8 * HTB, NXCD = 8, WGM = 8;

__host__ __device__ __forceinline__ int lds_byte(int r, int c) { const int st = (r >> 4) * 2 + (c >> 5), rr = r & 15, cc = c & 31, ob = rr * 64 + cc * 2; return st * 1024 + (ob ^ (((ob >> 9) & 1) << 5)); }
__host__ __device__ __forceinline__ void stage_rc(int b, int& R, int& C) { const int st = b / 1024, sb = b % 1024, swz = sb ^ (((sb >> 9) & 1) << 5); R = (st >> 1) * 16 + swz / 64; C = (st & 1) * 32 + (swz % 64) / 2; }
__host__ __device__ __forceinline__ int perm32(int rho) { const int n = rho >> 4, i = rho & 15; return 8 * (i >> 2) + 4 * n + (i & 3); }

struct Gemm { const bf16_t* A; const bf16_t* Bt; int M, N, K; };

struct Unit { int pm, pn; };
struct StaticOrder {
    int nM, nN, nwg, G, c;
    __host__ __device__ void init(int M, int N, int G_, int c_) { nM = M / BM; nN = N / BM; nwg = nM * nN; G = G_; c = c_; }
    __host__ __device__ bool next(int i, Unit& u) const {
        const long L = (long)i * G + c; if (L >= nwg) return false;
        int wgid = (int)L; { const int q = nwg / NXCD, r = nwg % NXCD, xcd = wgid % NXCD, off = wgid / NXCD; wgid = (xcd < r ? xcd * (q + 1) : r * (q + 1) + (xcd - r) * q) + off; }
        const int nig = WGM * nN, gid = wgid / nig, fm = gid * WGM, gsz = (nM - fm) < WGM ? (nM - fm) : WGM;
        u.pm = fm + ((wgid % nig) % gsz); u.pn = (wgid % nig) / gsz; return true;
    }
    __device__ __forceinline__ void a_ready(const Unit&) const {}
    __device__ __forceinline__ size_t a_off(const Unit&) const { return 0; }
    __device__ __forceinline__ void done(const Unit&) const {}
};

struct MergeOrder {
    StaticOrder base;
    __host__ __device__ void init(int G_, int c_) { base.init(MC, 1024, G_, c_); }
    __host__ __device__ bool next(int i, Unit& u) const { Unit b; if (!base.next(i / 3, b)) return false; u.pm = b.pm; u.pn = (i % 3) * 4 + b.pn; return true; }
    __device__ __forceinline__ void a_ready(const Unit&) const {}
    __device__ __forceinline__ void done(const Unit&) const {}
    __device__ __forceinline__ size_t a_off(const Unit& u) const { return (size_t)(u.pn >> 2) * ((size_t)MC * 512 * 2); }
};
struct EpiProj {
  static constexpr bool PERM = false, AFTER_DRAIN = false, MID = false;
  bf16_t* PROJ; const float* rope; int coff; bf16_t* USSM;
  __device__ __forceinline__ void operator()(const f32x4 (&acc)[2][2][4][2], const Unit& u, int wr, int wc, int fr, int fq) const {
#pragma unroll
    for (int bj = 0; bj < 2; ++bj) {
      const int cb = coff + u.pn * BM + bj * HALF + wc * 32;
      const int jg = (cb - C_Q) >> 6;
      const bool inqkv = (cb >= C_Q) && (cb < C_GN);
      const bool roped = inqkv && ((cb & 32) == 0) && (jg < 8 || (((jg - 8) & 2) == 0));
      const bool isq = (cb >= C_Q) && (cb < C_KV);
      const bool isgate = cb >= C_GN;
      const bool isssm = (cb >= C_SSM) && (cb < C_Q);
#pragma unroll
      for (int ai = 0; ai < 2; ++ai) {
        float4 csr[4], snr[4];
#pragma unroll
        for (int m = 0; m < 4; ++m) {
          if (roped) {
            const int pos = (u.pm * BM + ai * HALF + wr * 64 + m * 16 + fr) & (SEQ - 1);
            csr[m] = gldf4(rope + pos * 16 + (fq & 1) * 4); snr[m] = gldf4(rope + pos * 16 + 8 + (fq & 1) * 4);
          } else { csr[m] = make_float4(0.f, 0.f, 0.f, 0.f); snr[m] = make_float4(0.f, 0.f, 0.f, 0.f); }
        }
#pragma unroll
        for (int m = 0; m < 4; ++m) {
          const int row = u.pm * BM + ai * HALF + wr * 64 + m * 16 + fr;
#pragma unroll
          for (int n = 0; n < 2; ++n) {
            f32x4 v = acc[ai][bj][m][n];
            if (isgate) {
#pragma unroll
              for (int e = 0; e < 4; ++e) v[e] = sigmoidf_(v[e]);
            } else if (roped && n == 0) {
              const float csv[4] = {csr[m].x, csr[m].y, csr[m].z, csr[m].w}, snv[4] = {snr[m].x, snr[m].y, snr[m].z, snr[m].w};
#pragma unroll
              for (int e = 0; e < 4; ++e) {
                const float pv = shx(v[e], 32, fq * 16 + fr);
                v[e] = (fq < 2) ? (v[e] * csv[e] - pv * snv[e]) : (pv * snv[e] + v[e] * csv[e]);
              }
            }
            if (isq) {
#pragma unroll
              for (int e = 0; e < 4; ++e) v[e] *= 0.18033688011112042f;
            }
            if (isssm) gst8(USSM + ((size_t)(((cb - C_SSM) >> 4) + n) * MC + row) * 16 + 4 * fq, pack4(v));
            else gst8(PROJ + (size_t)row * INP + cb + n * 16 + 4 * fq, pack4(v));
          }
        }
        asm volatile("" ::: "memory");
      }
    }
  }
};
struct EpiRelu2 {
  static constexpr bool PERM = true, AFTER_DRAIN = false, MID = false;
  bf16_t* O; int ldc;
  __device__ __forceinline__ void operator()(const f32x4 (&acc)[2][2][4][2], const Unit& u, int wr, int wc, int fr, int fq) const {
    int row0 = u.pm * BM + wr * 64 + fr, col0 = u.pn * BM + wc * 32 + 8 * fq;
    asm volatile("" : "+v"(row0), "+v"(col0));
#pragma unroll
    for (int ai = 0; ai < 2; ++ai)
#pragma unroll
      for (int m = 0; m < 4; ++m) {
        bf16_t* rowp = O + (size_t)(row0 + ai * HALF + m * 16) * ldc + col0;
#pragma unroll
        for (int bj = 0; bj < 2; ++bj) {
          f32x4 v0 = acc[ai][bj][m][0], v1 = acc[ai][bj][m][1];
#pragma unroll
          for (int e = 0; e < 4; ++e) { const float a = fmaxf(v0[e], 0.f), b = fmaxf(v1[e], 0.f); v0[e] = a * a; v1[e] = b * b; }
          u32x4 w; w.x = pack2(v0[0], v0[1]); w.y = pack2(v0[2], v0[3]); w.z = pack2(v1[0], v1[1]); w.w = pack2(v1[2], v1[3]);
          *(u32x4*)(rowp + bj * HALF) = w;
        }
      }
  }
};
#define GAS __attribute__((address_space(1)))
struct EpiResid {
  static constexpr bool PERM = false, AFTER_DRAIN = false, MID = false;
  float* X; const bf16_t* XBr;
  __device__ __forceinline__ void operator()(const f32x4 (&acc)[2][2][4][2], const Unit& u, int wr, int wc, int fr, int fq) const {
    int row0 = u.pm * BM + wr * 64 + fr, col0 = u.pn * BM + wc * 32 + 4 * fq;
    asm volatile("" : "+v"(row0), "+v"(col0));
    const GAS bf16_t* xb = (const GAS bf16_t*)XBr; GAS float* xo = (GAS float*)X;
#pragma unroll
    for (int ai = 0; ai < 2; ++ai) {
      u32x2v xv[4][2][2];
#pragma unroll
      for (int m = 0; m < 4; ++m)
#pragma unroll
        for (int bj = 0; bj < 2; ++bj)
#pragma unroll
          for (int n = 0; n < 2; ++n) xv[m][bj][n] = *(const GAS u32x2v*)(xb + (size_t)(row0 + ai * HALF + m * 16) * 1024 + col0 + bj * HALF + n * 16);
#pragma unroll
      for (int m = 0; m < 4; ++m)
#pragma unroll
        for (int bj = 0; bj < 2; ++bj)
#pragma unroll
          for (int n = 0; n < 2; ++n)
            *(GAS f32x4*)(xo + (size_t)(row0 + ai * HALF + m * 16) * 1024 + col0 + bj * HALF + n * 16) = unpack4v(xv[m][bj][n]) * ALPHA + acc[ai][bj][m][n];
      asm volatile("" ::: "memory");
    }
  }
};
struct EpiMerge {
  static constexpr bool PERM = false, AFTER_DRAIN = false, MID = true;
  const bf16_t* PROJ; bf16_t* MG;
  __device__ __forceinline__ static f32x4 clampg(f32x4 g) { f32x4 r; for (int e = 0; e < 4; ++e) r[e] = fmaxf(g[e], 1e-30f); return r; }
  __device__ __forceinline__ void mid(f32x4 (&acc)[2][2][4][2], const Unit& u, int t, int wr, int wc, int fr, int fq) const {
    const int seg = (t == 8) ? 0 : 1;
    int row0 = u.pm * BM + wr * 64 + fr, col0 = u.pn * BM + wc * 32 + 4 * fq;
    asm volatile("" : "+v"(row0), "+v"(col0));
    const GAS bf16_t* pg = (const GAS bf16_t*)PROJ;
#pragma unroll
    for (int ai = 0; ai < 2; ++ai)
#pragma unroll
      for (int mh = 0; mh < 2; ++mh) {
        u32x2v ga[2][2][2], gb[2][2][2];
#pragma unroll
        for (int mm = 0; mm < 2; ++mm)
#pragma unroll
          for (int bj = 0; bj < 2; ++bj)
#pragma unroll
            for (int n = 0; n < 2; ++n) {
              const GAS bf16_t* gp = pg + (size_t)(row0 + ai * HALF + (mh * 2 + mm) * 16) * INP + C_GM + seg * 1024 + col0 + bj * HALF + n * 16;
              ga[mm][bj][n] = *(const GAS u32x2v*)gp; gb[mm][bj][n] = *(const GAS u32x2v*)(gp + 1024);
            }
#pragma unroll
        for (int mm = 0; mm < 2; ++mm)
#pragma unroll
          for (int bj = 0; bj < 2; ++bj)
#pragma unroll
            for (int n = 0; n < 2; ++n) {
              const f32x4 a = clampg(unpack4v(ga[mm][bj][n])), b = clampg(unpack4v(gb[mm][bj][n]));
              f32x4 r;
#pragma unroll
              for (int e = 0; e < 4; ++e) r[e] = a[e] * __builtin_amdgcn_rcpf(b[e]);
              acc[ai][bj][mh * 2 + mm][n] *= r;
            }
        asm volatile("" ::: "memory");
      }
  }
  __device__ __forceinline__ void operator()(const f32x4 (&acc)[2][2][4][2], const Unit& u, int wr, int wc, int fr, int fq) const {
    int row0 = u.pm * BM + wr * 64 + fr, col0 = u.pn * BM + wc * 32 + 4 * fq;
    asm volatile("" : "+v"(row0), "+v"(col0));
    const GAS bf16_t* pg = (const GAS bf16_t*)PROJ; GAS bf16_t* mg = (GAS bf16_t*)MG;
#pragma unroll
    for (int ai = 0; ai < 2; ++ai) {
      u32x2v gv[4][2][2];
#pragma unroll
      for (int m = 0; m < 4; ++m)
#pragma unroll
        for (int bj = 0; bj < 2; ++bj)
#pragma unroll
          for (int n = 0; n < 2; ++n) gv[m][bj][n] = *(const GAS u32x2v*)(pg + (size_t)(row0 + ai * HALF + m * 16) * INP + C_GM + 2 * 1024 + col0 + bj * HALF + n * 16);
#pragma unroll
      for (int m = 0; m < 4; ++m)
#pragma unroll
        for (int bj = 0; bj < 2; ++bj)
#pragma unroll
          for (int n = 0; n < 2; ++n)
            *(GAS u32x2v*)(mg + (size_t)(row0 + ai * HALF + m * 16) * 1024 + col0 + bj * HALF + n * 16) = pack4v(clampg(unpack4v(gv[m][bj][n])) * acc[ai][bj][m][n]);
      asm volatile("" ::: "memory");
    }
  }
};
template <class Epi, class Sched, bool STAMP = false>
__device__ __forceinline__ void gemm_phase(PG8_LAS unsigned char* lds, const Gemm g, const Sched& S, const Epi& E, unsigned long long* stamps) {
    const int tid = otid(), wid = __builtin_amdgcn_readfirstlane(tid >> 6), lane = tid & 63, wr = wid >> 2, wc = wid & 3, fr = lane & 15, fq = lane >> 4;
    const int K = g.K, nt = K / BK;
    int ts_lo = 0, ts_hi = 0, nts = 0; const unsigned long long rt_entry = STAMP ? (unsigned long long)wall_clock64() : 0ull;
#define PG8_STAMP() do { if (STAMP && wid == 0 && nts < 64) { const unsigned long long _c = (unsigned long long)clock64(); \
        ts_lo = (lane == nts) ? (int)(unsigned)_c : ts_lo; ts_hi = (lane == nts) ? (int)(unsigned)(_c >> 32) : ts_hi; ++nts; } } while (0)
    PG8_STAMP();
    unsigned voffA[2], voffB[2];
#pragma unroll
    for (int i = 0; i < 2; ++i) { int R, C; stage_rc(tid * 16 + i * 8192, R, C); const int Rb = Epi::PERM ? ((R & ~31) + perm32(R & 31)) : R;
        voffA[i] = (unsigned)(R * K + C) * 2u; voffB[i] = (unsigned)(Rb * K + C) * 2u; }
    const size_t kstep = (size_t)(BK * 2);
    const size_t hstep = (size_t)HALF * K * 2;
    const size_t tstep = 2 * hstep;
    const unsigned ldsw = (unsigned)wid * 1024u;
    const int aoff = lds_byte(wr * 64 + fr, fq * 8), boff = lds_byte(wc * 32 + fr, fq * 8);
#define PG8_SA(b, h) (((b) * 2 + (h)) * HTB)
#define PG8_SB(b, h) ((4 + (b) * 2 + (h)) * HTB)
#define PG8_STAGE(bufoff, gbase, voff) do { _Pragma("unroll") for (int _i = 0; _i < 2; ++_i) \
        __builtin_amdgcn_global_load_lds((const unsigned*)((const char*)(gbase) + (voff)[_i]), (PG8_LAS unsigned*)(lds + (bufoff) + ldsw + _i * 8192), 16, 0, 0); } while (0)
#define PG8_LDA(dst, b, h) do { _Pragma("unroll") for (int m = 0; m < 4; ++m) _Pragma("unroll") for (int k = 0; k < 2; ++k) dst[m][k] = *(const PG8_LAS bf16x8*)(lds + PG8_SA(b, h) + aoff + m * 2048 + k * 1024); } while (0)
#define PG8_LDB(dst, b, h) do { _Pragma("unroll") for (int n = 0; n < 2; ++n) _Pragma("unroll") for (int k = 0; k < 2; ++k) dst[n][k] = *(const PG8_LAS bf16x8*)(lds + PG8_SB(b, h) + boff + n * 2048 + k * 1024); } while (0)
#define PG8_MMA(ai, bj, At, Bt) do { __builtin_amdgcn_s_setprio(1); _Pragma("unroll") for (int m = 0; m < 4; ++m) _Pragma("unroll") for (int n = 0; n < 2; ++n) _Pragma("unroll") for (int k = 0; k < 2; ++k) \
        acc[ai][bj][m][n] = __builtin_amdgcn_mfma_f32_16x16x32_bf16(Bt[n][k], At[m][k], acc[ai][bj][m][n], 0, 0, 0); __builtin_amdgcn_s_setprio(0); } while (0)
#define PG8_WAIT_V(n) asm volatile("s_waitcnt vmcnt(" #n ")" ::: "memory")
#define PG8_WAIT_L(n) asm volatile("s_waitcnt lgkmcnt(" #n ")" ::: "memory")
#define PG8_BAR __builtin_amdgcn_s_barrier()
#define PG8_SCHED __builtin_amdgcn_sched_barrier(0)
    Unit cur, nxt; int ui = 0;
    if (!S.next(0, cur)) return;
    f32x4 acc[2][2][4][2];
#pragma unroll
    for (int a = 0; a < 2; ++a)
#pragma unroll
        for (int b = 0; b < 2; ++b)
#pragma unroll
            for (int m = 0; m < 4; ++m)
#pragma unroll
                for (int n = 0; n < 2; ++n) acc[a][b][m][n] = (f32x4){0.f, 0.f, 0.f, 0.f};
    bf16x8 At[4][2], B0[2][2], B1[2][2];
    const char* cA = (const char*)g.A + (size_t)cur.pm * tstep + S.a_off(cur); const char* cB = (const char*)g.Bt + (size_t)cur.pn * tstep;
    S.a_ready(cur);
    PG8_STAGE(PG8_SB(0, 0), cB, voffB); PG8_STAGE(PG8_SA(0, 0), cA, voffA); PG8_STAGE(PG8_SB(0, 1), cB + hstep, voffB); PG8_STAGE(PG8_SA(0, 1), cA + hstep, voffA);
    if (wr == 1) PG8_BAR;
    PG8_WAIT_V(4); PG8_BAR;
    PG8_STAGE(PG8_SB(1, 0), cB + kstep, voffB); PG8_STAGE(PG8_SA(1, 0), cA + kstep, voffA); PG8_STAGE(PG8_SB(1, 1), cB + hstep + kstep, voffB);
    PG8_WAIT_V(6); PG8_BAR;
    PG8_STAMP();
    for (;;) {
        const bool has_next = S.next(ui + 1, nxt);
        const char* nA = has_next ? (const char*)g.A + (size_t)nxt.pm * tstep + S.a_off(nxt) : cA; const char* nB = has_next ? (const char*)g.Bt + (size_t)nxt.pn * tstep : cB;
        for (int t = 0; t < nt; t += 2) {
            if constexpr (Epi::MID) { if (t == 8 || t == 16) E.mid(acc, cur, t, wr, wc, fr, fq); }
            const bool last = (t == nt - 2);
            const char* a1 = cA + (size_t)(t + 1) * kstep;
            const char* a2 = last ? nA : cA + (size_t)(t + 2) * kstep; const char* b2 = last ? nB : cB + (size_t)(t + 2) * kstep;
            const char* a3 = a2 + kstep; const char* b3 = b2 + kstep;
            if (last && has_next) S.a_ready(nxt);
            PG8_LDB(B0, 0, 0); PG8_SCHED; PG8_LDA(At, 0, 0); PG8_STAGE(PG8_SA(1, 1), a1 + hstep, voffA);
            PG8_WAIT_L(8); PG8_BAR; PG8_WAIT_L(0); PG8_MMA(0, 0, At, B0); PG8_BAR; PG8_SCHED;
            PG8_LDB(B1, 0, 1); PG8_STAGE(PG8_SB(0, 0), b2, voffB);
            PG8_BAR; PG8_WAIT_L(0); PG8_MMA(0, 1, At, B1); PG8_BAR;
            PG8_LDA(At, 0, 1); PG8_STAGE(PG8_SA(0, 0), a2, voffA);
            PG8_BAR; PG8_WAIT_L(0); PG8_MMA(1, 0, At, B0); PG8_BAR; PG8_SCHED;
            PG8_STAGE(PG8_SB(0, 1), b2 + hstep, voffB);
            PG8_WAIT_V(6); PG8_BAR; PG8_MMA(1, 1, At, B1); PG8_BAR;
            PG8_LDB(B0, 1, 0); PG8_SCHED; PG8_LDA(At, 1, 0); PG8_STAGE(PG8_SA(0, 1), a2 + hstep, voffA);
            PG8_WAIT_L(8); PG8_BAR; PG8_WAIT_L(0); PG8_MMA(0, 0, At, B0); PG8_BAR; PG8_SCHED;
            PG8_LDB(B1, 1, 1); PG8_STAGE(PG8_SB(1, 0), b3, voffB);
            PG8_BAR; PG8_WAIT_L(0); PG8_MMA(0, 1, At, B1); PG8_BAR;
            PG8_LDA(At, 1, 1); PG8_STAGE(PG8_SA(1, 0), a3, voffA);
            PG8_BAR; PG8_WAIT_L(0); PG8_MMA(1, 0, At, B0); PG8_BAR; PG8_SCHED;
            PG8_STAGE(PG8_SB(1, 1), b3 + hstep, voffB);
            PG8_WAIT_V(6); PG8_BAR; PG8_MMA(1, 1, At, B1); PG8_BAR;
        }
        PG8_STAMP();
        if constexpr (!Epi::AFTER_DRAIN) { E(acc, cur, wr, wc, fr, fq); S.done(cur); }
        PG8_STAMP();
        if (!has_next) break;
#pragma unroll
        for (int a = 0; a < 2; ++a)
#pragma unroll
            for (int b = 0; b < 2; ++b)
#pragma unroll
                for (int m = 0; m < 4; ++m)
#pragma unroll
                    for (int n = 0; n < 2; ++n) acc[a][b][m][n] = (f32x4){0.f, 0.f, 0.f, 0.f};
        cur = nxt; cA = nA; cB = nB; ++ui;
    }
    PG8_WAIT_V(0);
    if (wr == 0) PG8_BAR;
    PG8_BAR;
    if constexpr (Epi::AFTER_DRAIN) { E.fused(acc, cur, wr, wc, fr, fq, lds, wid, lane); S.done(cur); }
    PG8_STAMP();
    if (STAMP && wid == 0) { stamps[lane] = lane < nts ? (((unsigned long long)(unsigned)ts_hi << 32) | (unsigned)ts_lo) : 0ull;
        if (lane == 62) stamps[62] = rt_entry; if (lane == 63) stamps[63] = (unsigned long long)wall_clock64(); }
#undef PG8_STAMP
#undef PG8_SA
#undef PG8_SB
#undef PG8_STAGE
#undef PG8_LDA
#undef PG8_LDB
#undef PG8_MMA
#undef PG8_WAIT_V
#undef PG8_WAIT_L
#undef PG8_BAR
#undef PG8_SCHED
}
}

template <class LA, class LB>
__device__ __forceinline__ void gemm_acc(unsigned char* lds, int nk, const LA& la, const LB& lb, f32x4 (&acc)[4][2]) {
  const int tid = otid(), lane = tid & 63, wid = tid >> 6, wr = wid >> 2, wc = wid & 3, fr = lane & 15, fq = lane >> 4;
  bf16_t* sA = (bf16_t*)lds;
  bf16_t* sB = sA + 128 * 72;
  const int lrow = tid >> 3, lk = (tid & 7) * 8;
  uint4 ra[2][2], rb[2][2];
#pragma unroll
  for (int i = 0; i < 2; ++i) { ra[0][i] = la(lrow + i * 64, lk); rb[0][i] = lb(lrow + i * 64, lk); }
  if (nk > 1) {
#pragma unroll
    for (int i = 0; i < 2; ++i) { ra[1][i] = la(lrow + i * 64, 64 + lk); rb[1][i] = lb(lrow + i * 64, 64 + lk); }
  } else {
#pragma unroll
    for (int i = 0; i < 2; ++i) { ra[1][i] = make_uint4(0, 0, 0, 0); rb[1][i] = make_uint4(0, 0, 0, 0); }
  }
  for (int kt = 0; kt < nk; kt += 2) {
#pragma unroll
    for (int st = 0; st < 2; ++st) {
      if (kt + st < nk) {
        __syncthreads();
#pragma unroll
        for (int i = 0; i < 2; ++i) {
          *(uint4*)(sA + (lrow + i * 64) * 72 + lk) = ra[st][i];
          *(uint4*)(sB + (lrow + i * 64) * 72 + lk) = rb[st][i];
        }
        __syncthreads();
        if (kt + st + 2 < nk) {
#pragma unroll
          for (int i = 0; i < 2; ++i) { ra[st][i] = la(lrow + i * 64, (kt + st + 2) * 64 + lk); rb[st][i] = lb(lrow + i * 64, (kt + st + 2) * 64 + lk); }
        }
#pragma unroll
        for (int ks = 0; ks < 2; ++ks) {
          bf16x8 af[4], bfr[2];
#pragma unroll
          for (int mi = 0; mi < 4; ++mi) af[mi] = *(const bf16x8*)(sA + (wr * 64 + mi * 16 + fr) * 72 + ks * 32 + fq * 8);
#pragma unroll
          for (int ni = 0; ni < 2; ++ni) bfr[ni] = *(const bf16x8*)(sB + (wc * 32 + ni * 16 + fr) * 72 + ks * 32 + fq * 8);
#pragma unroll
          for (int mi = 0; mi < 4; ++mi)
#pragma unroll
            for (int ni = 0; ni < 2; ++ni) acc[mi][ni] = __builtin_amdgcn_mfma_f32_16x16x32_bf16(bfr[ni], af[mi], acc[mi][ni], 0, 0, 0);
        }
      }
    }
  }
}
__device__ __forceinline__ void zero_acc(f32x4 (&acc)[4][2]) {
#pragma unroll
  for (int i = 0; i < 4; ++i)
#pragma unroll
    for (int j = 0; j < 2; ++j) acc[i][j] = (f32x4){0.f, 0.f, 0.f, 0.f};
}
template <class LD>
__device__ __forceinline__ void gemm_pre(uint2 (&pre)[4][2], const LD& ld) {
  const int tid = otid(), lane = tid & 63, wid = tid >> 6, wr = wid >> 2, wc = wid & 3, fr = lane & 15, fq = lane >> 4;
#pragma unroll
  for (int mi = 0; mi < 4; ++mi)
#pragma unroll
    for (int ni = 0; ni < 2; ++ni) pre[mi][ni] = ld(wr * 64 + mi * 16 + fr, wc * 32 + ni * 16 + fq * 4);
}
template <class EP>
__device__ __forceinline__ void gemm_epi_pre(const f32x4 (&acc)[4][2], const uint2 (&pre)[4][2], const EP& ep) {
  const int tid = otid(), lane = tid & 63, wid = tid >> 6, wr = wid >> 2, wc = wid & 3, fr = lane & 15, fq = lane >> 4;
#pragma unroll
  for (int mi = 0; mi < 4; ++mi)
#pragma unroll
    for (int ni = 0; ni < 2; ++ni) ep(wr * 64 + mi * 16 + fr, wc * 32 + ni * 16 + fq * 4, acc[mi][ni], pre[mi][ni], ni);
}
template <class EP>
__device__ __forceinline__ void gemm_epi(const f32x4 (&acc)[4][2], const EP& ep) {
  const int tid = otid(), lane = tid & 63, wid = tid >> 6, wr = wid >> 2, wc = wid & 3, fr = lane & 15, fq = lane >> 4;
#pragma unroll
  for (int mi = 0; mi < 4; ++mi)
#pragma unroll
    for (int ni = 0; ni < 2; ++ni) ep(wr * 64 + mi * 16 + fr, wc * 32 + ni * 16 + fq * 4, acc[mi][ni], ni);
}

__device__ void transpose_job(unsigned char* lds, const float* src, bf16_t* dst, int K, int N, int Npad, int bid, int nblk, int ldd = 0) {
  if (ldd == 0) ldd = K;
  float* sm = (float*)lds;
  const int tid = otid();
  const int tk = K / 64, tn = Npad / 64, ntile = tk * tn;
  const int rr = tid >> 4, c4 = (tid & 15) * 4;
  const int wn = tid & 63, wk = (tid >> 6) * 8;
  float4 cur[2], nxt[2];
  auto ldtile = [&](int t, float4 (&v)[2]) {
    const int k0 = (t % tk) * 64, n0 = (t / tk) * 64;
#pragma unroll
    for (int i = 0; i < 2; ++i)
      v[i] = (n0 + c4 < N) ? gldf4(src + (size_t)(k0 + rr + 32 * i) * N + n0 + c4) : make_float4(0.f, 0.f, 0.f, 0.f);
  };
#pragma unroll
  for (int i = 0; i < 2; ++i) { cur[i] = make_float4(0.f, 0.f, 0.f, 0.f); nxt[i] = cur[i]; }
  if (bid < ntile) ldtile(bid, cur);
  for (int t = bid; t < ntile; t += nblk) {
    const int k0 = (t % tk) * 64, n0 = (t / tk) * 64;
    if (t + nblk < ntile) ldtile(t + nblk, nxt);
    __syncthreads();
#pragma unroll
    for (int i = 0; i < 2; ++i) *(float4*)(sm + (rr + 32 * i) * 68 + c4) = cur[i];
    __syncthreads();
    {
      float v[8];
#pragma unroll
      for (int e = 0; e < 8; ++e) v[e] = sm[(wk + e) * 68 + wn];
      uint4 o; o.x = pack2(v[0], v[1]); o.y = pack2(v[2], v[3]); o.z = pack2(v[4], v[5]); o.w = pack2(v[6], v[7]);
      u32x4v ov; ov.x = o.x; ov.y = o.y; ov.z = o.z; ov.w = o.w;
      *(GASQ u32x4v*)(dst + (size_t)(n0 + wn) * ldd + k0 + wk) = ov;
    }
#pragma unroll
    for (int i = 0; i < 2; ++i) cur[i] = nxt[i];
  }
}

__device__ __forceinline__ void sincos_f(float ang, float& s, float& c) {
  const float q = rintf(ang * 0.15915494309189535f);
  float r = fmaf(-q, 6.28125f, ang);
  r = fmaf(-q, 0.001934051513671875f, r);
  r = fmaf(-q, 1.255665914356996e-06f, r);
  s = __sinf(r); c = __cosf(r);
}

__device__ void phase0(const Params& p, unsigned char* lds, int bid, int nblk) {
  unsigned char* WS = launder_ws(lds);
  const int tid = otid();
  for (int layer = 0; layer < DEPTH; ++layer) {
    unsigned char* wl = WS + G_WL + layer * WL_SIZE;
    transpose_job(lds, p.in[3] + (size_t)layer * 1024 * INW, (bf16_t*)(wl + O_WIN), 1024, INW, INP, bid, nblk);
    for (int g = 0; g < 4; ++g)
      transpose_job(lds, p.in[4] + (size_t)(layer * 4 + g) * 128 * 128, (bf16_t*)(wl + O_WPOOL) + g * 128 * 128, 128, 128, 128, bid, nblk);
    transpose_job(lds, p.in[14] + (size_t)layer * 512 * 512, (bf16_t*)(wl + O_WGLU), 512, 512, 512, bid, nblk);
    for (int i = 0; i < 3; ++i)
      transpose_job(lds, p.in[22 + i] + (size_t)layer * 512 * 1024, (bf16_t*)(wl + O_WUP) + (size_t)i * 512, 512, 1024, 1024, bid, nblk, 1536);
    transpose_job(lds, p.in[25] + (size_t)layer * 1024 * 1024, (bf16_t*)(wl + O_WOUT), 1024, 1024, 1024, bid, nblk);
    transpose_job(lds, p.in[28] + (size_t)layer * 1024 * 4096, (bf16_t*)(wl + O_WFF1), 1024, 4096, 4096, bid, nblk);
    transpose_job(lds, p.in[29] + (size_t)layer * 4096 * 1024, (bf16_t*)(wl + O_WFF2), 4096, 1024, 1024, bid, nblk);
    transpose_job(lds, p.in[18] + (size_t)layer * 2048 * 128, (bf16_t*)(wl + O_WCK1), 2048, 128, 128, bid, nblk);
    transpose_job(lds, p.in[20] + (size_t)layer * 2048 * 128, (bf16_t*)(wl + O_WCV1), 2048, 128, 128, bid, nblk);
    transpose_job(lds, p.in[19] + (size_t)layer * 128 * 64, (bf16_t*)(wl + O_WCK2), 128, 64, 64, bid, nblk);
    transpose_job(lds, p.in[21] + (size_t)layer * 128 * 64, (bf16_t*)(wl + O_WCV2), 128, 64, 64, bid, nblk);
  }
  {
    float* rope = (float*)(WS + G_ROPE);
    for (int idx = bid * NTHR + tid; idx < 4096 * 8; idx += nblk * NTHR) {
      int pos = idx >> 3, i = idx & 7;
      const float inv = (i == 0) ? 1.0f : (i == 1) ? 0.19392274474868576f : (i == 2) ? 0.03760603093086393f : (i == 3) ? 0.007292664737217109f
                      : (i == 4) ? 0.001414213562373095f : (i == 5) ? 0.0002742481756762073f : (i == 6) ? 5.318295896944988e-05f : 1.031338537721246e-05f;
      float sn, cs; sincos_f((float)pos * inv, sn, cs);
      rope[pos * 16 + i] = cs; rope[pos * 16 + 8 + i] = sn;
    }
  }
  for (int it = bid; it < DEPTH * 2 * 8; it += nblk) {
    const int layer = it >> 4, kv = (it >> 3) & 1, j0 = (it & 7) * 16;
    const float* pe = p.in[16 + kv] + (size_t)layer * 2048;
    const float* w1 = p.in[kv ? 20 : 18] + (size_t)layer * 2048 * 128;
    float* sm = (float*)lds;
    const int jj = tid & 15, part = tid >> 4;
    float acc = 0.f;
#pragma unroll 8
    for (int i = 0; i < 64; ++i) { const int kk = part + i * 32; acc += pe[kk] * w1[(size_t)kk * 128 + j0 + jj]; }
    __syncthreads();
    sm[tid] = acc;
    __syncthreads();
    if (tid < 16) {
      float t = 0.f;
      for (int q = 0; q < 32; ++q) t += sm[q * 16 + tid];
      ((float*)(WS + G_WL + layer * WL_SIZE + (kv ? O_BCV1 : O_BCK1)))[j0 + tid] = t;
    }
    __syncthreads();
  }
  for (int it = bid; it < DEPTH * 32 * 9; it += nblk) {
    const int layer = it / (32 * 9), rem = it % (32 * 9), g = rem / 9, dg = rem % 9;
    unsigned char* wl = WS + G_WL + layer * WL_SIZE;
    float* pwr = (float*)lds; float* pwi = pwr + 64; float* kr = pwi + 64; float* ki = kr + 64; float* th1s = ki + 64; float* lrs = th1s + 64;
    float* bbr = lrs + 64; float* bbi = bbr + 1024; float* scre = bbi + 1024; float* scim = scre + 1024;
    const size_t gp = (size_t)(layer * 32 + g) * 64;
    __syncthreads();
    for (int idx = tid; idx < 1024; idx += NTHR) { scre[idx] = p.in[11][gp * 16 + idx]; scim[idx] = p.in[12][gp * 16 + idx]; }
    if (tid < 64) {
      const float lr = p.in[6][gp + tid], li = p.in[7][gp + tid];
      const float step = expf(p.in[8][layer * 32 + g]);
      const float th1 = li * step;
      float s1, c1; sincos_f(th1, s1, c1);
      const float mag = expf(lr * step);
      const float abr = mag * c1, abi = mag * s1;
      const float den = lr * lr + li * li;
      const float nr = abr - 1.0f, ni = abi;
      kr[tid] = (nr * lr + ni * li) / den;
      ki[tid] = (ni * lr - nr * li) / den;
      th1s[tid] = th1; lrs[tid] = lr * step;
    }
    __syncthreads();
    for (int idx = tid; idx < 1024; idx += NTHR) {
      int pp = idx >> 4;
      float br = p.in[9][gp * 16 + idx], bi = p.in[10][gp * 16 + idx];
      bbr[idx] = kr[pp] * br - ki[pp] * bi;
      bbi[idx] = kr[pp] * bi + ki[pp] * br;
    }
#pragma unroll 1
    for (int dd = 0; dd < 8; ++dd) {
      const int d = dg * 8 + dd;
      if (d > 64) break;
      __syncthreads();
      if (tid < 64) {
        float sd, cd; sincos_f(th1s[tid] * (float)d, sd, cd);
        const float md = expf(lrs[tid] * (float)d);
        pwr[tid] = md * cd; pwi[tid] = md * sd;
      }
      __syncthreads();
      if (d <= 63) {
        if (tid < 256) {
          const int co = tid >> 4, ci = tid & 15;
          float val = 0.f;
#pragma unroll 8
          for (int pp = 0; pp < 64; ++pp) {
            const float cr = scre[co * 64 + pp], cm = scim[co * 64 + pp];
            const float wr_ = cr * pwr[pp] - cm * pwi[pp], wi_ = cr * pwi[pp] + cm * pwr[pp];
            val += wr_ * bbr[pp * 16 + ci] - wi_ * bbi[pp * 16 + ci];
          }
          ((bf16_t*)(wl + O_KMAT))[(((size_t)g * 64 + d) * 16 + co) * 16 + ci] = f2bf(val);
        }
        const int sidx = 63 - d;
        bf16_t* em = (bf16_t*)(wl + O_EMAT);
        for (int idx = tid; idx < 1024; idx += NTHR) {
          const int pp = idx >> 4, ci = idx & 15;
          const float re = pwr[pp] * bbr[idx] - pwi[pp] * bbi[idx], im = pwr[pp] * bbi[idx] + pwi[pp] * bbr[idx];
          em[((size_t)g * 128 + pp) * 1024 + sidx * 16 + ci] = f2bf(re);
          em[((size_t)g * 128 + 64 + pp) * 1024 + sidx * 16 + ci] = f2bf(im);
        }
      }
      if (d >= 1) {
        const int t = d - 1;
        bf16_t* fm = (bf16_t*)(wl + O_FMAT);
        for (int idx = tid; idx < 1024; idx += NTHR) {
          const int co = idx >> 6, pp = idx & 63;
          const float cr = scre[idx], cm = scim[idx];
          const float wr_ = cr * pwr[pp] - cm * pwi[pp], wi_ = cr * pwi[pp] + cm * pwr[pp];
          fm[((size_t)g * 1024 + t * 16 + co) * 128 + pp] = f2bf(wr_);
          fm[((size_t)g * 1024 + t * 16 + co) * 128 + 64 + pp] = f2bf(-wi_);
        }
      }
      if (d == 64 && tid < 64) {
        float* a64 = (float*)(wl + O_A64);
        a64[(g * 64 + tid) * 2] = pwr[tid]; a64[(g * 64 + tid) * 2 + 1] = pwi[tid];
      }
    }
  }
}

__device__ void ln_rows(const float* src, float* dst, bf16_t* dstb, const float* gam, const float* bet, int nrows, int bid, int nblk) {
  const int tid = otid(), lane = tid & 63, wid = tid >> 6;
  const int stride = nblk * NWV;
  for (int row0 = bid * NWV + wid; row0 < nrows; row0 += 2 * stride) {
    float4 v[2][4];
    bool ok[2];
#pragma unroll
    for (int u = 0; u < 2; ++u) {
      const int row = row0 + u * stride;
      ok[u] = row < nrows;
      const float4* s4 = (const float4*)(src + (size_t)(ok[u] ? row : row0) * 1024);
#pragma unroll
      for (int i = 0; i < 4; ++i) v[u][i] = s4[i * 64 + lane];
    }
#pragma unroll
    for (int u = 0; u < 2; ++u) {
      const int row = row0 + u * stride;
      float sum = 0.f;
#pragma unroll
      for (int i = 0; i < 4; ++i) sum += (v[u][i].x + v[u][i].y) + (v[u][i].z + v[u][i].w);
      const float mean = wave_sum(sum, lane) * (1.0f / 1024.0f);
      float sq = 0.f;
#pragma unroll
      for (int i = 0; i < 4; ++i) {
        float a = v[u][i].x - mean, b = v[u][i].y - mean, c = v[u][i].z - mean, d = v[u][i].w - mean;
        sq += (a * a + b * b) + (c * c + d * d);
      }
      const float rstd = rsqrtf(wave_sum(sq, lane) * (1.0f / 1024.0f) + 1e-5f);
      if (ok[u]) {
#pragma unroll
        for (int i = 0; i < 4; ++i) {
          float4 gg = ((const float4*)gam)[i * 64 + lane], bb = ((const float4*)bet)[i * 64 + lane];
          float4 o;
          o.x = (v[u][i].x - mean) * rstd * gg.x + bb.x; o.y = (v[u][i].y - mean) * rstd * gg.y + bb.y;
          o.z = (v[u][i].z - mean) * rstd * gg.z + bb.z; o.w = (v[u][i].w - mean) * rstd * gg.w + bb.w;
          if (dst) ((float4*)(dst + (size_t)row * 1024))[i * 64 + lane] = o;
          if (dstb) {
            uint2 pk; pk.x = pack2(o.x, o.y); pk.y = pack2(o.z, o.w);
            ((uint2*)(dstb + (size_t)row * 1024))[i * 64 + lane] = pk;
          }
        }
      }
    }
  }
}

constexpr int PROJ_N0 = 5120;
__device__ void phase_proj(const Params& p, unsigned char* lds, int layer, int bid, int nblk) {
  unsigned char* WS = launder_ws(lds);
  pg8::Gemm g{(const bf16_t*)(WS + G_XB), (const bf16_t*)(WS + G_WL + layer * WL_SIZE + O_WIN), MC, PROJ_N0, 1024};
  pg8::StaticOrder S; S.init(MC, PROJ_N0, nblk, bid);
  pg8::EpiProj E{(bf16_t*)(WS + G_PROJ), (const float*)(WS + G_ROPE), 0, (bf16_t*)(WS + G_USSM)};
  pg8::gemm_phase<pg8::EpiProj, pg8::StaticOrder>((PG8_LAS unsigned char*)lds, g, S, E, nullptr);
}

__device__ void phase2(const Params& p, unsigned char* lds, int layer, int bid, int nblk) {
  unsigned char* WS = launder_ws(lds);
  unsigned char* wl = WS + G_WL + layer * WL_SIZE;
  const bf16_t* PROJ = (const bf16_t*)(WS + G_PROJ);
  constexpr int T_CMP = 32, T_S5 = 64, T_POOL = (MC / 128) * 4;
  const int hgrid = nblk >> 1;
  if (bid < hgrid) {
    pg8::Gemm g{(const bf16_t*)(WS + G_XB), (const bf16_t*)(wl + O_WIN) + (size_t)PROJ_N0 * 1024, MC, INP - PROJ_N0, 1024};
    pg8::StaticOrder S; S.init(MC, INP - PROJ_N0, hgrid, bid);
    pg8::EpiProj E{(bf16_t*)(WS + G_PROJ), (const float*)(WS + G_ROPE), PROJ_N0, (bf16_t*)(WS + G_USSM)};
    pg8::gemm_phase<pg8::EpiProj, pg8::StaticOrder>((PG8_LAS unsigned char*)lds, g, S, E, nullptr);
  }
  constexpr int T_HEAVY = T_CMP + T_S5, T_POOL0 = 256;
  const bool firsth = bid < hgrid;
  const int vstart = firsth ? bid : bid - hgrid, vstride = firsth ? hgrid : nblk - hgrid, vend = firsth ? T_POOL0 : T_HEAVY + T_POOL - T_POOL0;
  for (int v = vstart; v < vend; v += vstride) {
    const int t = firsth ? (T_HEAVY + v) : (v < T_HEAVY ? v : v + T_POOL0);
    f32x4 acc[4][2]; zero_acc(acc);
    if (t < T_CMP) {
      const int kv = t & 1, mt = t >> 1, m0 = mt * 128;
      const bf16_t* Bt = (const bf16_t*)(wl + (kv ? O_WCV1 : O_WCK1));
      const float* bias = (const float*)(wl + (kv ? O_BCV1 : O_BCK1));
      bf16_t* H1 = (bf16_t*)(WS + G_H1) + (size_t)kv * CHB * 512 * 128;
      const int col0 = C_KV + kv * 128;
      auto la = [=](int r, int kk) -> uint4 {
        const int row = m0 + r;
        int n = row & 255; if (n > 254) n = 254;
        const int k = (row >> 8) & 1, bl = row >> 9;
        return gld16(PROJ + ((size_t)bl * SEQ + 16 * n + (kk >> 6)) * INP + col0 + k * 64 + (kk & 63));
      };
      auto lb = [=](int n, int kk) -> uint4 { return gld16(Bt + (size_t)n * 2048 + kk); };
      gemm_acc(lds, 32, la, lb, acc);
      const int ecol = ((otid() >> 6) & 3) * 32 + ((otid() & 63) >> 4) * 4;
      const float4 bia0 = gldf4(bias + ecol), bia1 = gldf4(bias + ecol + 16);
      gemm_epi(acc, [=](int r, int c, f32x4 v, int ni) {
        const float4 b4 = ni ? bia1 : bia0;
        v[0] = gelu_tanh(v[0] + b4.x); v[1] = gelu_tanh(v[1] + b4.y); v[2] = gelu_tanh(v[2] + b4.z); v[3] = gelu_tanh(v[3] + b4.w);
        gst8(H1 + (size_t)(m0 + r) * 128 + c, pack4(v));
      });
    } else if (t < T_CMP + T_S5) {
      const int tt = t - T_CMP, g = tt >> 1, m0 = (tt & 1) * 128;
      const bf16_t* Bt = (const bf16_t*)(wl + O_EMAT) + (size_t)g * 128 * 1024;
      float* S = (float*)(WS + G_S);
      auto la = [=](int r, int kk) -> uint4 {
        return gld16((const bf16_t*)(WS + G_USSM) + ((size_t)g * MC + (size_t)(m0 + r) * 64) * 16 + kk);
      };
      auto lb = [=](int n, int kk) -> uint4 { return gld16(Bt + (size_t)n * 1024 + kk); };
      gemm_acc(lds, 16, la, lb, acc);
      gemm_epi(acc, [=](int r, int c, f32x4 v, int) {
        gstf4(S + ((size_t)g * NROW + m0 + r) * 128 + c, make_float4(v[0], v[1], v[2], v[3]));
      });
    } else {
      const int tt = t - T_CMP - T_S5, g = tt & 3, m0 = (tt >> 2) * 128;
      const bf16_t* Bt = (const bf16_t*)(wl + O_WPOOL) + g * 128 * 128;
      const float* pscale = p.in[5] + (size_t)layer * 512 + g * 128;
      bf16_t* Y = (bf16_t*)(WS + G_Y);
      auto lb = [=](int n, int kk) -> uint4 { return gld16(Bt + (size_t)n * 128 + kk); };
      auto pool_la = [=](auto wtag, int r, int kk) -> uint4 {
        constexpr int W = decltype(wtag)::value;
        const int row = m0 + r, tpos = row & (SEQ - 1);
        const int cnt = (tpos + 1 < W) ? (tpos + 1) : W;
        const bf16_t* base = PROJ + (size_t)row * INP + g * 128 + kk;
        uint4 u[W];
#pragma unroll
        for (int j = 0; j < W; ++j) u[j] = gld16(base - (size_t)((j < cnt) ? j : 0) * INP);
        float sum[8];
#pragma unroll
        for (int e = 0; e < 8; ++e) sum[e] = 0.f;
#pragma unroll
        for (int j = 0; j < W; ++j) {
          const float wj = (j < cnt) ? 1.0f : 0.0f;
          sum[0] += wj * __uint_as_float(u[j].x << 16); sum[1] += wj * __uint_as_float(u[j].x & 0xffff0000u);
          sum[2] += wj * __uint_as_float(u[j].y << 16); sum[3] += wj * __uint_as_float(u[j].y & 0xffff0000u);
          sum[4] += wj * __uint_as_float(u[j].z << 16); sum[5] += wj * __uint_as_float(u[j].z & 0xffff0000u);
          sum[6] += wj * __uint_as_float(u[j].w << 16); sum[7] += wj * __uint_as_float(u[j].w & 0xffff0000u);
        }
        const float ic = 1.0f / (float)cnt;
        uint4 o;
        o.x = pack2(sum[0] * ic - __uint_as_float(u[0].x << 16), sum[1] * ic - __uint_as_float(u[0].x & 0xffff0000u));
        o.y = pack2(sum[2] * ic - __uint_as_float(u[0].y << 16), sum[3] * ic - __uint_as_float(u[0].y & 0xffff0000u));
        o.z = pack2(sum[4] * ic - __uint_as_float(u[0].z << 16), sum[5] * ic - __uint_as_float(u[0].z & 0xffff0000u));
        o.w = pack2(sum[6] * ic - __uint_as_float(u[0].w << 16), sum[7] * ic - __uint_as_float(u[0].w & 0xffff0000u));
        return o;
      };
      if (g == 0) gemm_acc(lds, 2, [=](int r, int kk) -> uint4 { return pool_la(std::integral_constant<int, 2>{}, r, kk); }, lb, acc);
      else if (g == 1) gemm_acc(lds, 2, [=](int r, int kk) -> uint4 { return pool_la(std::integral_constant<int, 4>{}, r, kk); }, lb, acc);
      else if (g == 2) gemm_acc(lds, 2, [=](int r, int kk) -> uint4 { return pool_la(std::integral_constant<int, 8>{}, r, kk); }, lb, acc);
      else gemm_acc(lds, 2, [=](int r, int kk) -> uint4 { return pool_la(std::integral_constant<int, 16>{}, r, kk); }, lb, acc);
      const int ecol = ((otid() >> 6) & 3) * 32 + ((otid() & 63) >> 4) * 4;
      const float4 psc0 = gldf4(pscale + ecol), psc1 = gldf4(pscale + ecol + 16);
      gemm_epi(acc, [=](int r, int c, f32x4 v, int ni) {
        const float4 s4 = ni ? psc1 : psc0;
        v[0] *= s4.x; v[1] *= s4.y; v[2] *= s4.z; v[3] *= s4.w;
        gst8(Y + (size_t)(m0 + r) * 1536 + g * 128 + c, pack4(v));
      });
    }
  }
}

__device__ void phase3(const Params& p, unsigned char* lds, int layer, int bid, int nblk) {
  unsigned char* WS = launder_ws(lds);
  unsigned char* wl = WS + G_WL + layer * WL_SIZE;
  constexpr int T_CMP = 32, T_SCAN = 32 * CHB * 64 / NTHR;
  for (int t = bid; t < T_CMP + T_SCAN; t += nblk) {
    if (t < T_CMP) {
      const int kv = t & 1, m0 = (t >> 1) * 128;
      const bf16_t* A = (const bf16_t*)(WS + G_H1) + (size_t)kv * CHB * 512 * 128;
      const bf16_t* Bt = (const bf16_t*)(wl + (kv ? O_WCV2 : O_WCK2));
      bf16_t* KC = (bf16_t*)(WS + G_KCMP);
      bf16_t* VT = (bf16_t*)(WS + G_VCMPT);
      f32x4 acc[4][2]; zero_acc(acc);
      auto la = [=](int r, int kk) -> uint4 { return gld16(A + (size_t)(m0 + r) * 128 + kk); };
      auto lb = [=](int n, int kk) -> uint4 { return gld16(Bt + (size_t)(n & 63) * 128 + kk); };
      gemm_acc(lds, 2, la, lb, acc);
      gemm_epi(acc, [=](int r, int c, f32x4 v, int) {
        if (c < 64) {
          const int row = m0 + r;
          if (kv == 0) {
            gst8(KC + (size_t)row * 64 + c, pack4(v));
          } else {
            const int bk = row >> 8, n = row & 255;
#pragma unroll
            for (int e = 0; e < 4; ++e) VT[((size_t)bk * 64 + c + e) * 256 + n] = f2bf(v[e]);
          }
        }
      });
    } else {
      const int idx = (t - T_CMP) * NTHR + otid();
      const int pp = idx & 63, bl = (idx >> 6) % CHB, g = idx / (64 * CHB);
      const float* a64 = (const float*)(wl + O_A64);
      const float ar = a64[(g * 64 + pp) * 2], ai = a64[(g * 64 + pp) * 2 + 1];
      const float* S = (const float*)(WS + G_S) + ((size_t)g * NROW + bl * 64) * 128;
      bf16_t* HIN = (bf16_t*)(WS + G_HIN) + ((size_t)g * NROW + bl * 64) * 128;
      float hr = 0.f, hi = 0.f;
#pragma unroll 1
      for (int c0 = 0; c0 < 64; c0 += 16) {
        float sr[16], si[16];
#pragma unroll
        for (int c = 0; c < 16; ++c) { sr[c] = S[(c0 + c) * 128 + pp]; si[c] = S[(c0 + c) * 128 + 64 + pp]; }
#pragma unroll
        for (int c = 0; c < 16; ++c) {
          HIN[(c0 + c) * 128 + pp] = f2bf(hr); HIN[(c0 + c) * 128 + 64 + pp] = f2bf(hi);
          const float nr = ar * hr - ai * hi + sr[c], ni = ar * hi + ai * hr + si[c];
          hr = nr; hi = ni;
        }
      }
    }
  }
}

constexpr int CMP_LDS_OFF = 40960;
__device__ void cmp_attn_wave(const Params& p, unsigned char* lds, int it) {
  unsigned char* WS = launder_ws(lds);
  const int tid = otid(), lane = tid & 63, wid = __builtin_amdgcn_readfirstlane(tid >> 6), fr = lane & 15, fq = lane >> 4;
  const int pairidx = it >> 1;
  const int tg = (wid >> 2) ? 255 - pairidx : pairidx;
  const int bk = (it & 1) * 4 + (wid & 3), bl = bk >> 1, k = bk & 1;
  const bf16_t* PROJ = (const bf16_t*)(WS + G_PROJ);
  const bf16_t* KC = (const bf16_t*)(WS + G_KCMP) + (size_t)bk * 256 * 64;
  const bf16_t* VT = (const bf16_t*)(WS + G_VCMPT) + (size_t)bk * 64 * 256;
  float* ONSA = (float*)(WS + G_ONSA);
  u64* SEL = (u64*)(WS + G_SEL);
  float* sc = (float*)(lds + CMP_LDS_OFF) + wid * (16 * 65);
  const int t0 = tg * 16;
  const size_t tok = (size_t)bl * SEQ + t0 + fr;
  const int nvr = (tg == 0) ? 0 : ((fr == 15) ? tg : tg - 1);
  const int src = (lane + 48) & 63;
  float imp[16];
#pragma unroll
  for (int ni = 0; ni < 16; ++ni) imp[ni] = 0.f;
#pragma unroll 1
  for (int g = 0; g < 4; ++g) {
    int lnl = lane; asm volatile("" : "+v"(lnl));
    const int frl = lnl & 15, fql = lnl >> 4, srcl = (lnl + 48) & 63;
    const size_t tokl = (size_t)bl * SEQ + t0 + frl;
    const int h = k * 4 + g;
    int nrel = ((tg == 0) ? 0 : ((frl == 15) ? tg : tg - 1)) - fql * 4;
    asm volatile("" : "+v"(nrel));
    bf16x8 qf[2];
#pragma unroll
    for (int ks = 0; ks < 2; ++ks) qf[ks] = gld16b(PROJ + tokl * INP + C_Q + h * 64 + ks * 32 + fql * 8);
    f32x4 s[16];
#pragma unroll
    for (int ni = 0; ni < 16; ++ni) {
      s[ni] = (f32x4){0.f, 0.f, 0.f, 0.f};
      if (ni * 16 < tg) {
#pragma unroll
        for (int ks = 0; ks < 2; ++ks) {
          const bf16x8 kf = gld16b(KC + (size_t)(ni * 16 + frl) * 64 + ks * 32 + fql * 8);
          s[ni] = __builtin_amdgcn_mfma_f32_16x16x32_bf16(kf, qf[ks], s[ni], 0, 0, 0);
        }
      }
      if (ni & 1) asm volatile("" ::: "memory");
    }
    float rmax = -1e30f;
#pragma unroll
    for (int ni = 0; ni < 16; ++ni)
#pragma unroll
      for (int e = 0; e < 4; ++e) {
        if (ni * 16 + e < nrel) rmax = fmaxf(rmax, s[ni][e]);
      }
    rmax = fmaxf(rmax, shx(rmax, 16, lnl)); rmax = fmaxf(rmax, shx(rmax, 32, lnl));
    float rsum = 0.f;
#pragma unroll
    for (int ni = 0; ni < 16; ++ni)
#pragma unroll
      for (int e = 0; e < 4; ++e) {
        const float pv = (ni * 16 + e < nrel) ? __builtin_amdgcn_exp2f(s[ni][e] - rmax) : 0.f;
        s[ni][e] = pv; rsum += pv;
      }
    rsum += shx(rsum, 16, lnl); rsum += shx(rsum, 32, lnl);
    const float inv = (rsum > 0.f) ? 1.0f / rsum : 0.f;
#pragma unroll
    for (int ni = 0; ni < 16; ++ni) {
#pragma unroll
      for (int e = 0; e < 4; ++e) s[ni][e] *= inv;
      const float a = __int_as_float(__builtin_amdgcn_ds_bpermute(srcl << 2, __float_as_int(s[ni][3])));
      const float b = (ni > 0) ? __int_as_float(__builtin_amdgcn_ds_bpermute(srcl << 2, __float_as_int(s[ni > 0 ? ni - 1 : 0][3]))) : 0.f;
      const float prev = (fql > 0) ? a : b;
      imp[ni] += 2.0f * (s[ni][0] + s[ni][1] + s[ni][2]) + s[ni][3] + prev;
      if ((ni & 3) == 3) asm volatile("" ::: "memory");
    }
    f32x4 o[4];
#pragma unroll
    for (int nd = 0; nd < 4; ++nd) o[nd] = (f32x4){0.f, 0.f, 0.f, 0.f};
#pragma unroll
    for (int kh = 0; kh < 2; ++kh) {
      if (kh * 128 < tg) {
#pragma unroll
        for (int kq = 0; kq < 4; ++kq) {
          const int k8 = kh * 4 + kq;
          const uint2 pa = pack4(s[2 * k8]), pb = pack4(s[2 * k8 + 1]);
          const bf16x8 pf = __builtin_bit_cast(bf16x8, (u32x4v){pa.x, pa.y, pb.x, pb.y});
#pragma unroll
          for (int nd = 0; nd < 4; ++nd) {
            const uint2 va = gld8(VT + (size_t)(nd * 16 + frl) * 256 + k8 * 32 + fql * 4);
            const uint2 vb = gld8(VT + (size_t)(nd * 16 + frl) * 256 + k8 * 32 + 16 + fql * 4);
            o[nd] = __builtin_amdgcn_mfma_f32_16x16x32_bf16(__builtin_bit_cast(bf16x8, (u32x4v){va.x, va.y, vb.x, vb.y}), pf, o[nd], 0, 0, 0);
          }
          if (kq & 1) asm volatile("" ::: "memory");
        }
      }
    }
    const float gt = bf2f(PROJ[tokl * INP + C_GN + h * 3 + 0]);
#pragma unroll
    for (int nd = 0; nd < 4; ++nd)
      gstf4(ONSA + tokl * 512 + h * 64 + nd * 16 + fql * 4, make_float4(gt * o[nd][0], gt * o[nd][1], gt * o[nd][2], gt * o[nd][3]));
  }
#pragma unroll
  for (int ni = 0; ni < 16; ++ni) sc[fr * 65 + ni * 4 + fq] = imp[ni];
  asm volatile("s_waitcnt lgkmcnt(0)" ::: "memory");
#pragma unroll 1
  for (int r = 0; r < 16; ++r) {
    const int t = t0 + r, cur = t >> 6, sb = lane;
    const float impv = sc[r * 65 + sb];
    const bool forced = (sb == 0) || (sb == cur) || (sb == cur - 1);
    const float score = forced ? 1e6f : ((sb <= cur) ? impv : -1e6f);
    const unsigned bits = __float_as_uint(score);
    const unsigned u = (bits & 0x80000000u) ? ~bits : (bits | 0x80000000u);
    unsigned T = 0u;
#pragma unroll
    for (int bit = 31; bit >= 0; --bit) {
      const unsigned cand = T | (1u << bit);
      if (__popcll(__ballot(u >= cand)) >= 16) T = cand;
    }
    u64 m = __ballot(u > T);
    u64 eq = __ballot(u == T);
    int need = 16 - __popcll(m);
    while (need > 0 && eq) { const u64 low = eq & (~eq + 1ull); m |= low; eq ^= low; --need; }
    if (lane == 0) SEL[((size_t)bl * SEQ + t) * 2 + k] = m;
  }
  asm volatile("s_waitcnt lgkmcnt(0)" ::: "memory");
}

__device__ void phase4(const Params& p, unsigned char* lds, int layer, int bid, int nblk, int mode) {
  unsigned char* WS = launder_ws(lds);
  unsigned char* wl = WS + G_WL + layer * WL_SIZE;
  const bf16_t* PROJ = (const bf16_t*)(WS + G_PROJ);
  constexpr int T_S5 = 32 * 2 * 8, T_CMP = CHB * 2 * 256 / NWV;
  for (int t = bid; t < T_S5 + T_CMP; t += nblk) {
    if (mode == 1 && t >= T_S5) break;
    if (mode == 2 && t < T_S5) continue;
    if (t < T_S5) {
      const int nt = (t < T_S5 / 2) ? (7 - (t & 7)) : (t & 7), mt = (t >> 3) & 1, g = t >> 4;
      const int m0 = mt * 128, n0 = nt * 128, nk1 = 2 * nt + 2;
      const bf16_t* HIN = (const bf16_t*)(WS + G_HIN) + (size_t)g * NROW * 128;
      const bf16_t* USSM = (const bf16_t*)(WS + G_USSM);
      const bf16_t* KM = (const bf16_t*)(wl + O_KMAT) + (size_t)g * 64 * 256;
      const bf16_t* FM = (const bf16_t*)(wl + O_FMAT) + (size_t)g * 1024 * 128;
      const float* dsk = p.in[13] + (size_t)(layer * 32 + g) * 16;
      bf16_t* ZS = (bf16_t*)(WS + G_ZS);
      f32x4 acc[4][2]; zero_acc(acc);
      auto la = [=](int r, int kk) -> uint4 {
        const bool carry = kk >= nk1 * 64;
        const int k2 = carry ? (kk - nk1 * 64) : kk;
        const bf16_t* pu = USSM + ((size_t)g * MC + (size_t)(m0 + r) * 64) * 16 + k2;
        const bf16_t* ph_ = HIN + (size_t)(m0 + r) * 128 + (k2 & 127);
        return gld16(carry ? ph_ : pu);
      };
      auto lb = [=](int n, int kk) -> uint4 {
        const bool carry = kk >= nk1 * 64;
        const int k2 = carry ? (kk - nk1 * 64) : kk;
        const int nn = n0 + n, tt = nn >> 4, co = nn & 15;
        const int dd = tt - (k2 >> 4);
        const bf16_t* pk = KM + ((size_t)(dd < 0 ? 0 : dd) * 16 + co) * 16 + (k2 & 15);
        const bf16_t* pf = FM + (size_t)nn * 128 + (k2 & 127);
        uint4 v = gld16(carry ? pf : pk);
        if (!carry && dd < 0) v = make_uint4(0, 0, 0, 0);
        return v;
      };
      gemm_acc(lds, nk1 + 2, la, lb, acc);
      uint2 upre[4][2];
      gemm_pre(upre, [=](int r, int c) -> uint2 {
        const int nn = n0 + c, tt = nn >> 4, co = nn & 15;
        return gld8(USSM + ((size_t)g * MC + (size_t)(m0 + r) * 64 + tt) * 16 + co);
      });
      const float4 d4 = gldf4(dsk + ((otid() & 63) >> 4) * 4);
      gemm_epi_pre(acc, upre, [=](int r, int c, f32x4 v, uint2 pre, int) {
        const int nn = n0 + c, tt = nn >> 4, co = nn & 15;
        const size_t tok = (size_t)(m0 + r) * 64 + tt;
        const f32x4 u = unpack4(pre);
        v[0] = gelu_tanh(v[0] + d4.x * u[0]); v[1] = gelu_tanh(v[1] + d4.y * u[1]);
        v[2] = gelu_tanh(v[2] + d4.z * u[2]); v[3] = gelu_tanh(v[3] + d4.w * u[3]);
        gst8(ZS + tok * 512 + g * 16 + co, pack4(v));
      });
    } else {
      cmp_attn_wave(p, lds, t - T_S5);
    }
  }
}

constexpr int AMI = 2;
__device__ void attn_item(const Params& p, unsigned char* lds, int item) {
  unsigned char* WS = launder_ws(lds);
  const int tid = otid(), lane = tid & 63, wid = __builtin_amdgcn_readfirstlane(tid >> 6), g = wid & 3, th = wid >> 2, fr = lane & 15, fq = lane >> 4;
  const int qb = (item < 256) ? (63 - (item >> 3)) : ((item - 256) >> 3), k = item & 1, bl = (item >> 1) & 3;
  const bf16_t* PROJ = (const bf16_t*)(WS + G_PROJ);
  float* ONSA = (float*)(WS + G_ONSA);
  bf16_t* YN = (bf16_t*)(WS + G_Y) + 1024;
  const u64* SEL = (const u64*)(WS + G_SEL);
  bf16_t* sK = (bf16_t*)lds;
  bf16_t* sVt = sK + 64 * 72;
  const int h = k * 4 + g, t0 = qb * 64 + th * (AMI * 16);
  const int jq = qb;
  const size_t tokb = (size_t)bl * SEQ;
  bf16x8 qf[AMI][2];
#pragma unroll
  for (int mi = 0; mi < AMI; ++mi)
#pragma unroll
    for (int ks = 0; ks < 2; ++ks) qf[mi][ks] = gld16b(PROJ + (tokb + t0 + mi * 16 + fr) * INP + C_Q + h * 64 + ks * 32 + fq * 8);
  u64 mrow[AMI];
#pragma unroll
  for (int mi = 0; mi < AMI; ++mi) mrow[mi] = SEL[(tokb + t0 + mi * 16 + fr) * 2 + k];
  u64 um;
  {
    const u64 mm = SEL[(tokb + qb * 64 + lane) * 2 + k];
    unsigned lo = (unsigned)mm, hi = (unsigned)(mm >> 32);
#pragma unroll
    for (int o = 32; o >= 1; o >>= 1) { lo |= shxu(lo, o, lane); hi |= shxu(hi, o, lane); }
    lo = __builtin_amdgcn_readfirstlane(lo); hi = __builtin_amdgcn_readfirstlane(hi);
    um = ((u64)hi << 32) | lo;
  }
  const u64 causal = (jq == 63) ? ~0ull : ((1ull << (jq + 1)) - 1ull);
  um &= causal;
#pragma unroll 1
  for (int pass = 0; pass < 2; ++pass) {
    const int kcol = C_KV + (pass == 0 ? 512 : 256) + k * 64, vcol = kcol + 128;
    u64 blk;
    if (pass == 0) {
      const int lo = (qb >= 8) ? (qb - 8) : 0;
      blk = causal & ~((1ull << lo) - 1ull);
    } else blk = um;
    f32x4 o[AMI][4];
#pragma unroll
    for (int i = 0; i < AMI; ++i)
#pragma unroll
      for (int j = 0; j < 4; ++j) o[i][j] = (f32x4){0.f, 0.f, 0.f, 0.f};
    float mst[AMI], lst[AMI];
#pragma unroll
    for (int i = 0; i < AMI; ++i) { mst[i] = 0.f; lst[i] = 0.f; }
    bool first = true;
    const int lo_blk = (pass == 0 && qb >= 8) ? (qb - 8) : -1;
    const int krow = tid >> 3, kc8 = (tid & 7) * 8;
    auto pop = [&]() -> int { const int j_ = 63 - __builtin_clzll(blk); blk &= ~(1ull << j_); return j_; };
    auto stage = [&](int b_, const uint4& kreg, const uint4& vreg) {
      bf16_t* dK = sK + b_ * (2 * 64 * 72);
      bf16_t* dV = dK + 64 * 72;
      *(uint4*)(dK + krow * 72 + kc8) = kreg;
      const unsigned w[4] = {vreg.x, vreg.y, vreg.z, vreg.w};
#pragma unroll
      for (int e = 0; e < 4; ++e) {
        dV[(wid * 8 + 2 * e) * 72 + lane] = (bf16_t)(w[e] & 0xffffu);
        dV[(wid * 8 + 2 * e + 1) * 72 + lane] = (bf16_t)(w[e] >> 16);
      }
    };
    int jc = pop(), jn = -1, bsel = 0;
    uint4 kreg = gld16(PROJ + (tokb + jc * 64 + krow) * INP + kcol + kc8);
    uint4 vreg = gld16(PROJ + (tokb + jc * 64 + lane) * INP + vcol + wid * 8);
    __syncthreads();
    stage(0, kreg, vreg);
    if (blk) {
      jn = pop();
      kreg = gld16(PROJ + (tokb + jn * 64 + krow) * INP + kcol + kc8);
      vreg = gld16(PROJ + (tokb + jn * 64 + lane) * INP + vcol + wid * 8);
    }
    __syncthreads();
    for (;;) {
      const int j = jc;
      const bf16_t* cK = sK + bsel * (2 * 64 * 72);
      const bf16_t* cVt = cK + 64 * 72;
      int jnn = -1;
      if (jn >= 0) {
        stage(bsel ^ 1, kreg, vreg);
        if (blk) {
          jnn = pop();
          kreg = gld16(PROJ + (tokb + jnn * 64 + krow) * INP + kcol + kc8);
          vreg = gld16(PROJ + (tokb + jnn * 64 + lane) * INP + vcol + wid * 8);
        }
      }
      const bool maskblk = (j == jq) || (j == lo_blk);
      f32x4 sall[AMI][4];
      uint2 pp[AMI][4];
#pragma unroll
      for (int mi = 0; mi < AMI; ++mi) {
        const bool rowsel = (pass == 0) || ((mrow[mi] >> j) & 1ull);
        const float cinit = rowsel ? -mst[mi] : -1e30f;
#pragma unroll
        for (int ni = 0; ni < 4; ++ni) sall[mi][ni] = (f32x4){cinit, cinit, cinit, cinit};
      }
#pragma unroll
      for (int ks = 0; ks < 2; ++ks)
#pragma unroll
        for (int ni = 0; ni < 4; ++ni) {
          const bf16x8 kf = *(const bf16x8*)(cK + (ni * 16 + fr) * 72 + ks * 32 + fq * 8);
#pragma unroll
          for (int mi = 0; mi < AMI; ++mi) sall[mi][ni] = __builtin_amdgcn_mfma_f32_16x16x32_bf16(kf, qf[mi][ks], sall[mi][ni], 0, 0, 0);
        }
#pragma unroll
      for (int mi = 0; mi < AMI; ++mi) {
        f32x4 (&s)[4] = sall[mi];
        if (maskblk) {
          const int hi = t0 + mi * 16 + fr - j * 64, lo = hi - 512;
#pragma unroll
          for (int ni = 0; ni < 4; ++ni)
#pragma unroll
            for (int e = 0; e < 4; ++e) {
              const int key = ni * 16 + fq * 4 + e;
              s[ni][e] = (key <= hi && key > lo) ? s[ni][e] : -1e30f;
            }
        }
        float lm = s[0][0];
#pragma unroll
        for (int ni = 0; ni < 4; ++ni)
#pragma unroll
          for (int e = 0; e < 4; ++e) lm = fmaxf(lm, s[ni][e]);
        if (__any(first || lm > 64.0f)) {
          float r = fmaxf(lm, shx(lm, 16, lane)); r = fmaxf(r, shx(r, 32, lane));
          float delta = first ? r : fmaxf(r, 0.f);
          if (delta < -1e29f) delta = 0.f;
          const float alpha = __builtin_amdgcn_exp2f(-delta);
          mst[mi] += delta; lst[mi] *= alpha;
#pragma unroll
          for (int nd = 0; nd < 4; ++nd)
#pragma unroll
            for (int e = 0; e < 4; ++e) o[mi][nd][e] *= alpha;
#pragma unroll
          for (int ni = 0; ni < 4; ++ni)
#pragma unroll
            for (int e = 0; e < 4; ++e) s[ni][e] -= delta;
        }
        float rsum = 0.f;
#pragma unroll
        for (int ni = 0; ni < 4; ++ni) {
#pragma unroll
          for (int e = 0; e < 4; ++e) { const float pv = __builtin_amdgcn_exp2f(s[ni][e]); s[ni][e] = pv; rsum += pv; }
          pp[mi][ni] = pack4(s[ni]);
        }
        lst[mi] += rsum;
      }
      first = false;
#pragma unroll
      for (int ks = 0; ks < 2; ++ks) {
        bf16x8 vf[4], pf[AMI];
#pragma unroll
        for (int nd = 0; nd < 4; ++nd) {
          const uint2 va = *(const uint2*)(cVt + (nd * 16 + fr) * 72 + ks * 32 + fq * 4);
          const uint2 vb = *(const uint2*)(cVt + (nd * 16 + fr) * 72 + ks * 32 + 16 + fq * 4);
          vf[nd] = __builtin_bit_cast(bf16x8, (u32x4v){va.x, va.y, vb.x, vb.y});
        }
#pragma unroll
        for (int mi = 0; mi < AMI; ++mi) pf[mi] = __builtin_bit_cast(bf16x8, (u32x4v){pp[mi][2 * ks].x, pp[mi][2 * ks].y, pp[mi][2 * ks + 1].x, pp[mi][2 * ks + 1].y});
#pragma unroll
        for (int mi = 0; mi < AMI; ++mi)
#pragma unroll
          for (int nd = 0; nd < 4; ++nd) o[mi][nd] = __builtin_amdgcn_mfma_f32_16x16x32_bf16(vf[nd], pf[mi], o[mi][nd], 0, 0, 0);
      }
      if (jn < 0) break;
      __syncthreads();
      jc = jn; jn = jnn; bsel ^= 1;
    }
#pragma unroll
    for (int mi = 0; mi < AMI; ++mi) {
      const size_t tok = tokb + t0 + mi * 16 + fr;
      float lsum = lst[mi]; lsum += shx(lsum, 16, lane); lsum += shx(lsum, 32, lane);
      const float gt = bf2f(PROJ[tok * INP + C_GN + h * 3 + (pass == 0 ? 2 : 1)]) / lsum;
      float4 prevs[4];
#pragma unroll
      for (int nd = 0; nd < 4; ++nd) prevs[nd] = gldf4(ONSA + tok * 512 + h * 64 + nd * 16 + fq * 4);
#pragma unroll
      for (int nd = 0; nd < 4; ++nd) {
        const float4 prev = prevs[nd];
        f32x4 r;
        r[0] = prev.x + gt * o[mi][nd][0]; r[1] = prev.y + gt * o[mi][nd][1];
        r[2] = prev.z + gt * o[mi][nd][2]; r[3] = prev.w + gt * o[mi][nd][3];
        if (pass == 0) gstf4(ONSA + tok * 512 + h * 64 + nd * 16 + fq * 4, make_float4(r[0], r[1], r[2], r[3]));
        else gst8(YN + tok * 1536 + h * 64 + nd * 16 + fq * 4, pack4(r));
      }
    }
  }
}

__device__ void phase5(const Params& p, unsigned char* lds, int layer, int bid, int nblk) {
  unsigned char* WS = launder_ws(lds);
  unsigned char* wl = WS + G_WL + layer * WL_SIZE;
  constexpr int T_ATT = CHB * 2 * 64, T_GLU = (MC / 128) * 4;
  for (int t = bid; t < T_ATT + T_GLU; t += nblk) {
    if (t < T_ATT) {
      attn_item(p, lds, t);
    } else {
      const int tt = t - T_ATT, nt = tt & 3, m0 = (tt >> 2) * 128, n0 = nt * 128;
      const bf16_t* ZS = (const bf16_t*)(WS + G_ZS);
      const bf16_t* Bt = (const bf16_t*)(wl + O_WGLU);
      const float* bg = p.in[15] + (size_t)layer * 512;
      bf16_t* Y = (bf16_t*)(WS + G_Y);
      f32x4 acc[4][2]; zero_acc(acc);
      auto la = [=](int r, int kk) -> uint4 { return gld16(ZS + (size_t)(m0 + r) * 512 + kk); };
      auto lb = [=](int n, int kk) -> uint4 { return gld16(Bt + (size_t)(n0 + n) * 512 + kk); };
      gemm_acc(lds, 8, la, lb, acc);
      uint2 zpre[4][2];
      gemm_pre(zpre, [=](int r, int c) -> uint2 { return gld8(ZS + (size_t)(m0 + r) * 512 + n0 + c); });
      const int ecol = ((otid() >> 6) & 3) * 32 + ((otid() & 63) >> 4) * 4;
      const float4 bgl0 = gldf4(bg + n0 + ecol), bgl1 = gldf4(bg + n0 + ecol + 16);
      gemm_epi_pre(acc, zpre, [=](int r, int c, f32x4 v, uint2 pre, int ni) {
        const float4 b4 = ni ? bgl1 : bgl0;
        const f32x4 z = unpack4(pre);
        v[0] = z[0] * sigmoidf_(v[0] + b4.x); v[1] = z[1] * sigmoidf_(v[1] + b4.y);
        v[2] = z[2] * sigmoidf_(v[2] + b4.z); v[3] = z[3] * sigmoidf_(v[3] + b4.w);
        gst8(Y + (size_t)(m0 + r) * 1536 + 512 + n0 + c, pack4(v));
      });
    }
  }
}

__device__ void phase_merge(const Params& p, unsigned char* lds, int layer, int bid, int nblk) {
  unsigned char* WS = launder_ws(lds);
  unsigned char* wl = WS + G_WL + layer * WL_SIZE;
  pg8::Gemm g{(const bf16_t*)(WS + G_Y), (const bf16_t*)(wl + O_WUP), MC, 1024, 1536};
  pg8::StaticOrder S; S.init(MC, 1024, nblk, bid);
  pg8::EpiMerge E{(const bf16_t*)(WS + G_PROJ), (bf16_t*)(WS + G_ONSA)};
  pg8::gemm_phase<pg8::EpiMerge, pg8::StaticOrder>((PG8_LAS unsigned char*)lds, g, S, E, nullptr);
}
template <int K>
__device__ void phase_resid(const Params& p, unsigned char* lds, const bf16_t* A, const bf16_t* Bt, float* X, int bid, int nblk) {
  unsigned char* WS = launder_ws(lds);
  pg8::Gemm g{A, Bt, MC, 1024, K};
  pg8::StaticOrder S; S.init(MC, 1024, nblk, bid);
  pg8::EpiResid E{X, (const bf16_t*)(WS + G_XB)};
  pg8::gemm_phase<pg8::EpiResid, pg8::StaticOrder>((PG8_LAS unsigned char*)lds, g, S, E, nullptr);
}
__device__ void phase_ff1(const Params& p, unsigned char* lds, int layer, int bid, int nblk) {
  unsigned char* WS = launder_ws(lds);
  pg8::Gemm g{(const bf16_t*)(WS + G_XB), (const bf16_t*)(WS + G_WL + layer * WL_SIZE + O_WFF1), MC, 4096, 1024};
  pg8::StaticOrder S; S.init(MC, 4096, nblk, bid);
  pg8::EpiRelu2 E{(bf16_t*)(WS + G_PROJ), 4096};
  pg8::gemm_phase<pg8::EpiRelu2, pg8::StaticOrder>((PG8_LAS unsigned char*)lds, g, S, E, nullptr);
}

#define XB_TMO      128
#define XB_XCNT(j)  (256  + 64 * (j))
#define XB_XSUB(j)  (1280 + 64 * (j))
#define XB_XGEN(j)  (2304 + 64 * (j))
#define XB_TOP      3328
#define XB_TOPGEN   3392
#define XCD_BAR_WORDS 3456
#define XB_SPIN_CAP (1u << 18)
#define LAS __attribute__((address_space(3)))

__device__ __forceinline__ unsigned xb_ld(unsigned* p)              { return __hip_atomic_load(p, __ATOMIC_RELAXED, __HIP_MEMORY_SCOPE_AGENT); }
__device__ __forceinline__ unsigned xb_add(unsigned* p, unsigned v) { return __hip_atomic_fetch_add(p, v, __ATOMIC_RELAXED, __HIP_MEMORY_SCOPE_AGENT); }
__device__ __forceinline__ unsigned xb_xcc_id() { return (unsigned)__builtin_amdgcn_s_getreg((3 << 11) | 20) & 0xFu; }
#define XB_SPIN(cond, bar) do { unsigned _sp = 0; while (cond) { __builtin_amdgcn_s_sleep(1); \
    if ((++_sp & 255u) == 0u) { if (xb_ld(&(bar)[XB_TMO])) break; if (_sp > XB_SPIN_CAP) { atomicAdd(&(bar)[XB_TMO], 1u); break; } } } } while (0)

struct XcdBarrier {
    unsigned* bar; unsigned x;
    volatile LAS unsigned* st;
};

__device__ __forceinline__ XcdBarrier xcd_barrier_post(unsigned* bar, volatile LAS unsigned* st) {
    XcdBarrier b; b.bar = bar; b.x = xb_xcc_id(); b.st = st;
    if (threadIdx.x == 0) (void)xb_add(&bar[XB_XCNT(b.x)], 1u);
    return b;
}
__device__ __forceinline__ void xcd_barrier_complete(unsigned* bar, unsigned x, unsigned& nloc, unsigned& nx) {
    const unsigned G = gridDim.x * gridDim.y * gridDim.z;
    unsigned sum, cnt, mine, sp = 0u;
    for (;;) {
        sum = 0u; cnt = 0u; mine = 0u;
#pragma unroll
        for (unsigned j = 0; j < 16; ++j) { const unsigned c = xb_ld(&bar[XB_XCNT(j)]); sum += c; cnt += (c > 0u) ? 1u : 0u; mine = (j == x) ? c : mine; }
        if (sum == G) break;
        __builtin_amdgcn_s_sleep(1);
        if ((++sp & 255u) == 0u) { if (xb_ld(&bar[XB_TMO])) break; if (sp > XB_SPIN_CAP) { atomicAdd(&bar[XB_TMO], 1u); break; } }
    }
    nloc = mine > 0u ? mine : 1u; nx = cnt > 0u ? cnt : 1u;
}

__device__ __forceinline__ void xcd_barrier(const XcdBarrier& b) {
    asm volatile("s_waitcnt vmcnt(0)" ::: "memory");
    __syncthreads();
    if (threadIdx.x == 0) {
        unsigned* bar = b.bar;
        __builtin_amdgcn_s_waitcnt(0);
        unsigned nloc = b.st[0], nx = b.st[1];
        if (nloc == 0u) { xcd_barrier_complete(bar, b.x, nloc, nx); b.st[0] = nloc; b.st[1] = nx; }
        const unsigned old = xb_add(&bar[XB_XSUB(b.x)], 1u);
        const unsigned gen = old / nloc;
        if (old + 1u == (gen + 1u) * nloc) {
            __builtin_amdgcn_fence(__ATOMIC_RELEASE, "agent");
            asm volatile("s_waitcnt vmcnt(0)" ::: "memory");
            const unsigned og = xb_add(&bar[XB_TOP], 1u);
            const unsigned tg = og / nx;
            if (og + 1u == (tg + 1u) * nx) xb_add(&bar[XB_TOPGEN], 1u);
            else XB_SPIN(xb_ld(&bar[XB_TOPGEN]) == tg, bar);
            __builtin_amdgcn_fence(__ATOMIC_ACQUIRE, "agent");
            xb_add(&bar[XB_XGEN(b.x)], 1u);
            asm volatile("s_waitcnt vmcnt(0)" ::: "memory");
        } else {
            XB_SPIN(xb_ld(&bar[XB_XGEN(b.x)]) == gen, bar);
            __builtin_amdgcn_fence(__ATOMIC_ACQUIRE, "agent");
            asm volatile("s_waitcnt vmcnt(0)" ::: "memory");
        }
    }
    __syncthreads();
}


__device__ void run_phase(const Params& p, unsigned char* lds, int ph, int layer, int chunk, int bid, int nblk) {
  unsigned char* WS = launder_ws(lds);
  float* X = p.out + (size_t)chunk * MC * 1024;
  unsigned char* wl = WS + G_WL + layer * WL_SIZE;
  bf16_t* XB = (bf16_t*)(WS + G_XB);
  switch (ph) {
    case 0: phase0(p, lds, bid, nblk);
            ln_rows(p.in[0], (float*)nullptr, XB, p.in[1], p.in[2], MC, bid, nblk); break;
    case 2: phase_proj(p, lds, layer, bid, nblk); break;
    case 3: phase2(p, lds, layer, bid, nblk); break;
    case 4: phase3(p, lds, layer, bid, nblk); break;
    case 5: case 13: case 14: phase4(p, lds, layer, bid, nblk, ph == 5 ? 0 : ph - 12); break;
    case 6: phase5(p, lds, layer, bid, nblk); break;
    case 7: phase_merge(p, lds, layer, bid, nblk); break;
    case 8: phase_resid<1024>(p, lds, (const bf16_t*)(WS + G_ONSA), (const bf16_t*)(wl + O_WOUT), X, bid, nblk); break;
    case 9: ln_rows(X, (float*)nullptr, XB, p.in[26] + layer * 1024, p.in[27] + layer * 1024, MC, bid, nblk); break;
    case 10: phase_ff1(p, lds, layer, bid, nblk); break;
    case 11: phase_resid<4096>(p, lds, (const bf16_t*)(WS + G_PROJ), (const bf16_t*)(wl + O_WFF2), X, bid, nblk); break;
    case 12: {
      const bool fold = (layer + 1 == DEPTH) && (chunk + 1 < NCH);
      const int nj = fold ? 2 : 1;
#pragma unroll 1
      for (int i = 0; i < nj; ++i) {
        const bool second = (i == 1);
        ln_rows(second ? p.in[0] + (size_t)(chunk + 1) * MC * 1024 : X, (!second && layer + 1 == DEPTH) ? X : (float*)nullptr,
                (second || layer + 1 < DEPTH) ? XB : (bf16_t*)nullptr, second ? p.in[1] : p.in[30] + layer * 1024, second ? p.in[2] : p.in[31] + layer * 1024, MC, bid, nblk);
      }
      break; }
    default: break;
  }
}

__global__ void __launch_bounds__(NTHR, 2) k_mega(Params p) {
  __shared__ __attribute__((aligned(16))) unsigned char lds[LDS_BYTES + 256];
  cg::grid_group grid = cg::this_grid();
  {
    volatile LAS unsigned* bst = (volatile LAS unsigned*)(lds + LDS_BYTES);
    if (threadIdx.x == 0) { bst[0] = 0u; bst[1] = 0u; const unsigned long long wsv = (unsigned long long)p.ws; bst[4] = (unsigned)wsv; bst[5] = (unsigned)(wsv >> 32); }
    __syncthreads();
    if (blockIdx.x == 0) {
      unsigned* bw = (unsigned*)(launder_ws(lds) + G_BAR);
      for (int i = threadIdx.x; i < XCD_BAR_WORDS; i += NTHR) __hip_atomic_store(bw + i, 0u, __ATOMIC_RELAXED, __HIP_MEMORY_SCOPE_AGENT);
    }
  }
  const int bid = blockIdx.x, nblk = gridDim.x;
#ifdef DBL_LO
  constexpr int NEXTRA = DBL_HI - DBL_LO + 1;
  constexpr int DLO = DBL_LO, DHI = DBL_HI;
#else
  constexpr int NEXTRA = 0, DLO = 100, DHI = 100;
#endif
  constexpr int PER_LAYER = 11 + NEXTRA, PER_CHUNK = DEPTH * PER_LAYER, NSTEP = 1 + NCH * PER_CHUNK;
#pragma unroll 1
  for (int step = 0; step < NSTEP; ++step) {
    int ph = 0, layer = 0, chunk = 0;
    if (step > 0) {
      const int s = step - 1, r = s % PER_CHUNK;
      chunk = s / PER_CHUNK; layer = r / PER_LAYER;
      const int i = r % PER_LAYER, nfirst = DHI - 2 + 1;
      if (NEXTRA == 0 || i < nfirst) ph = 2 + i;
      else if (i < nfirst + NEXTRA) ph = DLO + (i - nfirst);
      else ph = 2 + i - NEXTRA;
    }
    run_phase(p, lds, ph, layer, chunk, bid, nblk);
    if (step + 1 < NSTEP) { if (step == 0) { grid.sync(); (void)xcd_barrier_post((unsigned*)(launder_ws(lds) + G_BAR), (volatile LAS unsigned*)(lds + LDS_BYTES)); } else { XcdBarrier xb; xb.bar = (unsigned*)(launder_ws(lds) + G_BAR); xb.x = xb_xcc_id(); xb.st = (volatile LAS unsigned*)(lds + LDS_BYTES); xcd_barrier(xb); } }
  }
}

extern "C" void kernel_launch(void* const* d_in, const int* in_sizes, int n_in, void* d_out, int out_size, void* d_ws, size_t ws_size,
                              hipStream_t stream) {
  Params p{};
  for (int i = 0; i < 32; ++i) p.in[i] = (const float*)d_in[i];
  p.out = (float*)d_out;
  p.ws = (unsigned char*)d_ws;
  static int grid_blocks = 0;
  if (!grid_blocks) {
    int dev = 0, cus = 0, per_cu = 0;
    (void)hipGetDevice(&dev);
    (void)hipDeviceGetAttribute(&cus, hipDeviceAttributeMultiprocessorCount, dev);
    (void)hipOccupancyMaxActiveBlocksPerMultiprocessor(&per_cu, k_mega, NTHR, 0);
    if (per_cu > 1) per_cu = 1;
    if (per_cu < 1) per_cu = 1;
    grid_blocks = cus * per_cu;
  }
  void* args[] = {&p};
  (void)hipLaunchCooperativeKernel((void*)k_mega, dim3(grid_blocks), dim3(NTHR), args, 0, stream);
}
```

```cpp
#include <hip/hip_runtime.h>
#include <hip/hip_cooperative_groups.h>
#include <type_traits>
namespace cg = cooperative_groups;

typedef unsigned short bf16_t;
typedef short bf16x8 __attribute__((ext_vector_type(8)));
typedef float f32x4 __attribute__((ext_vector_type(4)));
typedef unsigned long long u64;
typedef unsigned u32x4v __attribute__((ext_vector_type(4)));
typedef unsigned u32x2v __attribute__((ext_vector_type(2)));

constexpr int DM = 1024, NB = 8, SEQ = 4096, DEPTH = 2;
constexpr int CHB = 4;
constexpr int NCH = NB / CHB;
constexpr int MC = CHB * SEQ;
constexpr int INW = 5400, INP = 5632;
constexpr int C_SSM = 512, C_Q = 1024, C_KV = 1536, C_GN = 2304, C_GM = 2328;
constexpr int NROW = CHB * 64;
constexpr float ALPHA = 1.4142135623730951f;
constexpr int LDS_BYTES = 131072;
constexpr int NTHR = 512;
constexpr int NWV = NTHR / 64;

constexpr size_t al256(size_t x) { return (x + 255) & ~(size_t)255; }
constexpr size_t O_WIN = 0;
constexpr size_t O_WPOOL = O_WIN + (size_t)INP * 1024 * 2;
constexpr size_t O_WGLU = O_WPOOL + 4 * 128 * 128 * 2;
constexpr size_t O_WUP = O_WGLU + 512 * 512 * 2;
constexpr size_t O_WOUT = O_WUP + 3 * 1024 * 512 * 2;
constexpr size_t O_WFF1 = O_WOUT + 1024 * 1024 * 2;
constexpr size_t O_WFF2 = O_WFF1 + 4096 * 1024 * 2;
constexpr size_t O_WCK1 = O_WFF2 + 4096 * 1024 * 2;
constexpr size_t O_WCV1 = O_WCK1 + 128 * 2048 * 2;
constexpr size_t O_WCK2 = O_WCV1 + 128 * 2048 * 2;
constexpr size_t O_WCV2 = O_WCK2 + 64 * 128 * 2;
constexpr size_t O_BCK1 = O_WCV2 + 64 * 128 * 2;
constexpr size_t O_BCV1 = O_BCK1 + 512;
constexpr size_t O_KMAT = O_BCV1 + 512;
constexpr size_t O_EMAT = O_KMAT + 32 * 64 * 256 * 2;
constexpr size_t O_FMAT = O_EMAT + (size_t)32 * 128 * 1024 * 2;
constexpr size_t O_A64 = O_FMAT + (size_t)32 * 1024 * 128 * 2;
constexpr size_t WL_SIZE = al256(O_A64 + 32 * 64 * 2 * 4);
constexpr size_t G_WL = 0;
constexpr size_t G_ROPE = G_WL + 2 * WL_SIZE;
constexpr size_t G_XB = al256(G_ROPE + 4096 * 16 * 4);
constexpr size_t G_PROJ = al256(G_XB + (size_t)MC * 1024 * 4);
constexpr size_t G_Y = al256(G_PROJ + (size_t)MC * INP * 2);
constexpr size_t G_ZS = al256(G_Y + (size_t)MC * 1536 * 2);
constexpr size_t G_ONSA = al256(G_ZS + (size_t)MC * 512 * 2);
constexpr size_t G_S = al256(G_ONSA + (size_t)MC * 512 * 4);
constexpr size_t G_HIN = al256(G_S + (size_t)32 * NROW * 128 * 4);
constexpr size_t G_KCMP = al256(G_HIN + (size_t)32 * NROW * 128 * 2);
constexpr size_t G_VCMPT = al256(G_KCMP + (size_t)CHB * 2 * 256 * 64 * 2);
constexpr size_t G_H1 = al256(G_VCMPT + (size_t)CHB * 2 * 256 * 64 * 2);
constexpr size_t G_SEL = al256(G_H1 + (size_t)2 * CHB * 512 * 128 * 2);
constexpr size_t G_BAR = al256(G_SEL + (size_t)MC * 2 * 8);
constexpr size_t G_USSM = al256(G_BAR + 3456 * 4);
constexpr size_t G_END = al256(G_USSM + (size_t)32 * MC * 16 * 2);
static_assert(G_END <= (size_t)536870912, "workspace budget");
static_assert((size_t)MC * 4096 * 2 <= (size_t)MC * INP * 2, "H aliases PROJ");

struct Params {
  const float* in[32];
  float* out;
  unsigned char* ws;
};

__device__ __forceinline__ unsigned char* launder_ws(unsigned char* lds) {
  const volatile __attribute__((address_space(3))) unsigned* q = (const volatile __attribute__((address_space(3))) unsigned*)(lds + LDS_BYTES + 16);
  const unsigned lo = (unsigned)__builtin_amdgcn_readfirstlane((int)q[0]), hi = (unsigned)__builtin_amdgcn_readfirstlane((int)q[1]);
  return (unsigned char*)(((unsigned long long)hi << 32) | (unsigned long long)lo);
}
__device__ __forceinline__ int otid() { int t = threadIdx.x; asm volatile("" : "+v"(t)); return t; }
__device__ __forceinline__ float bf2f(bf16_t h) { return __uint_as_float(((unsigned)h) << 16); }
__device__ __forceinline__ bf16_t f2bf(float f) {
  unsigned u = __float_as_uint(f);
  u += 0x7fffu + ((u >> 16) & 1u);
  return (bf16_t)(u >> 16);
}
__device__ __forceinline__ unsigned pack2(float a, float b) { unsigned r; asm volatile("v_cvt_pk_bf16_f32 %0, %1, %2" : "=v"(r) : "v"(a), "v"(b)); return r; }
__device__ __forceinline__ uint2 pack4(f32x4 v) { uint2 r; r.x = pack2(v[0], v[1]); r.y = pack2(v[2], v[3]); return r; }
__device__ __forceinline__ f32x4 unpack4(uint2 u) {
  f32x4 r; r[0] = __uint_as_float(u.x << 16); r[1] = __uint_as_float(u.x & 0xffff0000u);
  r[2] = __uint_as_float(u.y << 16); r[3] = __uint_as_float(u.y & 0xffff0000u); return r;
}
__device__ __forceinline__ f32x4 unpack4v(u32x2v u) { uint2 t; t.x = u.x; t.y = u.y; return unpack4(t); }
__device__ __forceinline__ u32x2v pack4v(f32x4 v) { const uint2 t = pack4(v); u32x2v r; r.x = t.x; r.y = t.y; return r; }
#define GASQ __attribute__((address_space(1)))
__device__ __forceinline__ uint4 gld16(const void* q) { const u32x4v v = *(const GASQ u32x4v*)q; return make_uint4(v.x, v.y, v.z, v.w); }
__device__ __forceinline__ uint2 gld8(const void* q) { const u32x2v v = *(const GASQ u32x2v*)q; uint2 r; r.x = v.x; r.y = v.y; return r; }
__device__ __forceinline__ bf16x8 gld16b(const void* q) { return *(const GASQ bf16x8*)q; }
__device__ __forceinline__ float4 gldf4(const void* q) { const f32x4 v = *(const GASQ f32x4*)q; return make_float4(v[0], v[1], v[2], v[3]); }
__device__ __forceinline__ void gst8(void* q, uint2 v) { u32x2v t; t.x = v.x; t.y = v.y; *(GASQ u32x2v*)q = t; }
__device__ __forceinline__ void gstf4(void* q, float4 v) { *(GASQ f32x4*)q = (f32x4){v.x, v.y, v.z, v.w}; }
__device__ __forceinline__ float sigmoidf_(float x) { return __builtin_amdgcn_rcpf(1.0f + __builtin_amdgcn_exp2f(-1.4426950408889634f * x)); }
__device__ __forceinline__ float gelu_tanh(float x) {
  float u = 0.7978845608028654f * (x + 0.044715f * x * x * x);
  return x * __builtin_amdgcn_rcpf(1.0f + __builtin_amdgcn_exp2f(-2.8853900817779268f * u));
}
__device__ __forceinline__ float shx(float v, int mask, int lane) { return __int_as_float(__builtin_amdgcn_ds_bpermute((lane ^ mask) << 2, __float_as_int(v))); }
__device__ __forceinline__ unsigned shxu(unsigned v, int mask, int lane) { return (unsigned)__builtin_amdgcn_ds_bpermute((lane ^ mask) << 2, (int)v); }
__device__ __forceinline__ float wave_sum(float v, int lane) {
#pragma unroll
  for (int o = 32; o >= 1; o >>= 1) v += shx(v, o, lane);
  return v;
}

namespace pg8 {
#define PG8_LAS __attribute__((address_space(3)))
typedef unsigned short bf16_t;
typedef short bf16x8 __attribute__((ext_vector_type(8)));
typedef float f32x4 __attribute__((ext_vector_type(4)));
typedef unsigned u32x4 __attribute__((ext_vector_type(4)));
constexpr int BM = 256, BK = 64, HALF = 128, HTB = HALF * BK * 2  , STAGE_BYTES = 8 * HTB, NXCD = 8, WGM = 4;

__host__ __device__ __forceinline__ int lds_byte(int r, int c) { const int st = (r >> 4) * 2 + (c >> 5), rr = r & 15, cc = c & 31, ob = rr * 64 + cc * 2; return st * 1024 + (ob ^ (((ob >> 9) & 1) << 5)); }
__host__ __device__ __forceinline__ void stage_rc(int b, int& R, int& C) { const int st = b / 1024, sb = b % 1024, swz = sb ^ (((sb >> 9) & 1) << 5); R = (st >> 1) * 16 + swz / 64; C = (st & 1) * 32 + (swz % 64) / 2; }
__host__ __device__ __forceinline__ int perm32(int rho) { const int n = rho >> 4, i = rho & 15; return 8 * (i >> 2) + 4 * n + (i & 3); }

struct Gemm { const bf16_t* A; const bf16_t* Bt; int M, N, K; };

struct Unit { int pm, pn; };
struct StaticOrder {
    int nM, nN, nwg, G, c;
    __host__ __device__ void init(int M, int N, int G_, int c_) { nM = M / BM; nN = N / BM; nwg = nM * nN; G = G_; c = c_; }
    __host__ __device__ bool next(int i, Unit& u) const {
        const long L = (long)i * G + c; if (L >= nwg) return false;
        int wgid = (int)L; { const int q = nwg / NXCD, r = nwg % NXCD, xcd = wgid % NXCD, off = wgid / NXCD; wgid = (xcd < r ? xcd * (q + 1) : r * (q + 1) + (xcd - r) * q) + off; }
        const int nig = WGM * nN, gid = wgid / nig, fm = gid * WGM, gsz = (nM - fm) < WGM ? (nM - fm) : WGM;
        u.pm = fm + ((wgid % nig) % gsz); u.pn = (wgid % nig) / gsz; return true;
    }
    __device__ __forceinline__ void a_ready(const Unit&) const {}
    __device__ __forceinline__ size_t a_off(const Unit&) const { return 0; }
    __device__ __forceinline__ void done(const Unit&) const {}
};

struct MergeOrder {
    StaticOrder base;
    __host__ __device__ void init(int G_, int c_) { base.init(MC, 1024, G_, c_); }
    __host__ __device__ bool next(int i, Unit& u) const { Unit b; if (!base.next(i / 3, b)) return false; u.pm = b.pm; u.pn = (i % 3) * 4 + b.pn; return true; }
    __device__ __forceinline__ void a_ready(const Unit&) const {}
    __device__ __forceinline__ void done(const Unit&) const {}
    __device__ __forceinline__ size_t a_off(const Unit& u) const { return (size_t)(u.pn >> 2) * ((size_t)MC * 512 * 2); }
};
struct EpiProj {
  static constexpr bool PERM = false, AFTER_DRAIN = false, MID = false;
  bf16_t* PROJ; const float* rope; int coff; bf16_t* USSM;
  __device__ __forceinline__ void operator()(const f32x4 (&acc)[2][2][4][2], const Unit& u, int wr, int wc, int fr, int fq) const {
#pragma unroll
    for (int bj = 0; bj < 2; ++bj) {
      const int cb = coff + u.pn * BM + bj * HALF + wc * 32;
      const int jg = (cb - C_Q) >> 6;
      const bool inqkv = (cb >= C_Q) && (cb < C_GN);
      const bool roped = inqkv && ((cb & 32) == 0) && (jg < 8 || (((jg - 8) & 2) == 0));
      const bool isq = (cb >= C_Q) && (cb < C_KV);
      const bool isgate = cb >= C_GN;
      const bool isssm = (cb >= C_SSM) && (cb < C_Q);
#pragma unroll
      for (int ai = 0; ai < 2; ++ai) {
        float4 csr[4], snr[4];
#pragma unroll
        for (int m = 0; m < 4; ++m) {
          if (roped) {
            const int pos = (u.pm * BM + ai * HALF + wr * 64 + m * 16 + fr) & (SEQ - 1);
            csr[m] = gldf4(rope + pos * 16 + (fq & 1) * 4); snr[m] = gldf4(rope + pos * 16 + 8 + (fq & 1) * 4);
          } else { csr[m] = make_float4(0.f, 0.f, 0.f, 0.f); snr[m] = make_float4(0.f, 0.f, 0.f, 0.f); }
        }
#pragma unroll
        for (int m = 0; m < 4; ++m) {
          const int row = u.pm * BM + ai * HALF + wr * 64 + m * 16 + fr;
#pragma unroll
          for (int n = 0; n < 2; ++n) {
            f32x4 v = acc[ai][bj][m][n];
            if (isgate) {
#pragma unroll
              for (int e = 0; e < 4; ++e) v[e] = sigmoidf_(v[e]);
            } else if (roped && n == 0) {
              const float csv[4] = {csr[m].x, csr[m].y, csr[m].z, csr[m].w}, snv[4] = {snr[m].x, snr[m].y, snr[m].z, snr[m].w};
#pragma unroll
              for (int e = 0; e < 4; ++e) {
                const float pv = shx(v[e], 32, fq * 16 + fr);
                v[e] = (fq < 2) ? (v[e] * csv[e] - pv * snv[e]) : (pv * snv[e] + v[e] * csv[e]);
              }
            }
            if (isq) {
#pragma unroll
              for (int e = 0; e < 4; ++e) v[e] *= 0.18033688011112042f;
            }
            if (isssm) gst8(USSM + ((size_t)(((cb - C_SSM) >> 4) + n) * MC + row) * 16 + 4 * fq, pack4(v));
            else gst8(PROJ + (size_t)row * INP + cb + n * 16 + 4 * fq, pack4(v));
          }
        }
        asm volatile("" ::: "memory");
      }
    }
  }
};
struct EpiRelu2 {
  static constexpr bool PERM = true, AFTER_DRAIN = false, MID = false;
  bf16_t* O; int ldc;
  __device__ __forceinline__ void operator()(const f32x4 (&acc)[2][2][4][2], const Unit& u, int wr, int wc, int fr, int fq) const {
    int row0 = u.pm * BM + wr * 64 + fr, col0 = u.pn * BM + wc * 32 + 8 * fq;
    asm volatile("" : "+v"(row0), "+v"(col0));
#pragma unroll
    for (int ai = 0; ai < 2; ++ai)
#pragma unroll
      for (int m = 0; m < 4; ++m) {
        bf16_t* rowp = O + (size_t)(row0 + ai * HALF + m * 16) * ldc + col0;
#pragma unroll
        for (int bj = 0; bj < 2; ++bj) {
          f32x4 v0 = acc[ai][bj][m][0], v1 = acc[ai][bj][m][1];
#pragma unroll
          for (int e = 0; e < 4; ++e) { const float a = fmaxf(v0[e], 0.f), b = fmaxf(v1[e], 0.f); v0[e] = a * a; v1[e] = b * b; }
          u32x4 w; w.x = pack2(v0[0], v0[1]); w.y = pack2(v0[2], v0[3]); w.z = pack2(v1[0], v1[1]); w.w = pack2(v1[2], v1[3]);
          *(u32x4*)(rowp + bj * HALF) = w;
        }
      }
  }
};
#define GAS __attribute__((address_space(1)))
struct EpiResid {
  static constexpr bool PERM = false, AFTER_DRAIN = false, MID = false;
  float* X; const bf16_t* XBr;
  __device__ __forceinline__ void operator()(const f32x4 (&acc)[2][2][4][2], const Unit& u, int wr, int wc, int fr, int fq) const {
    int row0 = u.pm * BM + wr * 64 + fr, col0 = u.pn * BM + wc * 32 + 4 * fq;
    asm volatile("" : "+v"(row0), "+v"(col0));
    const GAS bf16_t* xb = (const GAS bf16_t*)XBr; GAS float* xo = (GAS float*)X;
#pragma unroll
    for (int ai = 0; ai < 2; ++ai) {
      u32x2v xv[4][2][2];
#pragma unroll
      for (int m = 0; m < 4; ++m)
#pragma unroll
        for (int bj = 0; bj < 2; ++bj)
#pragma unroll
          for (int n = 0; n < 2; ++n) xv[m][bj][n] = *(const GAS u32x2v*)(xb + (size_t)(row0 + ai * HALF + m * 16) * 1024 + col0 + bj * HALF + n * 16);
#pragma unroll
      for (int m = 0; m < 4; ++m)
#pragma unroll
        for (int bj = 0; bj < 2; ++bj)
#pragma unroll
          for (int n = 0; n < 2; ++n)
            *(GAS f32x4*)(xo + (size_t)(row0 + ai * HALF + m * 16) * 1024 + col0 + bj * HALF + n * 16) = unpack4v(xv[m][bj][n]) * ALPHA + acc[ai][bj][m][n];
      asm volatile("" ::: "memory");
    }
  }
};
struct EpiMerge {
  static constexpr bool PERM = false, AFTER_DRAIN = false, MID = true;
  const bf16_t* PROJ; bf16_t* MG;
  __device__ __forceinline__ static f32x4 clampg(f32x4 g) { f32x4 r; for (int e = 0; e < 4; ++e) r[e] = fmaxf(g[e], 1e-30f); return r; }
  __device__ __forceinline__ void mid(f32x4 (&acc)[2][2][4][2], const Unit& u, int t, int wr, int wc, int fr, int fq) const {
    const int seg = (t == 8) ? 0 : 1;
    int row0 = u.pm * BM + wr * 64 + fr, col0 = u.pn * BM + wc * 32 + 4 * fq;
    asm volatile("" : "+v"(row0), "+v"(col0));
    const GAS bf16_t* pg = (const GAS bf16_t*)PROJ;
#pragma unroll
    for (int ai = 0; ai < 2; ++ai)
#pragma unroll
      for (int mh = 0; mh < 2; ++mh) {
        u32x2v ga[2][2][2], gb[2][2][2];
#pragma unroll
        for (int mm = 0; mm < 2; ++mm)
#pragma unroll
          for (int bj = 0; bj < 2; ++bj)
#pragma unroll
            for (int n = 0; n < 2; ++n) {
              const GAS bf16_t* gp = pg + (size_t)(row0 + ai * HALF + (mh * 2 + mm) * 16) * INP + C_GM + seg * 1024 + col0 + bj * HALF + n * 16;
              ga[mm][bj][n] = *(const GAS u32x2v*)gp; gb[mm][bj][n] = *(const GAS u32x2v*)(gp + 1024);
            }
#pragma unroll
        for (int mm = 0; mm < 2; ++mm)
#pragma unroll
          for (int bj = 0; bj < 2; ++bj)
#pragma unroll
            for (int n = 0; n < 2; ++n) {
              const f32x4 a = clampg(unpack4v(ga[mm][bj][n])), b = clampg(unpack4v(gb[mm][bj][n]));
              f32x4 r;
#pragma unroll
              for (int e = 0; e < 4; ++e) r[e] = a[e] * __builtin_amdgcn_rcpf(b[e]);
              acc[ai][bj][mh * 2 + mm][n] *= r;
            }
        asm volatile("" ::: "memory");
      }
  }
  __device__ __forceinline__ void operator()(const f32x4 (&acc)[2][2][4][2], const Unit& u, int wr, int wc, int fr, int fq) const {
    int row0 = u.pm * BM + wr * 64 + fr, col0 = u.pn * BM + wc * 32 + 4 * fq;
    asm volatile("" : "+v"(row0), "+v"(col0));
    const GAS bf16_t* pg = (const GAS bf16_t*)PROJ; GAS bf16_t* mg = (GAS bf16_t*)MG;
#pragma unroll
    for (int ai = 0; ai < 2; ++ai) {
      u32x2v gv[4][2][2];
#pragma unroll
      for (int m = 0; m < 4; ++m)
#pragma unroll
        for (int bj = 0; bj < 2; ++bj)
#pragma unroll
          for (int n = 0; n < 2; ++n) gv[m][bj][n] = *(const GAS u32x2v*)(pg + (size_t)(row0 + ai * HALF + m * 16) * INP + C_GM + 2 * 1024 + col0 + bj * HALF + n * 16);
#pragma unroll
      for (int m = 0; m < 4; ++m)
#pragma unroll
        for (int bj = 0; bj < 2; ++bj)
#pragma unroll
          for (int n = 0; n < 2; ++n)
            *(GAS u32x2v*)(mg + (size_t)(row0 + ai * HALF + m * 16) * 1024 + col0 + bj * HALF + n * 16) = pack4v(clampg(unpack4v(gv[m][bj][n])) * acc[ai][bj][m][n]);
      asm volatile("" ::: "memory");
    }
  }
};
template <class Epi, class Sched, bool STAMP = false>
__device__ __forceinline__ void gemm_phase(PG8_LAS unsigned char* lds, const Gemm g, const Sched& S, const Epi& E, unsigned long long* stamps) {
    const int tid = otid(), wid = __builtin_amdgcn_readfirstlane(tid >> 6), lane = tid & 63, wr = wid >> 2, wc = wid & 3, fr = lane & 15, fq = lane >> 4;
    const int K = g.K, nt = K / BK;
    int ts_lo = 0, ts_hi = 0, nts = 0; const unsigned long long rt_entry = STAMP ? (unsigned long long)wall_clock64() : 0ull;
#define PG8_STAMP() do { if (STAMP && wid == 0 && nts < 64) { const unsigned long long _c = (unsigned long long)clock64(); \
        ts_lo = (lane == nts) ? (int)(unsigned)_c : ts_lo; ts_hi = (lane == nts) ? (int)(unsigned)(_c >> 32) : ts_hi; ++nts; } } while (0)
    PG8_STAMP();
    unsigned voffA[2], voffB[2];
#pragma unroll
    for (int i = 0; i < 2; ++i) { int R, C; stage_rc(tid * 16 + i * 8192, R, C); const int Rb = Epi::PERM ? ((R & ~31) + perm32(R & 31)) : R;
        voffA[i] = (unsigned)(R * K + C) * 2u; voffB[i] = (unsigned)(Rb * K + C) * 2u; }
    const size_t kstep = (size_t)(BK * 2);
    const size_t hstep = (size_t)HALF * K * 2;
    const size_t tstep = 2 * hstep;
    const unsigned ldsw = (unsigned)wid * 1024u;
    const int aoff = lds_byte(wr * 64 + fr, fq * 8), boff = lds_byte(wc * 32 + fr, fq * 8);
#define PG8_SA(b, h) (((b) * 2 + (h)) * HTB)
#define PG8_SB(b, h) ((4 + (b) * 2 + (h)) * HTB)
#define PG8_STAGE(bufoff, gbase, voff) do { _Pragma("unroll") for (int _i = 0; _i < 2; ++_i) \
        __builtin_amdgcn_global_load_lds((const unsigned*)((const char*)(gbase) + (voff)[_i]), (PG8_LAS unsigned*)(lds + (bufoff) + ldsw + _i * 8192), 16, 0, 0); } while (0)
#define PG8_LDA(dst, b, h) do { _Pragma("unroll") for (int m = 0; m < 4; ++m) _Pragma("unroll") for (int k = 0; k < 2; ++k) dst[m][k] = *(const PG8_LAS bf16x8*)(lds + PG8_SA(b, h) + aoff + m * 2048 + k * 1024); } while (0)
#define PG8_LDB(dst, b, h) do { _Pragma("unroll") for (int n = 0; n < 2; ++n) _Pragma("unroll") for (int k = 0; k < 2; ++k) dst[n][k] = *(const PG8_LAS bf16x8*)(lds + PG8_SB(b, h) + boff + n * 2048 + k * 1024); } while (0)
#define PG8_MMA(ai, bj, At, Bt) do { __builtin_amdgcn_s_setprio(1); _Pragma("unroll") for (int m = 0; m < 4; ++m) _Pragma("unroll") for (int n = 0; n < 2; ++n) _Pragma("unroll") for (int k = 0; k < 2; ++k) \
        acc[ai][bj][m][n] = __builtin_amdgcn_mfma_f32_16x16x32_bf16(Bt[n][k], At[m][k], acc[ai][bj][m][n], 0, 0, 0); __builtin_amdgcn_s_setprio(0); } while (0)
#define PG8_WAIT_V(n) asm volatile("s_waitcnt vmcnt(" #n ")" ::: "memory")
#define PG8_WAIT_L(n) asm volatile("s_waitcnt lgkmcnt(" #n ")" ::: "memory")
#define PG8_BAR __builtin_amdgcn_s_barrier()
#define PG8_SCHED __builtin_amdgcn_sched_barrier(0)
    Unit cur, nxt; int ui = 0;
    if (!S.next(0, cur)) return;
    f32x4 acc[2][2][4][2];
#pragma unroll
    for (int a = 0; a < 2; ++a)
#pragma unroll
        for (int b = 0; b < 2; ++b)
#pragma unroll
            for (int m = 0; m < 4; ++m)
#pragma unroll
                for (int n = 0; n < 2; ++n) acc[a][b][m][n] = (f32x4){0.f, 0.f, 0.f, 0.f};
    bf16x8 At[4][2], B0[2][2], B1[2][2];
    const char* cA = (const char*)g.A + (size_t)cur.pm * tstep + S.a_off(cur); const char* cB = (const char*)g.Bt + (size_t)cur.pn * tstep;
    S.a_ready(cur);
    PG8_STAGE(PG8_SB(0, 0), cB, voffB); PG8_STAGE(PG8_SA(0, 0), cA, voffA); PG8_STAGE(PG8_SB(0, 1), cB + hstep, voffB); PG8_STAGE(PG8_SA(0, 1), cA + hstep, voffA);
    if (wr == 1) PG8_BAR;
    PG8_WAIT_V(4); PG8_BAR;
    PG8_STAGE(PG8_SB(1, 0), cB + kstep, voffB); PG8_STAGE(PG8_SA(1, 0), cA + kstep, voffA); PG8_STAGE(PG8_SB(1, 1), cB + hstep + kstep, voffB);
    PG8_WAIT_V(6); PG8_BAR;
    PG8_STAMP();
    for (;;) {
        const bool has_next = S.next(ui + 1, nxt);
        const char* nA = has_next ? (const char*)g.A + (size_t)nxt.pm * tstep + S.a_off(nxt) : cA; const char* nB = has_next ? (const char*)g.Bt + (size_t)nxt.pn * tstep : cB;
        for (int t = 0; t < nt; t += 2) {
            if constexpr (Epi::MID) { if (t == 8 || t == 16) E.mid(acc, cur, t, wr, wc, fr, fq); }
            const bool last = (t == nt - 2);
            const char* a1 = cA + (size_t)(t + 1) * kstep;
            const char* a2 = last ? nA : cA + (size_t)(t + 2) * kstep; const char* b2 = last ? nB : cB + (size_t)(t + 2) * kstep;
            const char* a3 = a2 + kstep; const char* b3 = b2 + kstep;
            if (last && has_next) S.a_ready(nxt);
            PG8_LDB(B0, 0, 0); PG8_SCHED; PG8_LDA(At, 0, 0); PG8_STAGE(PG8_SA(1, 1), a1 + hstep, voffA);
            PG8_WAIT_L(8); PG8_BAR; PG8_WAIT_L(0); PG8_MMA(0, 0, At, B0); PG8_BAR; PG8_SCHED;
            PG8_LDB(B1, 0, 1); PG8_STAGE(PG8_SB(0, 0), b2, voffB);
            PG8_BAR; PG8_WAIT_L(0); PG8_MMA(0, 1, At, B1); PG8_BAR;
            PG8_LDA(At, 0, 1); PG8_STAGE(PG8_SA(0, 0), a2, voffA);
            PG8_BAR; PG8_WAIT_L(0); PG8_MMA(1, 0, At, B0); PG8_BAR; PG8_SCHED;
            PG8_STAGE(PG8_SB(0, 1), b2 + hstep, voffB);
            PG8_WAIT_V(6); PG8_BAR; PG8_MMA(1, 1, At, B1); PG8_BAR;
            PG8_LDB(B0, 1, 0); PG8_SCHED; PG8_LDA(At, 1, 0); PG8_STAGE(PG8_SA(0, 1), a2 + hstep, voffA);
            PG8_WAIT_L(8); PG8_BAR; PG8_WAIT_L(0); PG8_MMA(0, 0, At, B0); PG8_BAR; PG8_SCHED;
            PG8_LDB(B1, 1, 1); PG8_STAGE(PG8_SB(1, 0), b3, voffB);
            PG8_BAR; PG8_WAIT_L(0); PG8_MMA(0, 1, At, B1); PG8_BAR;
            PG8_LDA(At, 1, 1); PG8_STAGE(PG8_SA(1, 0), a3, voffA);
            PG8_BAR; PG8_WAIT_L(0); PG8_MMA(1, 0, At, B0); PG8_BAR; PG8_SCHED;
            PG8_STAGE(PG8_SB(1, 1), b3 + hstep, voffB);
            PG8_WAIT_V(6); PG8_BAR; PG8_MMA(1, 1, At, B1); PG8_BAR;
        }
        PG8_STAMP();
        if constexpr (!Epi::AFTER_DRAIN) { E(acc, cur, wr, wc, fr, fq); S.done(cur); }
        PG8_STAMP();
        if (!has_next) break;
#pragma unroll
        for (int a = 0; a < 2; ++a)
#pragma unroll
            for (int b = 0; b < 2; ++b)
#pragma unroll
                for (int m = 0; m < 4; ++m)
#pragma unroll
                    for (int n = 0; n < 2; ++n) acc[a][b][m][n] = (f32x4){0.f, 0.f, 0.f, 0.f};
        cur = nxt; cA = nA; cB = nB; ++ui;
    }
    PG8_WAIT_V(0);
    if (wr == 0) PG8_BAR;
    PG8_BAR;
    if constexpr (Epi::AFTER_DRAIN) { E.fused(acc, cur, wr, wc, fr, fq, lds, wid, lane); S.done(cur); }
    PG8_STAMP();
    if (STAMP && wid == 0) { stamps[lane] = lane < nts ? (((unsigned long long)(unsigned)ts_hi << 32) | (unsigned)ts_lo) : 0ull;
        if (lane == 62) stamps[62] = rt_entry; if (lane == 63) stamps[63] = (unsigned long long)wall_clock64(); }
#undef PG8_STAMP
#undef PG8_SA
#undef PG8_SB
#undef PG8_STAGE
#undef PG8_LDA
#undef PG8_LDB
#undef PG8_MMA
#undef PG8_WAIT_V
#undef PG8_WAIT_L
#undef PG8_BAR
#undef PG8_SCHED
}
}

template <class LA, class LB>
__device__ __forceinline__ void gemm_acc(unsigned char* lds, int nk, const LA& la, const LB& lb, f32x4 (&acc)[4][2]) {
  const int tid = otid(), lane = tid & 63, wid = tid >> 6, wr = wid >> 2, wc = wid & 3, fr = lane & 15, fq = lane >> 4;
  bf16_t* sA = (bf16_t*)lds;
  bf16_t* sB = sA + 128 * 72;
  const int lrow = tid >> 3, lk = (tid & 7) * 8;
  uint4 ra[2][2], rb[2][2];
#pragma unroll
  for (int i = 0; i < 2; ++i) { ra[0][i] = la(lrow + i * 64, lk); rb[0][i] = lb(lrow + i * 64, lk); }
  if (nk > 1) {
#pragma unroll
    for (int i = 0; i < 2; ++i) { ra[1][i] = la(lrow + i * 64, 64 + lk); rb[1][i] = lb(lrow + i * 64, 64 + lk); }
  } else {
#pragma unroll
    for (int i = 0; i < 2; ++i) { ra[1][i] = make_uint4(0, 0, 0, 0); rb[1][i] = make_uint4(0, 0, 0, 0); }
  }
  for (int kt = 0; kt < nk; kt += 2) {
#pragma unroll
    for (int st = 0; st < 2; ++st) {
      if (kt + st < nk) {
        __syncthreads();
#pragma unroll
        for (int i = 0; i < 2; ++i) {
          *(uint4*)(sA + (lrow + i * 64) * 72 + lk) = ra[st][i];
          *(uint4*)(sB + (lrow + i * 64) * 72 + lk) = rb[st][i];
        }
        __syncthreads();
        if (kt + st + 2 < nk) {
#pragma unroll
          for (int i = 0; i < 2; ++i) { ra[st][i] = la(lrow + i * 64, (kt + st + 2) * 64 + lk); rb[st][i] = lb(lrow + i * 64, (kt + st + 2) * 64 + lk); }
        }
#pragma unroll
        for (int ks = 0; ks < 2; ++ks) {
          bf16x8 af[4], bfr[2];
#pragma unroll
          for (int mi = 0; mi < 4; ++mi) af[mi] = *(const bf16x8*)(sA + (wr * 64 + mi * 16 + fr) * 72 + ks * 32 + fq * 8);
#pragma unroll
          for (int ni = 0; ni < 2; ++ni) bfr[ni] = *(const bf16x8*)(sB + (wc * 32 + ni * 16 + fr) * 72 + ks * 32 + fq * 8);
#pragma unroll
          for (int mi = 0; mi < 4; ++mi)
#pragma unroll
            for (int ni = 0; ni < 2; ++ni) acc[mi][ni] = __builtin_amdgcn_mfma_f32_16x16x32_bf16(bfr[ni], af[mi], acc[mi][ni], 0, 0, 0);
        }
      }
    }
  }
}
__device__ __forceinline__ void zero_acc(f32x4 (&acc)[4][2]) {
#pragma unroll
  for (int i = 0; i < 4; ++i)
#pragma unroll
    for (int j = 0; j < 2; ++j) acc[i][j] = (f32x4){0.f, 0.f, 0.f, 0.f};
}
template <class LD>
__device__ __forceinline__ void gemm_pre(uint2 (&pre)[4][2], const LD& ld) {
  const int tid = otid(), lane = tid & 63, wid = tid >> 6, wr = wid >> 2, wc = wid & 3, fr = lane & 15, fq = lane >> 4;
#pragma unroll
  for (int mi = 0; mi < 4; ++mi)
#pragma unroll
    for (int ni = 0; ni < 2; ++ni) pre[mi][ni] = ld(wr * 64 + mi * 16 + fr, wc * 32 + ni * 16 + fq * 4);
}
template <class EP>
__device__ __forceinline__ void gemm_epi_pre(const f32x4 (&acc)[4][2], const uint2 (&pre)[4][2], const EP& ep) {
  const int tid = otid(), lane = tid & 63, wid = tid >> 6, wr = wid >> 2, wc = wid & 3, fr = lane & 15, fq = lane >> 4;
#pragma unroll
  for (int mi = 0; mi < 4; ++mi)
#pragma unroll
    for (int ni = 0; ni < 2; ++ni) ep(wr * 64 + mi * 16 + fr, wc * 32 + ni * 16 + fq * 4, acc[mi][ni], pre[mi][ni], ni);
}
template <class EP>
__device__ __forceinline__ void gemm_epi(const f32x4 (&acc)[4][2], const EP& ep) {
  const int tid = otid(), lane = tid & 63, wid = tid >> 6, wr = wid >> 2, wc = wid & 3, fr = lane & 15, fq = lane >> 4;
#pragma unroll
  for (int mi = 0; mi < 4; ++mi)
#pragma unroll
    for (int ni = 0; ni < 2; ++ni) ep(wr * 64 + mi * 16 + fr, wc * 32 + ni * 16 + fq * 4, acc[mi][ni], ni);
}

__device__ void transpose_job(unsigned char* lds, const float* src, bf16_t* dst, int K, int N, int Npad, int bid, int nblk, int ldd = 0) {
  if (ldd == 0) ldd = K;
  float* sm = (float*)lds;
  const int tid = otid();
  const int tk = K / 64, tn = Npad / 64, ntile = tk * tn;
  const int rr = tid >> 4, c4 = (tid & 15) * 4;
  const int wn = tid & 63, wk = (tid >> 6) * 8;
  float4 cur[2], nxt[2];
  auto ldtile = [&](int t, float4 (&v)[2]) {
    const int k0 = (t % tk) * 64, n0 = (t / tk) * 64;
#pragma unroll
    for (int i = 0; i < 2; ++i)
      v[i] = (n0 + c4 < N) ? gldf4(src + (size_t)(k0 + rr + 32 * i) * N + n0 + c4) : make_float4(0.f, 0.f, 0.f, 0.f);
  };
#pragma unroll
  for (int i = 0; i < 2; ++i) { cur[i] = make_float4(0.f, 0.f, 0.f, 0.f); nxt[i] = cur[i]; }
  if (bid < ntile) ldtile(bid, cur);
  for (int t = bid; t < ntile; t += nblk) {
    const int k0 = (t % tk) * 64, n0 = (t / tk) * 64;
    if (t + nblk < ntile) ldtile(t + nblk, nxt);
    __syncthreads();
#pragma unroll
    for (int i = 0; i < 2; ++i) *(float4*)(sm + (rr + 32 * i) * 68 + c4) = cur[i];
    __syncthreads();
    {
      float v[8];
#pragma unroll
      for (int e = 0; e < 8; ++e) v[e] = sm[(wk + e) * 68 + wn];
      uint4 o; o.x = pack2(v[0], v[1]); o.y = pack2(v[2], v[3]); o.z = pack2(v[4], v[5]); o.w = pack2(v[6], v[7]);
      u32x4v ov; ov.x = o.x; ov.y = o.y; ov.z = o.z; ov.w = o.w;
      *(GASQ u32x4v*)(dst + (size_t)(n0 + wn) * ldd + k0 + wk) = ov;
    }
#pragma unroll
    for (int i = 0; i < 2; ++i) cur[i] = nxt[i];
  }
}

__device__ __forceinline__ void sincos_f(float ang, float& s, float& c) {
  const float q = rintf(ang * 0.15915494309189535f);
  float r = fmaf(-q, 6.28125f, ang);
  r = fmaf(-q, 0.001934051513671875f, r);
  r = fmaf(-q, 1.255665914356996e-06f, r);
  s = __sinf(r); c = __cosf(r);
}

__device__ void phase0(const Params& p, unsigned char* lds, int bid, int nblk) {
  unsigned char* WS = launder_ws(lds);
  const int tid = otid();
  for (int layer = 0; layer < DEPTH; ++layer) {
    unsigned char* wl = WS + G_WL + layer * WL_SIZE;
    transpose_job(lds, p.in[3] + (size_t)layer * 1024 * INW, (bf16_t*)(wl + O_WIN), 1024, INW, INP, bid, nblk);
    for (int g = 0; g < 4; ++g)
      transpose_job(lds, p.in[4] + (size_t)(layer * 4 + g) * 128 * 128, (bf16_t*)(wl + O_WPOOL) + g * 128 * 128, 128, 128, 128, bid, nblk);
    transpose_job(lds, p.in[14] + (size_t)layer * 512 * 512, (bf16_t*)(wl + O_WGLU), 512, 512, 512, bid, nblk);
    for (int i = 0; i < 3; ++i)
      transpose_job(lds, p.in[22 + i] + (size_t)layer * 512 * 1024, (bf16_t*)(wl + O_WUP) + (size_t)i * 512, 512, 1024, 1024, bid, nblk, 1536);
    transpose_job(lds, p.in[25] + (size_t)layer * 1024 * 1024, (bf16_t*)(wl + O_WOUT), 1024, 1024, 1024, bid, nblk);
    transpose_job(lds, p.in[28] + (size_t)layer * 1024 * 4096, (bf16_t*)(wl + O_WFF1), 1024, 4096, 4096, bid, nblk);
    transpose_job(lds, p.in[29] + (size_t)layer * 4096 * 1024, (bf16_t*)(wl + O_WFF2), 4096, 1024, 1024, bid, nblk);
    transpose_job(lds, p.in[18] + (size_t)layer * 2048 * 128, (bf16_t*)(wl + O_WCK1), 2048, 128, 128, bid, nblk);
    transpose_job(lds, p.in[20] + (size_t)layer * 2048 * 128, (bf16_t*)(wl + O_WCV1), 2048, 128, 128, bid, nblk);
    transpose_job(lds, p.in[19] + (size_t)layer * 128 * 64, (bf16_t*)(wl + O_WCK2), 128, 64, 64, bid, nblk);
    transpose_job(lds, p.in[21] + (size_t)layer * 128 * 64, (bf16_t*)(wl + O_WCV2), 128, 64, 64, bid, nblk);
  }
  {
    float* rope = (float*)(WS + G_ROPE);
    for (int idx = bid * NTHR + tid; idx < 4096 * 8; idx += nblk * NTHR) {
      int pos = idx >> 3, i = idx & 7;
      const float inv = (i == 0) ? 1.0f : (i == 1) ? 0.19392274474868576f : (i == 2) ? 0.03760603093086393f : (i == 3) ? 0.007292664737217109f
                      : (i == 4) ? 0.001414213562373095f : (i == 5) ? 0.0002742481756762073f : (i == 6) ? 5.318295896944988e-05f : 1.031338537721246e-05f;
      float sn, cs; sincos_f((float)pos * inv, sn, cs);
      rope[pos * 16 + i] = cs; rope[pos * 16 + 8 + i] = sn;
    }
  }
  for (int it = bid; it < DEPTH * 2 * 8; it += nblk) {
    const int layer = it >> 4, kv = (it >> 3) & 1, j0 = (it & 7) * 16;
    const float* pe = p.in[16 + kv] + (size_t)layer * 2048;
    const float* w1 = p.in[kv ? 20 : 18] + (size_t)layer * 2048 * 128;
    float* sm = (float*)lds;
    const int jj = tid & 15, part = tid >> 4;
    float acc = 0.f;
#pragma unroll 8
    for (int i = 0; i < 64; ++i) { const int kk = part + i * 32; acc += pe[kk] * w1[(size_t)kk * 128 + j0 + jj]; }
    __syncthreads();
    sm[tid] = acc;
    __syncthreads();
    if (tid < 16) {
      float t = 0.f;
      for (int q = 0; q < 32; ++q) t += sm[q * 16 + tid];
      ((float*)(WS + G_WL + layer * WL_SIZE + (kv ? O_BCV1 : O_BCK1)))[j0 + tid] = t;
    }
    __syncthreads();
  }
  for (int it = bid; it < DEPTH * 32 * 9; it += nblk) {
    const int layer = it / (32 * 9), rem = it % (32 * 9), g = rem / 9, dg = rem % 9;
    unsigned char* wl = WS + G_WL + layer * WL_SIZE;
    float* pwr = (float*)lds; float* pwi = pwr + 64; float* kr = pwi + 64; float* ki = kr + 64; float* th1s = ki + 64; float* lrs = th1s + 64;
    float* bbr = lrs + 64; float* bbi = bbr + 1024; float* scre = bbi + 1024; float* scim = scre + 1024;
    const size_t gp = (size_t)(layer * 32 + g) * 64;
    __syncthreads();
    for (int idx = tid; idx < 1024; idx += NTHR) { scre[idx] = p.in[11][gp * 16 + idx]; scim[idx] = p.in[12][gp * 16 + idx]; }
    if (tid < 64) {
      const float lr = p.in[6][gp + tid], li = p.in[7][gp + tid];
      const float step = expf(p.in[8][layer * 32 + g]);
      const float th1 = li * step;
      float s1, c1; sincos_f(th1, s1, c1);
      const float mag = expf(lr * step);
      const float abr = mag * c1, abi = mag * s1;
      const float den = lr * lr + li * li;
      const float nr = abr - 1.0f, ni = abi;
      kr[tid] = (nr * lr + ni * li) / den;
      ki[tid] = (ni * lr - nr * li) / den;
      th1s[tid] = th1; lrs[tid] = lr * step;
    }
    __syncthreads();
    for (int idx = tid; idx < 1024; idx += NTHR) {
      int pp = idx >> 4;
      float br = p.in[9][gp * 16 + idx], bi = p.in[10][gp * 16 + idx];
      bbr[idx] = kr[pp] * br - ki[pp] * bi;
      bbi[idx] = kr[pp] * bi + ki[pp] * br;
    }
#pragma unroll 1
    for (int dd = 0; dd < 8; ++dd) {
      const int d = dg * 8 + dd;
      if (d > 64) break;
      __syncthreads();
      if (tid < 64) {
        float sd, cd; sincos_f(th1s[tid] * (float)d, sd, cd);
        const float md = expf(lrs[tid] * (float)d);
        pwr[tid] = md * cd; pwi[tid] = md * sd;
      }
      __syncthreads();
      if (d <= 63) {
        if (tid < 256) {
          const int co = tid >> 4, ci = tid & 15;
          float val = 0.f;
#pragma unroll 8
          for (int pp = 0; pp < 64; ++pp) {
            const float cr = scre[co * 64 + pp], cm = scim[co * 64 + pp];
            const float wr_ = cr * pwr[pp] - cm * pwi[pp], wi_ = cr * pwi[pp] + cm * pwr[pp];
            val += wr_ * bbr[pp * 16 + ci] - wi_ * bbi[pp * 16 + ci];
          }
          ((bf16_t*)(wl + O_KMAT))[(((size_t)g * 64 + d) * 16 + co) * 16 + ci] = f2bf(val);
        }
        const int sidx = 63 - d;
        bf16_t* em = (bf16_t*)(wl + O_EMAT);
        for (int idx = tid; idx < 1024; idx += NTHR) {
          const int pp = idx >> 4, ci = idx & 15;
          const float re = pwr[pp] * bbr[idx] - pwi[pp] * bbi[idx], im = pwr[pp] * bbi[idx] + pwi[pp] * bbr[idx];
          em[((size_t)g * 128 + pp) * 1024 + sidx * 16 + ci] = f2bf(re);
          em[((size_t)g * 128 + 64 + pp) * 1024 + sidx * 16 + ci] = f2bf(im);
        }
      }
      if (d >= 1) {
        const int t = d - 1;
        bf16_t* fm = (bf16_t*)(wl + O_FMAT);
        for (int idx = tid; idx < 1024; idx += NTHR) {
          const int co = idx >> 6, pp = idx & 63;
          const float cr = scre[idx], cm = scim[idx];
          const float wr_ = cr * pwr[pp] - cm * pwi[pp], wi_ = cr * pwi[pp] + cm * pwr[pp];
          fm[((size_t)g * 1024 + t * 16 + co) * 128 + pp] = f2bf(wr_);
          fm[((size_t)g * 1024 + t * 16 + co) * 128 + 64 + pp] = f2bf(-wi_);
        }
      }
      if (d == 64 && tid < 64) {
        float* a64 = (float*)(wl + O_A64);
        a64[(g * 64 + tid) * 2] = pwr[tid]; a64[(g * 64 + tid) * 2 + 1] = pwi[tid];
      }
    }
  }
}

__device__ void ln_rows(const float* src, float* dst, bf16_t* dstb, const float* gam, const float* bet, int nrows, int bid, int nblk) {
  const int tid = otid(), lane = tid & 63, wid = tid >> 6;
  const int stride = nblk * NWV;
  for (int row0 = bid * NWV + wid; row0 < nrows; row0 += 2 * stride) {
    float4 v[2][4];
    bool ok[2];
#pragma unroll
    for (int u = 0; u < 2; ++u) {
      const int row = row0 + u * stride;
      ok[u] = row < nrows;
      const float4* s4 = (const float4*)(src + (size_t)(ok[u] ? row : row0) * 1024);
#pragma unroll
      for (int i = 0; i < 4; ++i) v[u][i] = s4[i * 64 + lane];
    }
#pragma unroll
    for (int u = 0; u < 2; ++u) {
      const int row = row0 + u * stride;
      float sum = 0.f;
#pragma unroll
      for (int i = 0; i < 4; ++i) sum += (v[u][i].x + v[u][i].y) + (v[u][i].z + v[u][i].w);
      const float mean = wave_sum(sum, lane) * (1.0f / 1024.0f);
      float sq = 0.f;
#pragma unroll
      for (int i = 0; i < 4; ++i) {
        float a = v[u][i].x - mean, b = v[u][i].y - mean, c = v[u][i].z - mean, d = v[u][i].w - mean;
        sq += (a * a + b * b) + (c * c + d * d);
      }
      const float rstd = rsqrtf(wave_sum(sq, lane) * (1.0f / 1024.0f) + 1e-5f);
      if (ok[u]) {
#pragma unroll
        for (int i = 0; i < 4; ++i) {
          float4 gg = ((const float4*)gam)[i * 64 + lane], bb = ((const float4*)bet)[i * 64 + lane];
          float4 o;
          o.x = (v[u][i].x - mean) * rstd * gg.x + bb.x; o.y = (v[u][i].y - mean) * rstd * gg.y + bb.y;
          o.z = (v[u][i].z - mean) * rstd * gg.z + bb.z; o.w = (v[u][i].w - mean) * rstd * gg.w + bb.w;
          if (dst) ((float4*)(dst + (size_t)row * 1024))[i * 64 + lane] = o;
          if (dstb) {
            uint2 pk; pk.x = pack2(o.x, o.y); pk.y = pack2(o.z, o.w);
            ((uint2*)(dstb + (size_t)row * 1024))[i * 64 + lane] = pk;
          }
        }
      }
    }
  }
}

constexpr int PROJ_N0 = 5120;
__device__ void phase_proj(const Params& p, unsigned char* lds, int layer, int bid, int nblk) {
  unsigned char* WS = launder_ws(lds);
  pg8::Gemm g{(const bf16_t*)(WS + G_XB), (const bf16_t*)(WS + G_WL + layer * WL_SIZE + O_WIN), MC, PROJ_N0, 1024};
  pg8::StaticOrder S; S.init(MC, PROJ_N0, nblk, bid);
  pg8::EpiProj E{(bf16_t*)(WS + G_PROJ), (const float*)(WS + G_ROPE), 0, (bf16_t*)(WS + G_USSM)};
  pg8::gemm_phase<pg8::EpiProj, pg8::StaticOrder>((PG8_LAS unsigned char*)lds, g, S, E, nullptr);
}

__device__ void phase2(const Params& p, unsigned char* lds, int layer, int bid, int nblk) {
  unsigned char* WS = launder_ws(lds);
  unsigned char* wl = WS + G_WL + layer * WL_SIZE;
  const bf16_t* PROJ = (const bf16_t*)(WS + G_PROJ);
  constexpr int T_CMP = 32, T_S5 = 64, T_POOL = (MC / 128) * 4;
  const int hgrid = nblk >> 1;
  if (bid < hgrid) {
    pg8::Gemm g{(const bf16_t*)(WS + G_XB), (const bf16_t*)(wl + O_WIN) + (size_t)PROJ_N0 * 1024, MC, INP - PROJ_N0, 1024};
    pg8::StaticOrder S; S.init(MC, INP - PROJ_N0, hgrid, bid);
    pg8::EpiProj E{(bf16_t*)(WS + G_PROJ), (const float*)(WS + G_ROPE), PROJ_N0, (bf16_t*)(WS + G_USSM)};
    pg8::gemm_phase<pg8::EpiProj, pg8::StaticOrder>((PG8_LAS unsigned char*)lds, g, S, E, nullptr);
  }
  constexpr int T_HEAVY = T_CMP + T_S5, T_POOL0 = 256;
  const bool firsth = bid < hgrid;
  const int vstart = firsth ? bid : bid - hgrid, vstride = firsth ? hgrid : nblk - hgrid, vend = firsth ? T_POOL0 : T_HEAVY + T_POOL - T_POOL0;
  for (int v = vstart; v < vend; v += vstride) {
    const int t = firsth ? (T_HEAVY + v) : (v < T_HEAVY ? v : v + T_POOL0);
    f32x4 acc[4][2]; zero_acc(acc);
    if (t < T_CMP) {
      const int kv = t & 1, mt = t >> 1, m0 = mt * 128;
      const bf16_t* Bt = (const bf16_t*)(wl + (kv ? O_WCV1 : O_WCK1));
      const float* bias = (const float*)(wl + (kv ? O_BCV1 : O_BCK1));
      bf16_t* H1 = (bf16_t*)(WS + G_H1) + (size_t)kv * CHB * 512 * 128;
      const int col0 = C_KV + kv * 128;
      auto la = [=](int r, int kk) -> uint4 {
        const int row = m0 + r;
        int n = row & 255; if (n > 254) n = 254;
        const int k = (row >> 8) & 1, bl = row >> 9;
        return gld16(PROJ + ((size_t)bl * SEQ + 16 * n + (kk >> 6)) * INP + col0 + k * 64 + (kk & 63));
      };
      auto lb = [=](int n, int kk) -> uint4 { return gld16(Bt + (size_t)n * 2048 + kk); };
      gemm_acc(lds, 32, la, lb, acc);
      const int ecol = ((otid() >> 6) & 3) * 32 + ((otid() & 63) >> 4) * 4;
      const float4 bia0 = gldf4(bias + ecol), bia1 = gldf4(bias + ecol + 16);
      gemm_epi(acc, [=](int r, int c, f32x4 v, int ni) {
        const float4 b4 = ni ? bia1 : bia0;
        v[0] = gelu_tanh(v[0] + b4.x); v[1] = gelu_tanh(v[1] + b4.y); v[2] = gelu_tanh(v[2] + b4.z); v[3] = gelu_tanh(v[3] + b4.w);
        gst8(H1 + (size_t)(m0 + r) * 128 + c, pack4(v));
      });
    } else if (t < T_CMP + T_S5) {
      const int tt = t - T_CMP, g = tt >> 1, m0 = (tt & 1) * 128;
      const bf16_t* Bt = (const bf16_t*)(wl + O_EMAT) + (size_t)g * 128 * 1024;
      float* S = (float*)(WS + G_S);
      auto la = [=](int r, int kk) -> uint4 {
        return gld16((const bf16_t*)(WS + G_USSM) + ((size_t)g * MC + (size_t)(m0 + r) * 64) * 16 + kk);
      };
      auto lb = [=](int n, int kk) -> uint4 { return gld16(Bt + (size_t)n * 1024 + kk); };
      gemm_acc(lds, 16, la, lb, acc);
      gemm_epi(acc, [=](int r, int c, f32x4 v, int) {
        gstf4(S + ((size_t)g * NROW + m0 + r) * 128 + c, make_float4(v[0], v[1], v[2], v[3]));
      });
    } else {
      const int tt = t - T_CMP - T_S5, g = tt & 3, m0 = (tt >> 2) * 128;
      const bf16_t* Bt = (const bf16_t*)(wl + O_WPOOL) + g * 128 * 128;
      const float* pscale = p.in[5] + (size_t)layer * 512 + g * 128;
      bf16_t* Y = (bf16_t*)(WS + G_Y);
      auto lb = [=](int n, int kk) -> uint4 { return gld16(Bt + (size_t)n * 128 + kk); };
      auto pool_la = [=](auto wtag, int r, int kk) -> uint4 {
        constexpr int W = decltype(wtag)::value;
        const int row = m0 + r, tpos = row & (SEQ - 1);
        const int cnt = (tpos + 1 < W) ? (tpos + 1) : W;
        const bf16_t* base = PROJ + (size_t)row * INP + g * 128 + kk;
        uint4 u[W];
#pragma unroll
        for (int j = 0; j < W; ++j) u[j] = gld16(base - (size_t)((j < cnt) ? j : 0) * INP);
        float sum[8];
#pragma unroll
        for (int e = 0; e < 8; ++e) sum[e] = 0.f;
#pragma unroll
        for (int j = 0; j < W; ++j) {
          const float wj = (j < cnt) ? 1.0f : 0.0f;
          sum[0] += wj * __uint_as_float(u[j].x << 16); sum[1] += wj * __uint_as_float(u[j].x & 0xffff0000u);
          sum[2] += wj * __uint_as_float(u[j].y << 16); sum[3] += wj * __uint_as_float(u[j].y & 0xffff0000u);
          sum[4] += wj * __uint_as_float(u[j].z << 16); sum[5] += wj * __uint_as_float(u[j].z & 0xffff0000u);
          sum[6] += wj * __uint_as_float(u[j].w << 16); sum[7] += wj * __uint_as_float(u[j].w & 0xffff0000u);
        }
        const float ic = 1.0f / (float)cnt;
        uint4 o;
        o.x = pack2(sum[0] * ic - __uint_as_float(u[0].x << 16), sum[1] * ic - __uint_as_float(u[0].x & 0xffff0000u));
        o.y = pack2(sum[2] * ic - __uint_as_float(u[0].y << 16), sum[3] * ic - __uint_as_float(u[0].y & 0xffff0000u));
        o.z = pack2(sum[4] * ic - __uint_as_float(u[0].z << 16), sum[5] * ic - __uint_as_float(u[0].z & 0xffff0000u));
        o.w = pack2(sum[6] * ic - __uint_as_float(u[0].w << 16), sum[7] * ic - __uint_as_float(u[0].w & 0xffff0000u));
        return o;
      };
      if (g == 0) gemm_acc(lds, 2, [=](int r, int kk) -> uint4 { return pool_la(std::integral_constant<int, 2>{}, r, kk); }, lb, acc);
      else if (g == 1) gemm_acc(lds, 2, [=](int r, int kk) -> uint4 { return pool_la(std::integral_constant<int, 4>{}, r, kk); }, lb, acc);
      else if (g == 2) gemm_acc(lds, 2, [=](int r, int kk) -> uint4 { return pool_la(std::integral_constant<int, 8>{}, r, kk); }, lb, acc);
      else gemm_acc(lds, 2, [=](int r, int kk) -> uint4 { return pool_la(std::integral_constant<int, 16>{}, r, kk); }, lb, acc);
      const int ecol = ((otid() >> 6) & 3) * 32 + ((otid() & 63) >> 4) * 4;
      const float4 psc0 = gldf4(pscale + ecol), psc1 = gldf4(pscale + ecol + 16);
      gemm_epi(acc, [=](int r, int c, f32x4 v, int ni) {
        const float4 s4 = ni ? psc1 : psc0;
        v[0] *= s4.x; v[1] *= s4.y; v[2] *= s4.z; v[3] *= s4.w;
        gst8(Y + (size_t)(m0 + r) * 1536 + g * 128 + c, pack4(v));
      });
    }
  }
}

__device__ void phase3(const Params& p, unsigned char* lds, int layer, int bid, int nblk) {
  unsigned char* WS = launder_ws(lds);
  unsigned char* wl = WS + G_WL + layer * WL_SIZE;
  constexpr int T_CMP = 32, T_SCAN = 32 * CHB * 64 / NTHR;
  for (int t = bid; t < T_CMP + T_SCAN; t += nblk) {
    if (t < T_CMP) {
      const int kv = t & 1, m0 = (t >> 1) * 128;
      const bf16_t* A = (const bf16_t*)(WS + G_H1) + (size_t)kv * CHB * 512 * 128;
      const bf16_t* Bt = (const bf16_t*)(wl + (kv ? O_WCV2 : O_WCK2));
      bf16_t* KC = (bf16_t*)(WS + G_KCMP);
      bf16_t* VT = (bf16_t*)(WS + G_VCMPT);
      f32x4 acc[4][2]; zero_acc(acc);
      auto la = [=](int r, int kk) -> uint4 { return gld16(A + (size_t)(m0 + r) * 128 + kk); };
      auto lb = [=](int n, int kk) -> uint4 { return gld16(Bt + (size_t)(n & 63) * 128 + kk); };
      gemm_acc(lds, 2, la, lb, acc);
      gemm_epi(acc, [=](int r, int c, f32x4 v, int) {
        if (c < 64) {
          const int row = m0 + r;
          if (kv == 0) {
            gst8(KC + (size_t)row * 64 + c, pack4(v));
          } else {
            const int bk = row >> 8, n = row & 255;
#pragma unroll
            for (int e = 0; e < 4; ++e) VT[((size_t)bk * 64 + c + e) * 256 + n] = f2bf(v[e]);
          }
        }
      });
    } else {
      const int idx = (t - T_CMP) * NTHR + otid();
      const int pp = idx & 63, bl = (idx >> 6) % CHB, g = idx / (64 * CHB);
      const float* a64 = (const float*)(wl + O_A64);
      const float ar = a64[(g * 64 + pp) * 2], ai = a64[(g * 64 + pp) * 2 + 1];
      const float* S = (const float*)(WS + G_S) + ((size_t)g * NROW + bl * 64) * 128;
      bf16_t* HIN = (bf16_t*)(WS + G_HIN) + ((size_t)g * NROW + bl * 64) * 128;
      float hr = 0.f, hi = 0.f;
#pragma unroll 1
      for (int c0 = 0; c0 < 64; c0 += 16) {
        float sr[16], si[16];
#pragma unroll
        for (int c = 0; c < 16; ++c) { sr[c] = S[(c0 + c) * 128 + pp]; si[c] = S[(c0 + c) * 128 + 64 + pp]; }
#pragma unroll
        for (int c = 0; c < 16; ++c) {
          HIN[(c0 + c) * 128 + pp] = f2bf(hr); HIN[(c0 + c) * 128 + 64 + pp] = f2bf(hi);
          const float nr = ar * hr - ai * hi + sr[c], ni = ar * hi + ai * hr + si[c];
          hr = nr; hi = ni;
        }
      }
    }
  }
}

constexpr int CMP_LDS_OFF = 40960;
__device__ void cmp_attn_wave(const Params& p, unsigned char* lds, int it) {
  unsigned char* WS = launder_ws(lds);
  const int tid = otid(), lane = tid & 63, wid = __builtin_amdgcn_readfirstlane(tid >> 6), fr = lane & 15, fq = lane >> 4;
  const int pairidx = it >> 1;
  const int tg = (wid >> 2) ? 255 - pairidx : pairidx;
  const int bk = (it & 1) * 4 + (wid & 3), bl = bk >> 1, k = bk & 1;
  const bf16_t* PROJ = (const bf16_t*)(WS + G_PROJ);
  const bf16_t* KC = (const bf16_t*)(WS + G_KCMP) + (size_t)bk * 256 * 64;
  const bf16_t* VT = (const bf16_t*)(WS + G_VCMPT) + (size_t)bk * 64 * 256;
  float* ONSA = (float*)(WS + G_ONSA);
  u64* SEL = (u64*)(WS + G_SEL);
  float* sc = (float*)(lds + CMP_LDS_OFF) + wid * (16 * 65);
  const int t0 = tg * 16;
  const size_t tok = (size_t)bl * SEQ + t0 + fr;
  const int nvr = (tg == 0) ? 0 : ((fr == 15) ? tg : tg - 1);
  const int src = (lane + 48) & 63;
  float imp[16];
#pragma unroll
  for (int ni = 0; ni < 16; ++ni) imp[ni] = 0.f;
#pragma unroll 1
  for (int g = 0; g < 4; ++g) {
    int lnl = lane; asm volatile("" : "+v"(lnl));
    const int frl = lnl & 15, fql = lnl >> 4, srcl = (lnl + 48) & 63;
    const size_t tokl = (size_t)bl * SEQ + t0 + frl;
    const int h = k * 4 + g;
    int nrel = ((tg == 0) ? 0 : ((frl == 15) ? tg : tg - 1)) - fql * 4;
    asm volatile("" : "+v"(nrel));
    bf16x8 qf[2];
#pragma unroll
    for (int ks = 0; ks < 2; ++ks) qf[ks] = gld16b(PROJ + tokl * INP + C_Q + h * 64 + ks * 32 + fql * 8);
    f32x4 s[16];
#pragma unroll
    for (int ni = 0; ni < 16; ++ni) {
      s[ni] = (f32x4){0.f, 0.f, 0.f, 0.f};
      if (ni * 16 < tg) {
#pragma unroll
        for (int ks = 0; ks < 2; ++ks) {
          const bf16x8 kf = gld16b(KC + (size_t)(ni * 16 + frl) * 64 + ks * 32 + fql * 8);
          s[ni] = __builtin_amdgcn_mfma_f32_16x16x32_bf16(kf, qf[ks], s[ni], 0, 0, 0);
        }
      }
      if (ni & 1) asm volatile("" ::: "memory");
    }
    float rmax = -1e30f;
#pragma unroll
    for (int ni = 0; ni < 16; ++ni)
#pragma unroll
      for (int e = 0; e < 4; ++e) {
        if (ni * 16 + e < nrel) rmax = fmaxf(rmax, s[ni][e]);
      }
    rmax = fmaxf(rmax, shx(rmax, 16, lnl)); rmax = fmaxf(rmax, shx(rmax, 32, lnl));
    float rsum = 0.f;
#pragma unroll
    for (int ni = 0; ni < 16; ++ni)
#pragma unroll
      for (int e = 0; e < 4; ++e) {
        const float pv = (ni * 16 + e < nrel) ? __builtin_amdgcn_exp2f(s[ni][e] - rmax) : 0.f;
        s[ni][e] = pv; rsum += pv;
      }
    rsum += shx(rsum, 16, lnl); rsum += shx(rsum, 32, lnl);
    const float inv = (rsum > 0.f) ? 1.0f / rsum : 0.f;
#pragma unroll
    for (int ni = 0; ni < 16; ++ni) {
#pragma unroll
      for (int e = 0; e < 4; ++e) s[ni][e] *= inv;
      const float a = __int_as_float(__builtin_amdgcn_ds_bpermute(srcl << 2, __float_as_int(s[ni][3])));
      const float b = (ni > 0) ? __int_as_float(__builtin_amdgcn_ds_bpermute(srcl << 2, __float_as_int(s[ni > 0 ? ni - 1 : 0][3]))) : 0.f;
      const float prev = (fql > 0) ? a : b;
      imp[ni] += 2.0f * (s[ni][0] + s[ni][1] + s[ni][2]) + s[ni][3] + prev;
      if ((ni & 3) == 3) asm volatile("" ::: "memory");
    }
    f32x4 o[4];
#pragma unroll
    for (int nd = 0; nd < 4; ++nd) o[nd] = (f32x4){0.f, 0.f, 0.f, 0.f};
#pragma unroll
    for (int kh = 0; kh < 2; ++kh) {
      if (kh * 128 < tg) {
#pragma unroll
        for (int kq = 0; kq < 4; ++kq) {
          const int k8 = kh * 4 + kq;
          const uint2 pa = pack4(s[2 * k8]), pb = pack4(s[2 * k8 + 1]);
          const bf16x8 pf = __builtin_bit_cast(bf16x8, (u32x4v){pa.x, pa.y, pb.x, pb.y});
#pragma unroll
          for (int nd = 0; nd < 4; ++nd) {
            const uint2 va = gld8(VT + (size_t)(nd * 16 + frl) * 256 + k8 * 32 + fql * 4);
            const uint2 vb = gld8(VT + (size_t)(nd * 16 + frl) * 256 + k8 * 32 + 16 + fql * 4);
            o[nd] = __builtin_amdgcn_mfma_f32_16x16x32_bf16(__builtin_bit_cast(bf16x8, (u32x4v){va.x, va.y, vb.x, vb.y}), pf, o[nd], 0, 0, 0);
          }
          if (kq & 1) asm volatile("" ::: "memory");
        }
      }
    }
    const float gt = bf2f(PROJ[tokl * INP + C_GN + h * 3 + 0]);
#pragma unroll
    for (int nd = 0; nd < 4; ++nd)
      gstf4(ONSA + tokl * 512 + h * 64 + nd * 16 + fql * 4, make_float4(gt * o[nd][0], gt * o[nd][1], gt * o[nd][2], gt * o[nd][3]));
  }
#pragma unroll
  for (int ni = 0; ni < 16; ++ni) sc[fr * 65 + ni * 4 + fq] = imp[ni];
  asm volatile("s_waitcnt lgkmcnt(0)" ::: "memory");
#pragma unroll 1
  for (int r = 0; r < 16; ++r) {
    const int t = t0 + r, cur = t >> 6, sb = lane;
    const float impv = sc[r * 65 + sb];
    const bool forced = (sb == 0) || (sb == cur) || (sb == cur - 1);
    const float score = forced ? 1e6f : ((sb <= cur) ? impv : -1e6f);
    const unsigned bits = __float_as_uint(score);
    const unsigned u = (bits & 0x80000000u) ? ~bits : (bits | 0x80000000u);
    unsigned T = 0u;
#pragma unroll
    for (int bit = 31; bit >= 0; --bit) {
      const unsigned cand = T | (1u << bit);
      if (__popcll(__ballot(u >= cand)) >= 16) T = cand;
    }
    u64 m = __ballot(u > T);
    u64 eq = __ballot(u == T);
    int need = 16 - __popcll(m);
    while (need > 0 && eq) { const u64 low = eq & (~eq + 1ull); m |= low; eq ^= low; --need; }
    if (lane == 0) SEL[((size_t)bl * SEQ + t) * 2 + k] = m;
  }
  asm volatile("s_waitcnt lgkmcnt(0)" ::: "memory");
}

__device__ void phase4(const Params& p, unsigned char* lds, int layer, int bid, int nblk, int mode) {
  unsigned char* WS = launder_ws(lds);
  unsigned char* wl = WS + G_WL + layer * WL_SIZE;
  const bf16_t* PROJ = (const bf16_t*)(WS + G_PROJ);
  constexpr int T_S5 = 32 * 2 * 8, T_CMP = CHB * 2 * 256 / NWV;
  for (int t = bid; t < T_S5 + T_CMP; t += nblk) {
    if (mode == 1 && t >= T_S5) break;
    if (mode == 2 && t < T_S5) continue;
    if (t < T_S5) {
      const int nt = (t < T_S5 / 2) ? (7 - (t & 7)) : (t & 7), mt = (t >> 3) & 1, g = t >> 4;
      const int m0 = mt * 128, n0 = nt * 128, nk1 = 2 * nt + 2;
      const bf16_t* HIN = (const bf16_t*)(WS + G_HIN) + (size_t)g * NROW * 128;
      const bf16_t* USSM = (const bf16_t*)(WS + G_USSM);
      const bf16_t* KM = (const bf16_t*)(wl + O_KMAT) + (size_t)g * 64 * 256;
      const bf16_t* FM = (const bf16_t*)(wl + O_FMAT) + (size_t)g * 1024 * 128;
      const float* dsk = p.in[13] + (size_t)(layer * 32 + g) * 16;
      bf16_t* ZS = (bf16_t*)(WS + G_ZS);
      f32x4 acc[4][2]; zero_acc(acc);
      auto la = [=](int r, int kk) -> uint4 {
        const bool carry = kk >= nk1 * 64;
        const int k2 = carry ? (kk - nk1 * 64) : kk;
        const bf16_t* pu = USSM + ((size_t)g * MC + (size_t)(m0 + r) * 64) * 16 + k2;
        const bf16_t* ph_ = HIN + (size_t)(m0 + r) * 128 + (k2 & 127);
        return gld16(carry ? ph_ : pu);
      };
      auto lb = [=](int n, int kk) -> uint4 {
        const bool carry = kk >= nk1 * 64;
        const int k2 = carry ? (kk - nk1 * 64) : kk;
        const int nn = n0 + n, tt = nn >> 4, co = nn & 15;
        const int dd = tt - (k2 >> 4);
        const bf16_t* pk = KM + ((size_t)(dd < 0 ? 0 : dd) * 16 + co) * 16 + (k2 & 15);
        const bf16_t* pf = FM + (size_t)nn * 128 + (k2 & 127);
        uint4 v = gld16(carry ? pf : pk);
        if (!carry && dd < 0) v = make_uint4(0, 0, 0, 0);
        return v;
      };
      gemm_acc(lds, nk1 + 2, la, lb, acc);
      uint2 upre[4][2];
      gemm_pre(upre, [=](int r, int c) -> uint2 {
        const int nn = n0 + c, tt = nn >> 4, co = nn & 15;
        return gld8(USSM + ((size_t)g * MC + (size_t)(m0 + r) * 64 + tt) * 16 + co);
      });
      const float4 d4 = gldf4(dsk + ((otid() & 63) >> 4) * 4);
      gemm_epi_pre(acc, upre, [=](int r, int c, f32x4 v, uint2 pre, int) {
        const int nn = n0 + c, tt = nn >> 4, co = nn & 15;
        const size_t tok = (size_t)(m0 + r) * 64 + tt;
        const f32x4 u = unpack4(pre);
        v[0] = gelu_tanh(v[0] + d4.x * u[0]); v[1] = gelu_tanh(v[1] + d4.y * u[1]);
        v[2] = gelu_tanh(v[2] + d4.z * u[2]); v[3] = gelu_tanh(v[3] + d4.w * u[3]);
        gst8(ZS + tok * 512 + g * 16 + co, pack4(v));
      });
    } else {
      cmp_attn_wave(p, lds, t - T_S5);
    }
  }
}

constexpr int AMI = 2;
__device__ void attn_item(const Params& p, unsigned char* lds, int item) {
  unsigned char* WS = launder_ws(lds);
  const int tid = otid(), lane = tid & 63, wid = __builtin_amdgcn_readfirstlane(tid >> 6), g = wid & 3, th = wid >> 2, fr = lane & 15, fq = lane >> 4;
  const int qb = (item < 256) ? (63 - (item >> 3)) : ((item - 256) >> 3), k = item & 1, bl = (item >> 1) & 3;
  const bf16_t* PROJ = (const bf16_t*)(WS + G_PROJ);
  float* ONSA = (float*)(WS + G_ONSA);
  bf16_t* YN = (bf16_t*)(WS + G_Y) + 1024;
  const u64* SEL = (const u64*)(WS + G_SEL);
  bf16_t* sK = (bf16_t*)lds;
  bf16_t* sVt = sK + 64 * 72;
  const int h = k * 4 + g, t0 = qb * 64 + th * (AMI * 16);
  const int jq = qb;
  const size_t tokb = (size_t)bl * SEQ;
  bf16x8 qf[AMI][2];
#pragma unroll
  for (int mi = 0; mi < AMI; ++mi)
#pragma unroll
    for (int ks = 0; ks < 2; ++ks) qf[mi][ks] = gld16b(PROJ + (tokb + t0 + mi * 16 + fr) * INP + C_Q + h * 64 + ks * 32 + fq * 8);
  u64 mrow[AMI];
#pragma unroll
  for (int mi = 0; mi < AMI; ++mi) mrow[mi] = SEL[(tokb + t0 + mi * 16 + fr) * 2 + k];
  u64 um;
  {
    const u64 mm = SEL[(tokb + qb * 64 + lane) * 2 + k];
    unsigned lo = (unsigned)mm, hi = (unsigned)(mm >> 32);
#pragma unroll
    for (int o = 32; o >= 1; o >>= 1) { lo |= shxu(lo, o, lane); hi |= shxu(hi, o, lane); }
    lo = __builtin_amdgcn_readfirstlane(lo); hi = __builtin_amdgcn_readfirstlane(hi);
    um = ((u64)hi << 32) | lo;
  }
  const u64 causal = (jq == 63) ? ~0ull : ((1ull << (jq + 1)) - 1ull);
  um &= causal;
#pragma unroll 1
  for (int pass = 0; pass < 2; ++pass) {
    const int kcol = C_KV + (pass == 0 ? 512 : 256) + k * 64, vcol = kcol + 128;
    u64 blk;
    if (pass == 0) {
      const int lo = (qb >= 8) ? (qb - 8) : 0;
      blk = causal & ~((1ull << lo) - 1ull);
    } else blk = um;
    f32x4 o[AMI][4];
#pragma unroll
    for (int i = 0; i < AMI; ++i)
#pragma unroll
      for (int j = 0; j < 4; ++j) o[i][j] = (f32x4){0.f, 0.f, 0.f, 0.f};
    float mst[AMI], lst[AMI];
#pragma unroll
    for (int i = 0; i < AMI; ++i) { mst[i] = 0.f; lst[i] = 0.f; }
    bool first = true;
    const int lo_blk = (pass == 0 && qb >= 8) ? (qb - 8) : -1;
    const int krow = tid >> 3, kc8 = (tid & 7) * 8;
    auto pop = [&]() -> int { const int j_ = 63 - __builtin_clzll(blk); blk &= ~(1ull << j_); return j_; };
    auto stage = [&](int b_, const uint4& kreg, const uint4& vreg) {
      bf16_t* dK = sK + b_ * (2 * 64 * 72);
      bf16_t* dV = dK + 64 * 72;
      *(uint4*)(dK + krow * 72 + kc8) = kreg;
      const unsigned w[4] = {vreg.x, vreg.y, vreg.z, vreg.w};
#pragma unroll
      for (int e = 0; e < 4; ++e) {
        dV[(wid * 8 + 2 * e) * 72 + lane] = (bf16_t)(w[e] & 0xffffu);
        dV[(wid * 8 + 2 * e + 1) * 72 + lane] = (bf16_t)(w[e] >> 16);
      }
    };
    int jc = pop(), jn = -1, bsel = 0;
    uint4 kreg = gld16(PROJ + (tokb + jc * 64 + krow) * INP + kcol + kc8);
    uint4 vreg = gld16(PROJ + (tokb + jc * 64 + lane) * INP + vcol + wid * 8);
    __syncthreads();
    stage(0, kreg, vreg);
    if (blk) {
      jn = pop();
      kreg = gld16(PROJ + (tokb + jn * 64 + krow) * INP + kcol + kc8);
      vreg = gld16(PROJ + (tokb + jn * 64 + lane) * INP + vcol + wid * 8);
    }
    __syncthreads();
    for (;;) {
      const int j = jc;
      const bf16_t* cK = sK + bsel * (2 * 64 * 72);
      const bf16_t* cVt = cK + 64 * 72;
      int jnn = -1;
      if (jn >= 0) {
        stage(bsel ^ 1, kreg, vreg);
        if (blk) {
          jnn = pop();
          kreg = gld16(PROJ + (tokb + jnn * 64 + krow) * INP + kcol + kc8);
          vreg = gld16(PROJ + (tokb + jnn * 64 + lane) * INP + vcol + wid * 8);
        }
      }
      const bool maskblk = (j == jq) || (j == lo_blk);
      f32x4 sall[AMI][4];
      uint2 pp[AMI][4];
#pragma unroll
      for (int mi = 0; mi < AMI; ++mi) {
        const bool rowsel = (pass == 0) || ((mrow[mi] >> j) & 1ull);
        const float cinit = rowsel ? -mst[mi] : -1e30f;
#pragma unroll
        for (int ni = 0; ni < 4; ++ni) sall[mi][ni] = (f32x4){cinit, cinit, cinit, cinit};
      }
#pragma unroll
      for (int ks = 0; ks < 2; ++ks)
#pragma unroll
        for (int ni = 0; ni < 4; ++ni) {
          const bf16x8 kf = *(const bf16x8*)(cK + (ni * 16 + fr) * 72 + ks * 32 + fq * 8);
#pragma unroll
          for (int mi = 0; mi < AMI; ++mi) sall[mi][ni] = __builtin_amdgcn_mfma_f32_16x16x32_bf16(kf, qf[mi][ks], sall[mi][ni], 0, 0, 0);
        }
#pragma unroll
      for (int mi = 0; mi < AMI; ++mi) {
        f32x4 (&s)[4] = sall[mi];
        if (maskblk) {
          const int hi = t0 + mi * 16 + fr - j * 64, lo = hi - 512;
#pragma unroll
          for (int ni = 0; ni < 4; ++ni)
#pragma unroll
            for (int e = 0; e < 4; ++e) {
              const int key = ni * 16 + fq * 4 + e;
              s[ni][e] = (key <= hi && key > lo) ? s[ni][e] : -1e30f;
            }
        }
        float lm = s[0][0];
#pragma unroll
        for (int ni = 0; ni < 4; ++ni)
#pragma unroll
          for (int e = 0; e < 4; ++e) lm = fmaxf(lm, s[ni][e]);
        if (__any(first || lm > 64.0f)) {
          float r = fmaxf(lm, shx(lm, 16, lane)); r = fmaxf(r, shx(r, 32, lane));
          float delta = first ? r : fmaxf(r, 0.f);
          if (delta < -1e29f) delta = 0.f;
          const float alpha = __builtin_amdgcn_exp2f(-delta);
          mst[mi] += delta; lst[mi] *= alpha;
#pragma unroll
          for (int nd = 0; nd < 4; ++nd)
#pragma unroll
            for (int e = 0; e < 4; ++e) o[mi][nd][e] *= alpha;
#pragma unroll
          for (int ni = 0; ni < 4; ++ni)
#pragma unroll
            for (int e = 0; e < 4; ++e) s[ni][e] -= delta;
        }
        float rsum = 0.f;
#pragma unroll
        for (int ni = 0; ni < 4; ++ni) {
#pragma unroll
          for (int e = 0; e < 4; ++e) { const float pv = __builtin_amdgcn_exp2f(s[ni][e]); s[ni][e] = pv; rsum += pv; }
          pp[mi][ni] = pack4(s[ni]);
        }
        lst[mi] += rsum;
      }
      first = false;
#pragma unroll
      for (int ks = 0; ks < 2; ++ks) {
        bf16x8 vf[4], pf[AMI];
#pragma unroll
        for (int nd = 0; nd < 4; ++nd) {
          const uint2 va = *(const uint2*)(cVt + (nd * 16 + fr) * 72 + ks * 32 + fq * 4);
          const uint2 vb = *(const uint2*)(cVt + (nd * 16 + fr) * 72 + ks * 32 + 16 + fq * 4);
          vf[nd] = __builtin_bit_cast(bf16x8, (u32x4v){va.x, va.y, vb.x, vb.y});
        }
#pragma unroll
        for (int mi = 0; mi < AMI; ++mi) pf[mi] = __builtin_bit_cast(bf16x8, (u32x4v){pp[mi][2 * ks].x, pp[mi][2 * ks].y, pp[mi][2 * ks + 1].x, pp[mi][2 * ks + 1].y});
#pragma unroll
        for (int mi = 0; mi < AMI; ++mi)
#pragma unroll
          for (int nd = 0; nd < 4; ++nd) o[mi][nd] = __builtin_amdgcn_mfma_f32_16x16x32_bf16(vf[nd], pf[mi], o[mi][nd], 0, 0, 0);
      }
      if (jn < 0) break;
      __syncthreads();
      jc = jn; jn = jnn; bsel ^= 1;
    }
#pragma unroll
    for (int mi = 0; mi < AMI; ++mi) {
      const size_t tok = tokb + t0 + mi * 16 + fr;
      float lsum = lst[mi]; lsum += shx(lsum, 16, lane); lsum += shx(lsum, 32, lane);
      const float gt = bf2f(PROJ[tok * INP + C_GN + h * 3 + (pass == 0 ? 2 : 1)]) / lsum;
      float4 prevs[4];
#pragma unroll
      for (int nd = 0; nd < 4; ++nd) prevs[nd] = gldf4(ONSA + tok * 512 + h * 64 + nd * 16 + fq * 4);
#pragma unroll
      for (int nd = 0; nd < 4; ++nd) {
        const float4 prev = prevs[nd];
        f32x4 r;
        r[0] = prev.x + gt * o[mi][nd][0]; r[1] = prev.y + gt * o[mi][nd][1];
        r[2] = prev.z + gt * o[mi][nd][2]; r[3] = prev.w + gt * o[mi][nd][3];
        if (pass == 0) gstf4(ONSA + tok * 512 + h * 64 + nd * 16 + fq * 4, make_float4(r[0], r[1], r[2], r[3]));
        else gst8(YN + tok * 1536 + h * 64 + nd * 16 + fq * 4, pack4(r));
      }
    }
  }
}

__device__ void phase5(const Params& p, unsigned char* lds, int layer, int bid, int nblk) {
  unsigned char* WS = launder_ws(lds);
  unsigned char* wl = WS + G_WL + layer * WL_SIZE;
  constexpr int T_ATT = CHB * 2 * 64, T_GLU = (MC / 128) * 4;
  for (int t = bid; t < T_ATT + T_GLU; t += nblk) {
    if (t < T_ATT) {
      attn_item(p, lds, t);
    } else {
      const int tt = t - T_ATT, nt = tt & 3, m0 = (tt >> 2) * 128, n0 = nt * 128;
      const bf16_t* ZS = (const bf16_t*)(WS + G_ZS);
      const bf16_t* Bt = (const bf16_t*)(wl + O_WGLU);
      const float* bg = p.in[15] + (size_t)layer * 512;
      bf16_t* Y = (bf16_t*)(WS + G_Y);
      f32x4 acc[4][2]; zero_acc(acc);
      auto la = [=](int r, int kk) -> uint4 { return gld16(ZS + (size_t)(m0 + r) * 512 + kk); };
      auto lb = [=](int n, int kk) -> uint4 { return gld16(Bt + (size_t)(n0 + n) * 512 + kk); };
      gemm_acc(lds, 8, la, lb, acc);
      uint2 zpre[4][2];
      gemm_pre(zpre, [=](int r, int c) -> uint2 { return gld8(ZS + (size_t)(m0 + r) * 512 + n0 + c); });
      const int ecol = ((otid() >> 6) & 3) * 32 + ((otid() & 63) >> 4) * 4;
      const float4 bgl0 = gldf4(bg + n0 + ecol), bgl1 = gldf4(bg + n0 + ecol + 16);
      gemm_epi_pre(acc, zpre, [=](int r, int c, f32x4 v, uint2 pre, int ni) {
        const float4 b4 = ni ? bgl1 : bgl0;
        const f32x4 z = unpack4(pre);
        v[0] = z[0] * sigmoidf_(v[0] + b4.x); v[1] = z[1] * sigmoidf_(v[1] + b4.y);
        v[2] = z[2] * sigmoidf_(v[2] + b4.z); v[3] = z[3] * sigmoidf_(v[3] + b4.w);
        gst8(Y + (size_t)(m0 + r) * 1536 + 512 + n0 + c, pack4(v));
      });
    }
  }
}

__device__ void phase_merge(const Params& p, unsigned char* lds, int layer, int bid, int nblk) {
  unsigned char* WS = launder_ws(lds);
  unsigned char* wl = WS + G_WL + layer * WL_SIZE;
  pg8::Gemm g{(const bf16_t*)(WS + G_Y), (const bf16_t*)(wl + O_WUP), MC, 1024, 1536};
  pg8::StaticOrder S; S.init(MC, 1024, nblk, bid);
  pg8::EpiMerge E{(const bf16_t*)(WS + G_PROJ), (bf16_t*)(WS + G_ONSA)};
  pg8::gemm_phase<pg8::EpiMerge, pg8::StaticOrder>((PG8_LAS unsigned char*)lds, g, S, E, nullptr);
}
template <int K>
__device__ void phase_resid(const Params& p, unsigned char* lds, const bf16_t* A, const bf16_t* Bt, float* X, int bid, int nblk) {
  unsigned char* WS = launder_ws(lds);
  pg8::Gemm g{A, Bt, MC, 1024, K};
  pg8::StaticOrder S; S.init(MC, 1024, nblk, bid);
  pg8::EpiResid E{X, (const bf16_t*)(WS + G_XB)};
  pg8::gemm_phase<pg8::EpiResid, pg8::StaticOrder>((PG8_LAS unsigned char*)lds, g, S, E, nullptr);
}
__device__ void phase_ff1(const Params& p, unsigned char* lds, int layer, int bid, int nblk) {
  unsigned char* WS = launder_ws(lds);
  pg8::Gemm g{(const bf16_t*)(WS + G_XB), (const bf16_t*)(WS + G_WL + layer * WL_SIZE + O_WFF1), MC, 4096, 1024};
  pg8::StaticOrder S; S.init(MC, 4096, nblk, bid);
  pg8::EpiRelu2 E{(bf16_t*)(WS + G_PROJ), 4096};
  pg8::gemm_phase<pg8::EpiRelu2, pg8::StaticOrder>((PG8_LAS unsigned char*)lds, g, S, E, nullptr);
}

#define XB_TMO      128
#define XB_XCNT(j)  (256  + 64 * (j))
#define XB_XSUB(j)  (1280 + 64 * (j))
#define XB_XGEN(j)  (2304 + 64 * (j))
#define XB_TOP      3328
#define XB_TOPGEN   3392
#define XCD_BAR_WORDS 3456
#define XB_SPIN_CAP (1u << 18)
#define LAS __attribute__((address_space(3)))

__device__ __forceinline__ unsigned xb_ld(unsigned* p)              { return __hip_atomic_load(p, __ATOMIC_RELAXED, __HIP_MEMORY_SCOPE_AGENT); }
__device__ __forceinline__ unsigned xb_add(unsigned* p, unsigned v) { return __hip_atomic_fetch_add(p, v, __ATOMIC_RELAXED, __HIP_MEMORY_SCOPE_AGENT); }
__device__ __forceinline__ unsigned xb_xcc_id() { return (unsigned)__builtin_amdgcn_s_getreg((3 << 11) | 20) & 0xFu; }
#define XB_SPIN(cond, bar) do { unsigned _sp = 0; while (cond) { __builtin_amdgcn_s_sleep(1); \
    if ((++_sp & 255u) == 0u) { if (xb_ld(&(bar)[XB_TMO])) break; if (_sp > XB_SPIN_CAP) { atomicAdd(&(bar)[XB_TMO], 1u); break; } } } } while (0)

struct XcdBarrier {
    unsigned* bar; unsigned x;
    volatile LAS unsigned* st;
};

__device__ __forceinline__ XcdBarrier xcd_barrier_post(unsigned* bar, volatile LAS unsigned* st) {
    XcdBarrier b; b.bar = bar; b.x = xb_xcc_id(); b.st = st;
    if (threadIdx.x == 0) (void)xb_add(&bar[XB_XCNT(b.x)], 1u);
    return b;
}
__device__ __forceinline__ void xcd_barrier_complete(unsigned* bar, unsigned x, unsigned& nloc, unsigned& nx) {
    const unsigned G = gridDim.x * gridDim.y * gridDim.z;
    unsigned sum, cnt, mine, sp = 0u;
    for (;;) {
        sum = 0u; cnt = 0u; mine = 0u;
#pragma unroll
        for (unsigned j = 0; j < 16; ++j) { const unsigned c = xb_ld(&bar[XB_XCNT(j)]); sum += c; cnt += (c > 0u) ? 1u : 0u; mine = (j == x) ? c : mine; }
        if (sum == G) break;
        __builtin_amdgcn_s_sleep(1);
        if ((++sp & 255u) == 0u) { if (xb_ld(&bar[XB_TMO])) break; if (sp > XB_SPIN_CAP) { atomicAdd(&bar[XB_TMO], 1u); break; } }
    }
    nloc = mine > 0u ? mine : 1u; nx = cnt > 0u ? cnt : 1u;
}

__device__ __forceinline__ void xcd_barrier(const XcdBarrier& b) {
    asm volatile("s_waitcnt vmcnt(0)" ::: "memory");
    __syncthreads();
    if (threadIdx.x == 0) {
        unsigned* bar = b.bar;
        __builtin_amdgcn_s_waitcnt(0);
        unsigned nloc = b.st[0], nx = b.st[1];
        if (nloc == 0u) { xcd_barrier_complete(bar, b.x, nloc, nx); b.st[0] = nloc; b.st[1] = nx; }
        const unsigned old = xb_add(&bar[XB_XSUB(b.x)], 1u);
        const unsigned gen = old / nloc;
        if (old + 1u == (gen + 1u) * nloc) {
            __builtin_amdgcn_fence(__ATOMIC_RELEASE, "agent");
            asm volatile("s_waitcnt vmcnt(0)" ::: "memory");
            const unsigned og = xb_add(&bar[XB_TOP], 1u);
            const unsigned tg = og / nx;
            if (og + 1u == (tg + 1u) * nx) xb_add(&bar[XB_TOPGEN], 1u);
            else XB_SPIN(xb_ld(&bar[XB_TOPGEN]) == tg, bar);
            __builtin_amdgcn_fence(__ATOMIC_ACQUIRE, "agent");
            xb_add(&bar[XB_XGEN(b.x)], 1u);
            asm volatile("s_waitcnt vmcnt(0)" ::: "memory");
        } else {
            XB_SPIN(xb_ld(&bar[XB_XGEN(b.x)]) == gen, bar);
            __builtin_amdgcn_fence(__ATOMIC_ACQUIRE, "agent");
            asm volatile("s_waitcnt vmcnt(0)" ::: "memory");
        }
    }
    __syncthreads();
}


__device__ void run_phase(const Params& p, unsigned char* lds, int ph, int layer, int chunk, int bid, int nblk) {
  unsigned char* WS = launder_ws(lds);
  float* X = p.out + (size_t)chunk * MC * 1024;
  unsigned char* wl = WS + G_WL + layer * WL_SIZE;
  bf16_t* XB = (bf16_t*)(WS + G_XB);
  switch (ph) {
    case 0: phase0(p, lds, bid, nblk);
            ln_rows(p.in[0], (float*)nullptr, XB, p.in[1], p.in[2], MC, bid, nblk); break;
    case 2: phase_proj(p, lds, layer, bid, nblk); break;
    case 3: phase2(p, lds, layer, bid, nblk); break;
    case 4: phase3(p, lds, layer, bid, nblk); break;
    case 5: case 13: case 14: phase4(p, lds, layer, bid, nblk, ph == 5 ? 0 : ph - 12); break;
    case 6: phase5(p, lds, layer, bid, nblk); break;
    case 7: phase_merge(p, lds, layer, bid, nblk); break;
    case 8: phase_resid<1024>(p, lds, (const bf16_t*)(WS + G_ONSA), (const bf16_t*)(wl + O_WOUT), X, bid, nblk); break;
    case 9: ln_rows(X, (float*)nullptr, XB, p.in[26] + layer * 1024, p.in[27] + layer * 1024, MC, bid, nblk); break;
    case 10: phase_ff1(p, lds, layer, bid, nblk); break;
    case 11: phase_resid<4096>(p, lds, (const bf16_t*)(WS + G_PROJ), (const bf16_t*)(wl + O_WFF2), X, bid, nblk); break;
    case 12: {
      const bool fold = (layer + 1 == DEPTH) && (chunk + 1 < NCH);
      const int nj = fold ? 2 : 1;
#pragma unroll 1
      for (int i = 0; i < nj; ++i) {
        const bool second = (i == 1);
        ln_rows(second ? p.in[0] + (size_t)(chunk + 1) * MC * 1024 : X, (!second && layer + 1 == DEPTH) ? X : (float*)nullptr,
                (second || layer + 1 < DEPTH) ? XB : (bf16_t*)nullptr, second ? p.in[1] : p.in[30] + layer * 1024, second ? p.in[2] : p.in[31] + layer * 1024, MC, bid, nblk);
      }
      break; }
    default: break;
  }
}

__global__ void __launch_bounds__(NTHR, 2) k_mega(Params p) {
  __shared__ __attribute__((aligned(16))) unsigned char lds[LDS_BYTES + 256];
  cg::grid_group grid = cg::this_grid();
  {
    volatile LAS unsigned* bst = (volatile LAS unsigned*)(lds + LDS_BYTES);
    if (threadIdx.x == 0) { bst[0] = 0u; bst[1] = 0u; const unsigned long long wsv = (unsigned long long)p.ws; bst[4] = (unsigned)wsv; bst[5] = (unsigned)(wsv >> 32); }
    __syncthreads();
    if (blockIdx.x == 0) {
      unsigned* bw = (unsigned*)(launder_ws(lds) + G_BAR);
      for (int i = threadIdx.x; i < XCD_BAR_WORDS; i += NTHR) __hip_atomic_store(bw + i, 0u, __ATOMIC_RELAXED, __HIP_MEMORY_SCOPE_AGENT);
    }
  }
  const int bid = blockIdx.x, nblk = gridDim.x;
#ifdef DBL_LO
  constexpr int NEXTRA = DBL_HI - DBL_LO + 1;
  constexpr int DLO = DBL_LO, DHI = DBL_HI;
#else
  constexpr int NEXTRA = 0, DLO = 100, DHI = 100;
#endif
  constexpr int PER_LAYER = 11 + NEXTRA, PER_CHUNK = DEPTH * PER_LAYER, NSTEP = 1 + NCH * PER_CHUNK;
#pragma unroll 1
  for (int step = 0; step < NSTEP; ++step) {
    int ph = 0, layer = 0, chunk = 0;
    if (step > 0) {
      const int s = step - 1, r = s % PER_CHUNK;
      chunk = s / PER_CHUNK; layer = r / PER_LAYER;
      const int i = r % PER_LAYER, nfirst = DHI - 2 + 1;
      if (NEXTRA == 0 || i < nfirst) ph = 2 + i;
      else if (i < nfirst + NEXTRA) ph = DLO + (i - nfirst);
      else ph = 2 + i - NEXTRA;
    }
    run_phase(p, lds, ph, layer, chunk, bid, nblk);
    if (step + 1 < NSTEP) { if (step == 0) { grid.sync(); (void)xcd_barrier_post((unsigned*)(launder_ws(lds) + G_BAR), (volatile LAS unsigned*)(lds + LDS_BYTES)); } else { XcdBarrier xb; xb.bar = (unsigned*)(launder_ws(lds) + G_BAR); xb.x = xb_xcc_id(); xb.st = (volatile LAS unsigned*)(lds + LDS_BYTES); xcd_barrier(xb); } }
  }
}

extern "C" void kernel_launch(void* const* d_in, const int* in_sizes, int n_in, void* d_out, int out_size, void* d_ws, size_t ws_size,
                              hipStream_t stream) {
  Params p{};
  for (int i = 0; i < 32; ++i) p.in[i] = (const float*)d_in[i];
  p.out = (float*)d_out;
  p.ws = (unsigned char*)d_ws;
  static int grid_blocks = 0;
  if (!grid_blocks) {
    int dev = 0, cus = 0, per_cu = 0;
    (void)hipGetDevice(&dev);
    (void)hipDeviceGetAttribute(&cus, hipDeviceAttributeMultiprocessorCount, dev);
    (void)hipOccupancyMaxActiveBlocksPerMultiprocessor(&per_cu, k_mega, NTHR, 0);
    if (per_cu > 1) per_cu = 1;
    if (per_cu < 1) per_cu = 1;
    grid_blocks = cus * per_cu;
  }
  void* args[] = {&p};
  (void)hipLaunchCooperativeKernel((void*)k_mega, dim3(grid_blocks), dim3(NTHR), args, 0, stream);
}
```
